# Optimizing an MI355X kernel written in HIP

```python
import jax, jax.numpy as jnp
from jax import lax
import numpy as np


D_MODEL = 1024
BATCH = 8
SEQ = 2048
DEPTH = 2

GRID_W = 64
CTX_LEN = 256
HEAD_DIM = 64
MIX_W = D_MODEL
POOL_W = MIX_W // 4
POOL_WINDOWS = (2, 4, 8, 16)
POOL_GW = POOL_W // len(POOL_WINDOWS)
ATT_W = MIX_W // 2
ATT_HEADS = ATT_W // HEAD_DIM
ATT_KV_HEADS = max(1, ATT_HEADS // 4)
ATT_GROUP = ATT_HEADS // ATT_KV_HEADS
ATT_KV_W = ATT_KV_HEADS * HEAD_DIM
WINDOW = 128
ATT_BLOCK = 128
HG_VW = MIX_W - POOL_W - ATT_W
HG_HEADS = HG_VW // HEAD_DIM
HG_DK = HEAD_DIM
HG_DV = HEAD_DIM
HG_KW = HG_HEADS * HG_DK
HG_CHUNK = 64
IN_SIZES = (POOL_W, ATT_W, ATT_KV_W, ATT_KV_W, HG_KW, HG_KW, HG_KW, HG_VW, HG_VW)
IN_W = sum(IN_SIZES)
D_FF = 4 * D_MODEL
ROPE_BASE = 10000.0
EPS = 1e-6
NEG_BIG = -1e30

kernel_name = "hybrid_pool_swa_hgrn2_prefix_dit"


def rmsnorm(x, w):
    xf = x.astype(jnp.float32)
    y = xf * lax.rsqrt(jnp.mean(xf * xf, axis=-1, keepdims=True) + EPS)
    return (y * w.astype(jnp.float32)).astype(x.dtype)


def axial_rope_tables(n):
    rows_n = n // GRID_W
    row = jnp.repeat(jnp.arange(rows_n), GRID_W).astype(jnp.float32)
    col = jnp.tile(jnp.arange(GRID_W), rows_n).astype(jnp.float32)
    axis_dims = HEAD_DIM // 2
    inv = ROPE_BASE ** (-jnp.arange(0, axis_dims, 2, dtype=jnp.float32) / axis_dims)
    ar = row[:, None] * inv
    ac = col[:, None] * inv
    return (jnp.cos(ar), jnp.sin(ar), jnp.cos(ac), jnp.sin(ac))


def _rot_half(x, cos, sin):
    x1, x2 = jnp.split(x, 2, axis=-1)
    c = cos[:, None, :]
    s = sin[:, None, :]
    return jnp.concatenate([x1 * c - x2 * s, x2 * c + x1 * s], axis=-1)


def apply_axial_rope(x, tabs):
    cr, sr, cc, sc = tabs
    xr, xc = jnp.split(x, 2, axis=-1)
    return jnp.concatenate([_rot_half(xr, cr, sr), _rot_half(xc, cc, sc)], axis=-1).astype(x.dtype)


def split_in(z):
    idx = np.cumsum(IN_SIZES)[:-1].tolist()
    return jnp.split(z, idx, axis=-1)


def pool_mixer(u, pool_w, pool_scale):
    B, n, _ = u.shape
    uf = u.astype(jnp.float32)
    csum = jnp.concatenate([jnp.zeros_like(uf[:, :1]), jnp.cumsum(uf, axis=1)], axis=1)
    pos = jnp.arange(n)
    outs = []
    for g, w in enumerate(POOL_WINDOWS):
        lo = jnp.clip(pos - w // 2, 0, n)
        hi = jnp.clip(pos + w // 2, 0, n)
        cg = csum[..., g * POOL_GW:(g + 1) * POOL_GW]
        cnt = (hi - lo).astype(jnp.float32)[None, :, None]
        outs.append((cg[:, hi] - cg[:, lo]) / cnt)
    d = jnp.concatenate(outs, axis=-1) - uf
    d = d.reshape(B, n, len(POOL_WINDOWS), POOL_GW)
    y = jnp.einsum('bngc,gcd->bngd', d, pool_w.astype(jnp.float32)).reshape(B, n, POOL_W)
    return (y * pool_scale.astype(jnp.float32)).astype(u.dtype)


def softmax_with_sink(s, sink):
    sk = jnp.broadcast_to(sink.astype(jnp.float32)[:, :, None, None], s.shape[:-1] + (1,))
    p = jax.nn.softmax(jnp.concatenate([s, sk], axis=-1), axis=-1)
    return p[..., :-1]


def window_attention(q, k, v, kc, vc, sink):
    B, S = q.shape[:2]
    L = kc.shape[1]
    nb = S // ATT_BLOCK
    qb = q.reshape(B, nb, ATT_BLOCK, ATT_KV_HEADS, ATT_GROUP, HEAD_DIM)
    pad = ((0, 0), (ATT_BLOCK, ATT_BLOCK), (0, 0), (0, 0))
    kp = jnp.pad(k, pad)
    vp = jnp.pad(v, pad)

    def bands(a):
        return jnp.concatenate([a[:, i * ATT_BLOCK:i * ATT_BLOCK + S].reshape(B, nb, ATT_BLOCK, ATT_KV_HEADS, HEAD_DIM)
                                for i in range(3)], axis=2)

    kb, vb = bands(kp), bands(vp)
    scale = HEAD_DIM ** -0.5
    s_loc = jnp.einsum('bnqkgd,bnskd->bnkgqs', qb, kb).astype(jnp.float32) * scale
    s_ctx = jnp.einsum('bnqkgd,bskd->bnkgqs', qb, kc).astype(jnp.float32) * scale
    qpos = jnp.arange(S).reshape(nb, ATT_BLOCK)
    kpos = jnp.arange(nb)[:, None] * ATT_BLOCK - ATT_BLOCK + jnp.arange(3 * ATT_BLOCK)[None, :]
    valid = ((kpos[:, None, :] >= 0) & (kpos[:, None, :] < S)
             & (jnp.abs(qpos[:, :, None] - kpos[:, None, :]) <= WINDOW))
    s_loc = jnp.where(valid[None, :, None, None], s_loc, NEG_BIG)
    p = softmax_with_sink(jnp.concatenate([s_loc, s_ctx], axis=-1), sink.reshape(ATT_KV_HEADS, ATT_GROUP))
    nk = 3 * ATT_BLOCK
    p_loc = p[..., :nk].astype(v.dtype)
    p_ctx = p[..., nk:nk + L].astype(v.dtype)
    o = (jnp.einsum('bnkgqs,bnskd->bnqkgd', p_loc, vb)
         + jnp.einsum('bnkgqs,bskd->bnqkgd', p_ctx, vc))
    return o.reshape(B, S, ATT_W)


def context_attention(qc, kc, vc, sink):
    B, L = qc.shape[:2]
    qg = qc.reshape(B, L, ATT_KV_HEADS, ATT_GROUP, HEAD_DIM)
    s = jnp.einsum('blkgd,bskd->bkgls', qg, kc).astype(jnp.float32) * (HEAD_DIM ** -0.5)
    p = softmax_with_sink(s, sink.reshape(ATT_KV_HEADS, ATT_GROUP)).astype(vc.dtype)
    return jnp.einsum('bkgls,bskd->blkgd', p, vc).reshape(B, L, ATT_W)


def gla_chunk_scan(q, k, v, logf, s0):
    B, n, H, _ = q.shape
    nc = n // HG_CHUNK

    def to_chunks(a):
        return jnp.moveaxis(a.reshape(B, nc, HG_CHUNK, H, a.shape[-1]), 1, 0)

    tri = jnp.tril(jnp.ones((HG_CHUNK, HG_CHUNK), dtype=bool))[None, :, :, None, None]

    def step(S, inp):
        qc, kc, vc, gc = inp
        b = jnp.cumsum(gc, axis=1)
        diff = jnp.where(tri, b[:, :, None] - b[:, None, :], NEG_BIG)
        a = jnp.sum(qc[:, :, None] * kc[:, None] * jnp.exp(diff), axis=-1)
        o = jnp.einsum('btsh,bshv->bthv', a, vc) + jnp.einsum('bthk,bhkv->bthv', qc * jnp.exp(b), S)
        b_end = b[:, -1]
        S_new = (jnp.exp(b_end)[..., None] * S
                 + jnp.einsum('bshk,bshv->bhkv', kc * jnp.exp(b_end[:, None] - b), vc))
        return S_new, o

    s_fin, o = lax.scan(step, s0, (to_chunks(q), to_chunks(k), to_chunks(v), to_chunks(logf)))
    return jnp.moveaxis(o, 0, 1).reshape(B, n, H, v.shape[-1]), s_fin


def _heads(a):
    B, n = a.shape[:2]
    return a.astype(jnp.float32).reshape(B, n, HG_HEADS, -1)


def hgrn2_gates(f_pre, lb):
    lb = lb.astype(jnp.float32)
    f = lb + (1.0 - lb) * jax.nn.sigmoid(f_pre.astype(jnp.float32))
    return _heads(1.0 - f), _heads(jnp.log(f))


def hgrn2_mixer(q, ff, fb, i, g, cq, cff, cfb, ci, cg, lb_f, lb_b, norm_w, need_ctx):
    B = q.shape[0]
    s0 = jnp.zeros((B, HG_HEADS, HG_DK, HG_DV), jnp.float32)
    flip = lambda a: jnp.flip(a, axis=1)
    qh, vh = _heads(jax.nn.silu(q)), _heads(i)
    cqh, cvh = _heads(jax.nn.silu(cq)), _heads(ci)
    kf, gf = hgrn2_gates(ff, lb_f)
    ckf, cgf = hgrn2_gates(cff, lb_f)
    oc_f, sc_f = gla_chunk_scan(cqh, ckf, cvh, cgf, s0)
    o_f, _ = gla_chunk_scan(qh, kf, vh, gf, sc_f)
    kb, gb = hgrn2_gates(fb, lb_b)
    ckb, cgb = hgrn2_gates(cfb, lb_b)
    oc_b, sc_b = gla_chunk_scan(flip(cqh), flip(ckb), flip(cvh), flip(cgb), s0)
    o_b, _ = gla_chunk_scan(flip(qh), flip(kb), flip(vh), flip(gb), sc_b)

    def readout(o, gate):
        Bn, n = o.shape[:2]
        return (rmsnorm(o, norm_w).reshape(Bn, n, HG_VW) * jax.nn.silu(gate.astype(jnp.float32))).astype(gate.dtype)

    y = readout(o_f + flip(o_b), g)
    yc = readout(oc_f + flip(oc_b), cg) if need_ctx else None
    return y, yc


def token_mixer(h, hc, w_in, pool_w, pool_scale, sink, lb_f, lb_b, hg_norm_w, w_out, rope, need_ctx):
    B, S, _ = h.shape
    L = hc.shape[1]
    pa, qa, ka, va, qh, ff, fb, ih, gh = split_in(h @ w_in)
    cpa, cqa, cka, cva, cqh, cff, cfb, cih, cgh = split_in(hc @ w_in)
    ya = pool_mixer(pa, pool_w, pool_scale)
    q = apply_axial_rope(qa.reshape(B, S, ATT_HEADS, HEAD_DIM), rope)
    k = apply_axial_rope(ka.reshape(B, S, ATT_KV_HEADS, HEAD_DIM), rope)
    v = va.reshape(B, S, ATT_KV_HEADS, HEAD_DIM)
    kc = cka.reshape(B, L, ATT_KV_HEADS, HEAD_DIM)
    vc = cva.reshape(B, L, ATT_KV_HEADS, HEAD_DIM)
    yb = window_attention(q, k, v, kc, vc, sink)
    yc, ycc = hgrn2_mixer(qh, ff, fb, ih, gh, cqh, cff, cfb, cih, cgh, lb_f, lb_b, hg_norm_w, need_ctx)
    y = jnp.concatenate([ya, yb, yc], axis=-1) @ w_out
    if not need_ctx:
        return y, None
    yca = pool_mixer(cpa, pool_w, pool_scale)
    ycb = context_attention(cqa.reshape(B, L, ATT_HEADS, HEAD_DIM), kc, vc, sink)
    y_ctx = jnp.concatenate([yca, ycb, ycc], axis=-1) @ w_out
    return y, y_ctx


def sqrelu_mlp(h, w1, w2):
    return jnp.square(jax.nn.relu(h @ w1)) @ w2


def setup_inputs(seed: int = 0) -> dict:
    key = jax.random.key(seed)
    ks = jax.random.split(key, 20)
    nrm = lambda k, shape, s: jax.random.normal(k, shape, jnp.float32) * s
    return {
        'x': nrm(ks[0], (BATCH, SEQ, D_MODEL), 1.0),
        'c': nrm(ks[1], (BATCH, D_MODEL), 1.0),
        'ctx': nrm(ks[2], (BATCH, CTX_LEN, D_MODEL), 1.0),
        'c_ctx': nrm(ks[3], (D_MODEL,), 1.0),
        'w_ada': nrm(ks[4], (DEPTH, D_MODEL, 6 * D_MODEL), D_MODEL ** -0.5),
        'b_ada': nrm(ks[5], (DEPTH, 6 * D_MODEL), 0.02),
        'norm1_w': 1.0 + nrm(ks[6], (DEPTH, D_MODEL), 0.1),
        'w_in': nrm(ks[7], (DEPTH, D_MODEL, IN_W), D_MODEL ** -0.5),
        'pool_w': nrm(ks[8], (DEPTH, len(POOL_WINDOWS), POOL_GW, POOL_GW), POOL_GW ** -0.5),
        'pool_scale': 1.0 + nrm(ks[9], (DEPTH, POOL_W), 0.1),
        'attn_sink': nrm(ks[10], (DEPTH, ATT_HEADS), 0.5),
        'hg_lower': nrm(ks[11], (DEPTH, 2, HG_KW), 0.5),
        'hg_norm_w': 1.0 + nrm(ks[12], (DEPTH, HG_DV), 0.1),
        'w_out': nrm(ks[13], (DEPTH, MIX_W, D_MODEL), MIX_W ** -0.5),
        'norm2_w': 1.0 + nrm(ks[14], (DEPTH, D_MODEL), 0.1),
        'w_mlp1': nrm(ks[15], (DEPTH, D_MODEL, D_FF), D_MODEL ** -0.5),
        'w_mlp2': nrm(ks[16], (DEPTH, D_FF, D_MODEL), D_FF ** -0.5),
        'final_norm_w': 1.0 + nrm(ks[17], (D_MODEL,), 0.1),
    }


def reference(x, c, ctx, c_ctx, w_ada, b_ada, norm1_w, w_in, pool_w, pool_scale, attn_sink,
              hg_lower, hg_norm_w, w_out, norm2_w, w_mlp1, w_mlp2, final_norm_w):
    rope = axial_rope_tables(x.shape[1])
    lbs = jax.nn.softmax(hg_lower.astype(jnp.float32), axis=0)
    lbs = jnp.cumsum(lbs, axis=0) - lbs[0]
    sc_lat = jax.nn.silu(c)
    sc_ctx = jax.nn.silu(c_ctx)
    xc = ctx
    for l in range(DEPTH):
        need_ctx = l < DEPTH - 1
        m = (sc_lat @ w_ada[l] + b_ada[l])[:, None, :]
        mc = sc_ctx @ w_ada[l] + b_ada[l]
        sh1, s1, g1, sh2, s2, g2 = jnp.split(m, 6, axis=-1)
        csh1, cs1, cg1, csh2, cs2, cg2 = jnp.split(mc, 6, axis=-1)
        h = rmsnorm(x, norm1_w[l]) * (1.0 + s1) + sh1
        hc = rmsnorm(xc, norm1_w[l]) * (1.0 + cs1) + csh1
        y, y_ctx = token_mixer(h, hc, w_in[l], pool_w[l], pool_scale[l], attn_sink[l],
                               lbs[l, 0], lbs[l, 1], hg_norm_w[l], w_out[l], rope, need_ctx)
        x = x + g1 * y
        h = rmsnorm(x, norm2_w[l]) * (1.0 + s2) + sh2
        x = x + g2 * sqrelu_mlp(h, w_mlp1[l], w_mlp2[l])
        if need_ctx:
            xc = xc + cg1 * y_ctx
            hc = rmsnorm(xc, norm2_w[l]) * (1.0 + cs2) + csh2
            xc = xc + cg2 * sqrelu_mlp(hc, w_mlp1[l], w_mlp2[l])
    return rmsnorm(x, final_norm_w)
```

```cpp
#include <hip/hip_runtime.h>
#include <hip/hip_cooperative_groups.h>
#include <cstdio>
#include <cstdint>
namespace cg = cooperative_groups;
namespace pg8 {
#define PG8_LAS __attribute__((address_space(3)))
typedef unsigned short bf16_t;
typedef short bf16x8 __attribute__((ext_vector_type(8)));
typedef float f32x4 __attribute__((ext_vector_type(4)));
typedef unsigned u32x4 __attribute__((ext_vector_type(4)));
constexpr int BM = 256, BK = 64, HALF = 128, HTB = HALF * BK * 2  , STAGE_BYTES = 8 * HTB, NXCD = 8, WGM = 8;

__host__ __device__ __forceinline__ int lds_byte(int r, int c) { const int st = (r >> 4) * 2 + (c >> 5), rr = r & 15, cc = c & 31, ob = rr * 64 + cc * 2; return st * 1024 + (ob ^ (((ob >> 9) & 1) << 5)); }
__host__ __device__ __forceinline__ void stage_rc(int b, int& R, int& C) { const int st = b / 1024, sb = b % 1024, swz = sb ^ (((sb >> 9) & 1) << 5); R = (st >> 1) * 16 + swz / 64; C = (st & 1) * 32 + (swz % 64) / 2; }
__host__ __device__ __forceinline__ int perm32(int rho) { const int n = rho >> 4, i = rho & 15; return 8 * (i >> 2) + 4 * n + (i & 3); }

struct Unit { int pm, pn, ks; };
struct Gemm { const bf16_t* A; const bf16_t* Bt; int M, N, K, ld; };

struct StaticOrder {
    int nM, nN, nwg, G, c;
    __host__ __device__ void init(int M, int N, int G_, int c_) { nM = M / BM; nN = N / BM; nwg = nM * nN; G = G_; c = c_; }
    __host__ __device__ bool next(int i, Unit& u) const {
        const long L = (long)i * G + c; if (L >= nwg) return false;
        int wgid = (int)L; { const int q = nwg / NXCD, r = nwg % NXCD, xcd = wgid % NXCD, off = wgid / NXCD; wgid = (xcd < r ? xcd * (q + 1) : r * (q + 1) + (xcd - r) * q) + off; }
        const int nig = WGM * nN, gid = wgid / nig, fm = gid * WGM, gsz = (nM - fm) < WGM ? (nM - fm) : WGM;
        u.pm = fm + ((wgid % nig) % gsz); u.pn = (wgid % nig) / gsz; u.ks = 0; return true;
    }
    __device__ __forceinline__ void a_ready(const Unit&) const {}
    __device__ __forceinline__ void done(const Unit&) const {}
};
__device__ __forceinline__ unsigned cvt_pk_bf16(float lo, float hi) { unsigned r; asm volatile("v_cvt_pk_bf16_f32 %0, %1, %2" : "=v"(r) : "v"(lo), "v"(hi)); return r; }
typedef float f32x2 __attribute__((ext_vector_type(2)));
struct EpiBf {
    static constexpr bool PERM = true, AFTER_DRAIN = false;
    bf16_t* O; int ldc; int act;
    __device__ __forceinline__ void operator()(const f32x4 (&acc)[2][2][4][2], const Unit& u, int wr, int wc, int fr, int fq) const {
        const int row0 = u.pm * BM + wr * 64 + fr; const int col0 = u.pn * BM + wc * 32 + 8 * fq;
#pragma unroll
        for (int ai = 0; ai < 2; ++ai)
#pragma unroll
            for (int m = 0; m < 4; ++m) { bf16_t* rowp = O + (size_t)(row0 + ai * HALF + m * 16) * ldc + col0;
#pragma unroll
                for (int bj = 0; bj < 2; ++bj) { f32x4 v0 = acc[ai][bj][m][0], v1 = acc[ai][bj][m][1];
                    if (act) {
#pragma unroll
                        for (int e = 0; e < 4; ++e) { float a = fmaxf(v0[e], 0.f), b = fmaxf(v1[e], 0.f); v0[e] = a * a; v1[e] = b * b; } }
                    u32x4 w; w.x = cvt_pk_bf16(v0[0], v0[1]); w.y = cvt_pk_bf16(v0[2], v0[3]); w.z = cvt_pk_bf16(v1[0], v1[1]); w.w = cvt_pk_bf16(v1[2], v1[3]);
                    *(u32x4*)(rowp + bj * HALF) = w; } }
    }
};
struct EpiRes {
    static constexpr bool PERM = false, AFTER_DRAIN = false;
    const float* res_lat; const float* res_ctx; float* out_lat; float* out_ctx; const float* gate;
    __device__ __forceinline__ void operator()(const f32x4 (&acc)[2][2][4][2], const Unit& u, int wr, int wc, int fr, int fq) const {
        const bool lat = u.pm < 64;
        const float* res = lat ? res_lat + (size_t)u.pm * BM * 1024 : res_ctx + (size_t)(u.pm - 64) * BM * 1024;
        float* out = lat ? out_lat + (size_t)u.pm * BM * 1024 : out_ctx + (size_t)(u.pm - 64) * BM * 1024;
        const float* g = gate + (size_t)(lat ? (u.pm >> 3) : 8) * 6144;
        const int col0 = u.pn * BM + wc * 32 + 4 * fq;
        f32x4 gv[2][2];
#pragma unroll
        for (int bj = 0; bj < 2; ++bj)
#pragma unroll
            for (int n = 0; n < 2; ++n) gv[bj][n] = *(const f32x4*)(g + col0 + bj * HALF + n * 16);
#pragma unroll
        for (int ai = 0; ai < 2; ++ai)
#pragma unroll
            for (int m = 0; m < 4; ++m) { const size_t off = (size_t)(ai * HALF + wr * 64 + m * 16 + fr) * 1024 + col0;
#pragma unroll
                for (int bj = 0; bj < 2; ++bj)
#pragma unroll
                    for (int n = 0; n < 2; ++n) { const f32x4 r = *(const f32x4*)(res + off + bj * HALF + n * 16);
                        *(f32x4*)(out + off + bj * HALF + n * 16) = r + gv[bj][n] * acc[ai][bj][m][n]; } }
    }
};

struct SplitOrder {
    int pm0, npm, nN, nks, G, c;
    __device__ __forceinline__ bool next(int i, Unit& u) const { const int L = i * G + c; if (L >= npm * nN * nks) return false;
        u.ks = L % nks; const int t = L / nks; u.pn = t % nN; u.pm = pm0 + t / nN; return true; }
    __device__ __forceinline__ void a_ready(const Unit&) const {}
    __device__ __forceinline__ void done(const Unit&) const {}
};
struct EpiPart {
    static constexpr bool PERM = false, AFTER_DRAIN = false;
    float* xc; float* p1; float* p2; float* p3; const float* gate;
    __device__ __forceinline__ void operator()(const f32x4 (&acc)[2][2][4][2], const Unit& u, int wr, int wc, int fr, int fq) const {
        float* base = u.ks == 0 ? xc : (u.ks == 1 ? p1 : (u.ks == 2 ? p2 : p3));
        float* out = base + (size_t)(u.pm - 64) * BM * 1024;
        const bool inplace = u.ks == 0;
        const int col0 = u.pn * BM + wc * 32 + 4 * fq;
        f32x4 gv[2][2];
#pragma unroll
        for (int bj = 0; bj < 2; ++bj)
#pragma unroll
            for (int n = 0; n < 2; ++n) gv[bj][n] = *(const f32x4*)(gate + col0 + bj * HALF + n * 16);
#pragma unroll
        for (int ai = 0; ai < 2; ++ai)
#pragma unroll
            for (int m = 0; m < 4; ++m) { const size_t off = (size_t)(ai * HALF + wr * 64 + m * 16 + fr) * 1024 + col0;
#pragma unroll
                for (int bj = 0; bj < 2; ++bj)
#pragma unroll
                    for (int n = 0; n < 2; ++n) { f32x4 v = gv[bj][n] * acc[ai][bj][m][n]; float* p = out + off + bj * HALF + n * 16;
                        if (inplace) v = v + *(const f32x4*)p;
                        *(f32x4*)p = v; } }
    }
};

typedef unsigned epi_u32x2 __attribute__((ext_vector_type(2)));
struct EpiFinal {
    static constexpr bool PERM = false, AFTER_DRAIN = true;
    const float* res; float* out; const float* gate; const float* w; unsigned long long* slots; unsigned* cnt; float eps;
    __device__ __forceinline__ void operator()(const f32x4 (&)[2][2][4][2], const Unit&, int, int, int, int) const {}
    __device__ __forceinline__ void fused(f32x4 (&acc)[2][2][4][2], const Unit& u, int wr, int wc, int fr, int fq, PG8_LAS unsigned char* lds, int wid, int lane) const {
        const float* rs = res + (size_t)u.pm * BM * 1024; float* o = out + (size_t)u.pm * BM * 1024;
        const float* g = gate + (size_t)(u.pm >> 3) * 6144;
        const int col0 = u.pn * BM + wc * 32 + 4 * fq;
        PG8_LAS float* Pp = (PG8_LAS float*)lds;
        PG8_LAS float* Sr = (PG8_LAS float*)(lds + 4096);
        f32x4 gv[2][2];
#pragma unroll
        for (int bj = 0; bj < 2; ++bj)
#pragma unroll
            for (int n = 0; n < 2; ++n) gv[bj][n] = *(const f32x4*)(g + col0 + bj * HALF + n * 16);
#pragma unroll
        for (int ai = 0; ai < 2; ++ai)
#pragma unroll
            for (int m = 0; m < 4; ++m) { const int row = ai * HALF + wr * 64 + m * 16 + fr; const size_t off = (size_t)row * 1024 + col0; float s = 0.f;
#pragma unroll
                for (int bj = 0; bj < 2; ++bj)
#pragma unroll
                    for (int n = 0; n < 2; ++n) { const f32x4 r = *(const f32x4*)(rs + off + bj * HALF + n * 16); const f32x4 x = r + gv[bj][n] * acc[ai][bj][m][n]; acc[ai][bj][m][n] = x;
                        s += (x[0] * x[0] + x[1] * x[1]) + (x[2] * x[2] + x[3] * x[3]); }
                { const epi_u32x2 t = __builtin_amdgcn_permlane16_swap(__float_as_uint(s), __float_as_uint(s), false, false); s = __uint_as_float(t.x) + __uint_as_float(t.y); }
                { const epi_u32x2 t = __builtin_amdgcn_permlane32_swap(__float_as_uint(s), __float_as_uint(s), false, false); s = __uint_as_float(t.x) + __uint_as_float(t.y); }
                if (fq == 0) Pp[row * 4 + wc] = s; }
        asm volatile("s_waitcnt lgkmcnt(0)" ::: "memory"); __builtin_amdgcn_s_barrier(); asm volatile("" ::: "memory");
        const int tid = wid * 64 + lane;
        if (tid < 256) { const f32x4 p = *(const PG8_LAS f32x4*)(Pp + tid * 4); const float tot = (p[0] + p[1]) + (p[2] + p[3]);
            __hip_atomic_store(slots + ((size_t)(u.pm * 4 + u.pn) * 256 + tid), (unsigned long long)__float_as_uint(tot) | (1ull << 32), __ATOMIC_RELAXED, __HIP_MEMORY_SCOPE_AGENT); }
        asm volatile("s_waitcnt vmcnt(0)" ::: "memory"); __builtin_amdgcn_s_barrier(); asm volatile("" ::: "memory");
        if (tid == 0) { __hip_atomic_fetch_add(cnt + 64 * u.pm, 1u, __ATOMIC_RELAXED, __HIP_MEMORY_SCOPE_AGENT);
            unsigned sp = 0; while (__hip_atomic_load(cnt + 64 * u.pm, __ATOMIC_RELAXED, __HIP_MEMORY_SCOPE_AGENT) < 4u) { __builtin_amdgcn_s_sleep(1); if (++sp > (1u << 20)) break; } }
        asm volatile("s_waitcnt vmcnt(0) lgkmcnt(0)" ::: "memory"); __builtin_amdgcn_s_barrier(); asm volatile("" ::: "memory");
        if (tid < 256) { float tot = 0.f;
#pragma unroll
            for (int t = 0; t < 4; ++t) tot += __uint_as_float((unsigned)__hip_atomic_load(slots + ((size_t)(u.pm * 4 + t) * 256 + tid), __ATOMIC_RELAXED, __HIP_MEMORY_SCOPE_AGENT));
            Sr[tid] = 1.0f / sqrtf(tot * (1.0f / 1024.0f) + eps); }
        asm volatile("s_waitcnt vmcnt(0) lgkmcnt(0)" ::: "memory"); __builtin_amdgcn_s_barrier(); asm volatile("" ::: "memory");
        f32x4 wv[2][2];
#pragma unroll
        for (int bj = 0; bj < 2; ++bj)
#pragma unroll
            for (int n = 0; n < 2; ++n) wv[bj][n] = *(const f32x4*)(w + col0 + bj * HALF + n * 16);
#pragma unroll
        for (int ai = 0; ai < 2; ++ai)
#pragma unroll
            for (int m = 0; m < 4; ++m) { const int row = ai * HALF + wr * 64 + m * 16 + fr; const size_t off = (size_t)row * 1024 + col0; const float rstd = Sr[row];
#pragma unroll
                for (int bj = 0; bj < 2; ++bj)
#pragma unroll
                    for (int n = 0; n < 2; ++n) *(f32x4*)(o + off + bj * HALF + n * 16) = acc[ai][bj][m][n] * rstd * wv[bj][n]; }
        asm volatile("s_waitcnt lgkmcnt(0)" ::: "memory"); __builtin_amdgcn_s_barrier(); asm volatile("" ::: "memory");
    }
};

struct EpiNorm2 {
    static constexpr bool PERM = false, AFTER_DRAIN = true;
    const float* res; float* out; const float* gate; const float* nw; const float* ms; const float* msh; bf16_t* hb; unsigned long long* slots; unsigned* cnt; float eps; int pm_sub; int mrow_c;
    __device__ __forceinline__ void operator()(const f32x4 (&)[2][2][4][2], const Unit&, int, int, int, int) const {}
    __device__ __forceinline__ void fused(f32x4 (&acc)[2][2][4][2], const Unit& u, int wr, int wc, int fr, int fq, PG8_LAS unsigned char* lds, int wid, int lane) const {
        const int pl = u.pm - pm_sub;
        const float* rs = res + (size_t)pl * BM * 1024; float* o = out + (size_t)pl * BM * 1024; bf16_t* hp = hb + (size_t)u.pm * BM * 1024;
        const size_t mrow = (size_t)(mrow_c >= 0 ? mrow_c : (u.pm >> 3)) * 6144;
        const int col0 = u.pn * BM + wc * 32 + 4 * fq;
        PG8_LAS float* Pp = (PG8_LAS float*)lds;
        PG8_LAS float* Sr = (PG8_LAS float*)(lds + 4096);
        f32x4 gv[2][2];
#pragma unroll
        for (int bj = 0; bj < 2; ++bj)
#pragma unroll
            for (int n = 0; n < 2; ++n) gv[bj][n] = *(const f32x4*)(gate + mrow + col0 + bj * HALF + n * 16);
#pragma unroll
        for (int ai = 0; ai < 2; ++ai)
#pragma unroll
            for (int m = 0; m < 4; ++m) { const int row = ai * HALF + wr * 64 + m * 16 + fr; const size_t off = (size_t)row * 1024 + col0; float s = 0.f;
#pragma unroll
                for (int bj = 0; bj < 2; ++bj)
#pragma unroll
                    for (int n = 0; n < 2; ++n) { const f32x4 r = *(const f32x4*)(rs + off + bj * HALF + n * 16); const f32x4 x = r + gv[bj][n] * acc[ai][bj][m][n]; acc[ai][bj][m][n] = x;
                        *(f32x4*)(o + off + bj * HALF + n * 16) = x;
                        s += (x[0] * x[0] + x[1] * x[1]) + (x[2] * x[2] + x[3] * x[3]); }
                { const epi_u32x2 t = __builtin_amdgcn_permlane16_swap(__float_as_uint(s), __float_as_uint(s), false, false); s = __uint_as_float(t.x) + __uint_as_float(t.y); }
                { const epi_u32x2 t = __builtin_amdgcn_permlane32_swap(__float_as_uint(s), __float_as_uint(s), false, false); s = __uint_as_float(t.x) + __uint_as_float(t.y); }
                if (fq == 0) Pp[row * 4 + wc] = s; }
        asm volatile("s_waitcnt lgkmcnt(0)" ::: "memory"); __builtin_amdgcn_s_barrier(); asm volatile("" ::: "memory");
        const int tid = wid * 64 + lane;
        if (tid < 256) { const f32x4 p = *(const PG8_LAS f32x4*)(Pp + tid * 4); const float tot = (p[0] + p[1]) + (p[2] + p[3]);
            __hip_atomic_store(slots + ((size_t)(pl * 4 + u.pn) * 256 + tid), (unsigned long long)__float_as_uint(tot) | (1ull << 32), __ATOMIC_RELAXED, __HIP_MEMORY_SCOPE_AGENT); }
        asm volatile("s_waitcnt vmcnt(0)" ::: "memory"); __builtin_amdgcn_s_barrier(); asm volatile("" ::: "memory");
        if (tid == 0) { __hip_atomic_fetch_add(cnt + 64 * pl, 1u, __ATOMIC_RELAXED, __HIP_MEMORY_SCOPE_AGENT);
            unsigned sp = 0; while (__hip_atomic_load(cnt + 64 * pl, __ATOMIC_RELAXED, __HIP_MEMORY_SCOPE_AGENT) < 4u) { __builtin_amdgcn_s_sleep(1); if (++sp > (1u << 20)) break; } }
        asm volatile("s_waitcnt vmcnt(0) lgkmcnt(0)" ::: "memory"); __builtin_amdgcn_s_barrier(); asm volatile("" ::: "memory");
        if (tid < 256) { float tot = 0.f;
#pragma unroll
            for (int t = 0; t < 4; ++t) tot += __uint_as_float((unsigned)__hip_atomic_load(slots + ((size_t)(pl * 4 + t) * 256 + tid), __ATOMIC_RELAXED, __HIP_MEMORY_SCOPE_AGENT));
            Sr[tid] = 1.0f / sqrtf(tot * (1.0f / 1024.0f) + eps); }
        asm volatile("s_waitcnt vmcnt(0) lgkmcnt(0)" ::: "memory"); __builtin_amdgcn_s_barrier(); asm volatile("" ::: "memory");
        f32x4 cv[2][2], hv[2][2];
#pragma unroll
        for (int bj = 0; bj < 2; ++bj)
#pragma unroll
            for (int n = 0; n < 2; ++n) { const int c = col0 + bj * HALF + n * 16; cv[bj][n] = *(const f32x4*)(nw + c) * (1.0f + *(const f32x4*)(ms + mrow + c)); hv[bj][n] = *(const f32x4*)(msh + mrow + c); }
#pragma unroll
        for (int ai = 0; ai < 2; ++ai)
#pragma unroll
            for (int m = 0; m < 4; ++m) { const int row = ai * HALF + wr * 64 + m * 16 + fr; const size_t off = (size_t)row * 1024 + col0; const float rstd = Sr[row];
#pragma unroll
                for (int bj = 0; bj < 2; ++bj)
#pragma unroll
                    for (int n = 0; n < 2; ++n) { const f32x4 h = acc[ai][bj][m][n] * rstd * cv[bj][n] + hv[bj][n];
                        epi_u32x2 pk; pk.x = cvt_pk_bf16(h[0], h[1]); pk.y = cvt_pk_bf16(h[2], h[3]); *(epi_u32x2*)(hp + off + bj * HALF + n * 16) = pk; } }
        asm volatile("s_waitcnt lgkmcnt(0)" ::: "memory"); __builtin_amdgcn_s_barrier(); asm volatile("" ::: "memory");
    }
};
template <class Epi, class Sched, bool ALIGN_EPI = false, bool SP2 = false>
__device__ __forceinline__ void gemm_phase(PG8_LAS unsigned char* lds, const Gemm g, const Sched& S, const Epi& E) {
    int tid_o = threadIdx.x; asm volatile("" : "+v"(tid_o));
    const int tid = tid_o, wid = __builtin_amdgcn_readfirstlane(tid >> 6), lane = tid & 63, wr = wid >> 2, wc = wid & 3, fr = lane & 15, fq = lane >> 4;
    const int K = g.K, nt = K / BK;
    unsigned voffA[2], voffB[2];
#pragma unroll
    for (int i = 0; i < 2; ++i) { int R, C; stage_rc(tid * 16 + i * 8192, R, C); const int Rb = Epi::PERM ? ((R & ~31) + perm32(R & 31)) : R;
        voffA[i] = (unsigned)(R * g.ld + C) * 2u; voffB[i] = (unsigned)(Rb * g.ld + C) * 2u; }
    const size_t kstep = (size_t)(BK * 2);
    const size_t hstep = (size_t)HALF * g.ld * 2;
    const size_t tstep = 2 * hstep;
    const unsigned ldsw = (unsigned)wid * 1024u;
    const int aoff = lds_byte(wr * 64 + fr, fq * 8), boff = lds_byte(wc * 32 + fr, fq * 8);
#define PG8_SA(b, h) (((b) * 2 + (h)) * HTB)
#define PG8_SB(b, h) ((4 + (b) * 2 + (h)) * HTB)
#define PG8_STAGE(bufoff, gbase, voff) do { _Pragma("unroll") for (int _i = 0; _i < 2; ++_i) \
        __builtin_amdgcn_global_load_lds((const unsigned*)((const char*)(gbase) + (voff)[_i]), (PG8_LAS unsigned*)(lds + (bufoff) + ldsw + _i * 8192), 16, 0, 0); } while (0)
#define PG8_LDA(dst, b, h) do { _Pragma("unroll") for (int m = 0; m < 4; ++m) _Pragma("unroll") for (int k = 0; k < 2; ++k) dst[m][k] = *(const PG8_LAS bf16x8*)(lds + PG8_SA(b, h) + aoff + m * 2048 + k * 1024); } while (0)
#define PG8_LDB(dst, b, h) do { _Pragma("unroll") for (int n = 0; n < 2; ++n) _Pragma("unroll") for (int k = 0; k < 2; ++k) dst[n][k] = *(const PG8_LAS bf16x8*)(lds + PG8_SB(b, h) + boff + n * 2048 + k * 1024); } while (0)
#define PG8_MMA(ai, bj, At, Bt) do { __builtin_amdgcn_s_setprio(1); _Pragma("unroll") for (int m = 0; m < 4; ++m) _Pragma("unroll") for (int n = 0; n < 2; ++n) _Pragma("unroll") for (int k = 0; k < 2; ++k) \
        acc[ai][bj][m][n] = __builtin_amdgcn_mfma_f32_16x16x32_bf16(Bt[n][k], At[m][k], acc[ai][bj][m][n], 0, 0, 0); __builtin_amdgcn_s_setprio(0); } while (0)
#define PG8_WAIT_V(n) asm volatile("s_waitcnt vmcnt(" #n ")" ::: "memory")
#define PG8_WAIT_L(n) asm volatile("s_waitcnt lgkmcnt(" #n ")" ::: "memory")
#define PG8_BAR __builtin_amdgcn_s_barrier()
#define PG8_SCHED __builtin_amdgcn_sched_barrier(0)
    Unit cur, nxt; int ui = 0;
    if (!S.next(0, cur)) return;
    f32x4 acc[2][2][4][2];
#pragma unroll
    for (int a = 0; a < 2; ++a)
#pragma unroll
        for (int b = 0; b < 2; ++b)
#pragma unroll
            for (int m = 0; m < 4; ++m)
#pragma unroll
                for (int n = 0; n < 2; ++n) acc[a][b][m][n] = (f32x4){0.f, 0.f, 0.f, 0.f};
    bf16x8 At[4][2], B0[2][2], B1[2][2];
    const char* cA = (const char*)g.A + (size_t)cur.pm * tstep + (size_t)cur.ks * K * 2; const char* cB = (const char*)g.Bt + (size_t)cur.pn * tstep + (size_t)cur.ks * K * 2;
    S.a_ready(cur);
    if constexpr (SP2) {
        PG8_STAGE(PG8_SB(0, 0), cB, voffB); PG8_STAGE(PG8_SB(0, 1), cB + hstep, voffB); PG8_STAGE(PG8_SA(0, 0), cA, voffA); PG8_STAGE(PG8_SA(0, 1), cA + hstep, voffA);
        if (wr == 1) PG8_BAR;
        PG8_WAIT_V(2); PG8_BAR;
        PG8_STAGE(PG8_SB(1, 0), cB + kstep, voffB); PG8_STAGE(PG8_SA(1, 0), cA + kstep, voffA); PG8_STAGE(PG8_SB(1, 1), cB + hstep + kstep, voffB);
        PG8_WAIT_V(6); PG8_BAR;
    } else {
        PG8_STAGE(PG8_SB(0, 0), cB, voffB); PG8_STAGE(PG8_SA(0, 0), cA, voffA); PG8_STAGE(PG8_SB(0, 1), cB + hstep, voffB); PG8_STAGE(PG8_SA(0, 1), cA + hstep, voffA);
        if (wr == 1) PG8_BAR;
        PG8_WAIT_V(4); PG8_BAR;
        PG8_STAGE(PG8_SB(1, 0), cB + kstep, voffB); PG8_STAGE(PG8_SA(1, 0), cA + kstep, voffA); PG8_STAGE(PG8_SB(1, 1), cB + hstep + kstep, voffB);
        PG8_WAIT_V(6); PG8_BAR;
    }
    for (;;) {
        const bool has_next = S.next(ui + 1, nxt);
        const char* nA = has_next ? (const char*)g.A + (size_t)nxt.pm * tstep + (size_t)nxt.ks * K * 2 : cA; const char* nB = has_next ? (const char*)g.Bt + (size_t)nxt.pn * tstep + (size_t)nxt.ks * K * 2 : cB;
        for (int t = 0; t < nt; t += 2) {
            const bool last = (t == nt - 2);
            const char* a1 = cA + (size_t)(t + 1) * kstep;
            const char* a2 = last ? nA : cA + (size_t)(t + 2) * kstep; const char* b2 = last ? nB : cB + (size_t)(t + 2) * kstep;
            const char* a3 = a2 + kstep; const char* b3 = b2 + kstep;
            if (last && has_next) S.a_ready(nxt);
            if constexpr (SP2) {
            PG8_LDB(B0, 0, 0); PG8_LDB(B1, 0, 1); PG8_SCHED; PG8_LDA(At, 0, 0); PG8_STAGE(PG8_SA(1, 1), a1 + hstep, voffA);
            PG8_WAIT_V(8); PG8_WAIT_L(0); PG8_BAR; PG8_MMA(0, 0, At, B0); PG8_MMA(0, 1, At, B1); PG8_BAR; PG8_SCHED;
            PG8_LDA(At, 0, 1); PG8_STAGE(PG8_SB(0, 0), b2, voffB); PG8_STAGE(PG8_SB(0, 1), b2 + hstep, voffB); PG8_STAGE(PG8_SA(0, 0), a2, voffA);
            PG8_WAIT_V(8); PG8_WAIT_L(0); PG8_BAR; PG8_MMA(1, 0, At, B0); PG8_MMA(1, 1, At, B1); PG8_BAR; PG8_SCHED;
            PG8_LDB(B0, 1, 0); PG8_LDB(B1, 1, 1); PG8_SCHED; PG8_LDA(At, 1, 0); PG8_STAGE(PG8_SA(0, 1), a2 + hstep, voffA);
            PG8_WAIT_V(8); PG8_WAIT_L(0); PG8_BAR; PG8_MMA(0, 0, At, B0); PG8_MMA(0, 1, At, B1); PG8_BAR; PG8_SCHED;
            PG8_LDA(At, 1, 1); PG8_STAGE(PG8_SB(1, 0), b3, voffB); PG8_STAGE(PG8_SB(1, 1), b3 + hstep, voffB); PG8_STAGE(PG8_SA(1, 0), a3, voffA);
            PG8_WAIT_V(8); PG8_WAIT_L(0); PG8_BAR; PG8_MMA(1, 0, At, B0); PG8_MMA(1, 1, At, B1); PG8_BAR; PG8_SCHED;
            } else {
            PG8_LDB(B0, 0, 0); PG8_SCHED; PG8_LDA(At, 0, 0); PG8_STAGE(PG8_SA(1, 1), a1 + hstep, voffA);
            PG8_WAIT_L(8); PG8_BAR; PG8_WAIT_L(0); PG8_MMA(0, 0, At, B0); PG8_BAR; PG8_SCHED;
            PG8_LDB(B1, 0, 1); PG8_STAGE(PG8_SB(0, 0), b2, voffB);
            PG8_BAR; PG8_WAIT_L(0); PG8_MMA(0, 1, At, B1); PG8_BAR;
            PG8_LDA(At, 0, 1); PG8_STAGE(PG8_SA(0, 0), a2, voffA);
            PG8_BAR; PG8_WAIT_L(0); PG8_MMA(1, 0, At, B0); PG8_BAR; PG8_SCHED;
            PG8_STAGE(PG8_SB(0, 1), b2 + hstep, voffB);
            PG8_WAIT_V(6); PG8_BAR; PG8_MMA(1, 1, At, B1); PG8_BAR;
            PG8_LDB(B0, 1, 0); PG8_SCHED; PG8_LDA(At, 1, 0); PG8_STAGE(PG8_SA(0, 1), a2 + hstep, voffA);
            PG8_WAIT_L(8); PG8_BAR; PG8_WAIT_L(0); PG8_MMA(0, 0, At, B0); PG8_BAR; PG8_SCHED;
            PG8_LDB(B1, 1, 1); PG8_STAGE(PG8_SB(1, 0), b3, voffB);
            PG8_BAR; PG8_WAIT_L(0); PG8_MMA(0, 1, At, B1); PG8_BAR;
            PG8_LDA(At, 1, 1); PG8_STAGE(PG8_SA(1, 0), a3, voffA);
            PG8_BAR; PG8_WAIT_L(0); PG8_MMA(1, 0, At, B0); PG8_BAR; PG8_SCHED;
            PG8_STAGE(PG8_SB(1, 1), b3 + hstep, voffB);
            PG8_WAIT_V(6); PG8_BAR; PG8_MMA(1, 1, At, B1); PG8_BAR;
            }
        }
        if constexpr (ALIGN_EPI) { if (wr == 0) PG8_BAR; }
        if constexpr (!Epi::AFTER_DRAIN) { E(acc, cur, wr, wc, fr, fq); S.done(cur); }
        if (!has_next) break;
#pragma unroll
        for (int a = 0; a < 2; ++a)
#pragma unroll
            for (int b = 0; b < 2; ++b)
#pragma unroll
                for (int m = 0; m < 4; ++m)
#pragma unroll
                    for (int n = 0; n < 2; ++n) acc[a][b][m][n] = (f32x4){0.f, 0.f, 0.f, 0.f};
        cur = nxt; cA = nA; cB = nB; ++ui;
        if constexpr (ALIGN_EPI) { if (wr == 1) PG8_BAR; }
    }
    PG8_WAIT_V(0);
    if constexpr (!ALIGN_EPI) { if (wr == 0) PG8_BAR; }
    PG8_BAR;
    if constexpr (Epi::AFTER_DRAIN) { E.fused(acc, cur, wr, wc, fr, fq, lds, wid, lane); S.done(cur); }
#undef PG8_SA
#undef PG8_SB
#undef PG8_STAGE
#undef PG8_LDA
#undef PG8_LDB
#undef PG8_MMA
#undef PG8_WAIT_V
#undef PG8_WAIT_L
#undef PG8_BAR
#undef PG8_SCHED
}
}

#define LAS __attribute__((address_space(3)))
typedef unsigned short bf16;
typedef float f32x4 __attribute__((ext_vector_type(4)));
typedef short bf16x8 __attribute__((ext_vector_type(8)));
typedef unsigned u32x4 __attribute__((ext_vector_type(4)));
typedef unsigned u32x2 __attribute__((ext_vector_type(2)));
typedef float f32x2 __attribute__((ext_vector_type(2)));

constexpr int DM = 1024, NB = 8, SEQ = 2048, CTXL = 256;
constexpr int ML = NB * SEQ, MC = NB * CTXL, MT = ML + MC;
constexpr int INW = 2304, DFF = 4096;
constexpr int ZP = 0, ZQ = 256, ZK = 768, ZV = 896, ZHQ = 1024, ZFF = 1280, ZFB = 1536, ZHI = 1792, ZHG = 2048;
constexpr int NTHREADS = 512;
constexpr int LDS_BYTES = 147456;
constexpr float EPSN = 1e-6f;

constexpr size_t MiB = 1u << 20;
constexpr size_t WS_WT = 0;
constexpr size_t WT_LAYER = 22 * MiB + MiB / 2, WT_IN = 0, WT_OUT = 4 * MiB + MiB / 2, WT_W1 = 6 * MiB + MiB / 2, WT_W2 = 14 * MiB + MiB / 2;
constexpr size_t WS_XC = 45 * MiB;
constexpr size_t WS_ACT = 53 * MiB;
constexpr size_t WS_Z = 89 * MiB;
constexpr size_t WS_S = 170 * MiB;
constexpr size_t WS_HH = 89 * MiB;
constexpr size_t WS_MOD = 233 * MiB;
constexpr size_t WS_ROPE = WS_MOD + 512 * 1024;
constexpr size_t WS_LB = WS_ROPE + 16 * 1024;
constexpr size_t WS_DEC = WS_LB + 16 * 1024;
constexpr size_t WS_CTL = 234 * MiB + 512 * 1024;
constexpr size_t CTL_BYTES = 90112;
constexpr size_t WS_PWT = 234 * MiB + 768 * 1024;
constexpr size_t WS_P1 = 0, WS_P2 = 235 * MiB, WS_P3 = 243 * MiB;
constexpr size_t WS_FSLOT = 251 * MiB;
constexpr size_t WS_END = 254 * MiB;
static_assert(WS_DEC + 2304 * 64 * 4 <= WS_CTL && WS_CTL + CTL_BYTES <= WS_PWT && WS_PWT + 65536 <= WS_P2, "ws map");

struct Params {
    const float *x, *c, *ctx, *c_ctx, *w_ada, *b_ada, *norm1_w, *w_in, *pool_w, *pool_scale, *attn_sink, *hg_lower, *hg_norm_w, *w_out, *norm2_w, *w_mlp1, *w_mlp2, *final_norm_w;
    float* out; unsigned char* ws; int ph_lo, ph_hi;
};

__device__ __forceinline__ int otid() { int t = threadIdx.x; asm volatile("" : "+v"(t)); return t; }
__device__ __forceinline__ float bf2f(unsigned u) { return __uint_as_float(u << 16); }
__device__ __forceinline__ unsigned f2bf(float f) { unsigned u = __float_as_uint(f); return (u + 0x7fffu + ((u >> 16) & 1u)) >> 16; }
__device__ __forceinline__ unsigned pk2(float lo, float hi) { return pg8::cvt_pk_bf16(lo, hi); }
__device__ __forceinline__ float xmax16(float v) { const u32x2 r = __builtin_amdgcn_permlane16_swap(__float_as_uint(v), __float_as_uint(v), false, false); return fmaxf(__uint_as_float(r.x), __uint_as_float(r.y)); }
__device__ __forceinline__ float xmax32(float v) { const u32x2 r = __builtin_amdgcn_permlane32_swap(__float_as_uint(v), __float_as_uint(v), false, false); return fmaxf(__uint_as_float(r.x), __uint_as_float(r.y)); }
__device__ __forceinline__ float xsum16(float v) { const u32x2 r = __builtin_amdgcn_permlane16_swap(__float_as_uint(v), __float_as_uint(v), false, false); return __uint_as_float(r.x) + __uint_as_float(r.y); }
__device__ __forceinline__ float xsum32(float v) { const u32x2 r = __builtin_amdgcn_permlane32_swap(__float_as_uint(v), __float_as_uint(v), false, false); return __uint_as_float(r.x) + __uint_as_float(r.y); }
#define DPP_F(v, ctrl) __uint_as_float((unsigned)__builtin_amdgcn_update_dpp(0, (int)__float_as_uint(v), (ctrl), 0xF, 0xF, false))
__device__ __forceinline__ float wave_sum(float v) {
    v += DPP_F(v, 0xB1);
    v += DPP_F(v, 0x4E);
    v += DPP_F(v, 0x141);
    v += DPP_F(v, 0x140);
    return xsum32(xsum16(v));
}
__device__ __forceinline__ float rcpf_(float x) { return __builtin_amdgcn_rcpf(x); }
__device__ __forceinline__ float siluf(float x) { return x * rcpf_(1.f + __expf(-x)); }
__device__ __forceinline__ float bfe(const u32x4& v, int j) { const unsigned w = v[j >> 1]; return (j & 1) ? __uint_as_float(w & 0xffff0000u) : __uint_as_float(w << 16); }

__device__ __forceinline__ f32x4 mma16(const LAS bf16* A, int lda, const LAS bf16* Bt, int ldb, int K, f32x4 acc, int lane) {
    const int r = lane & 15, q = lane >> 4;
    for (int k0 = 0; k0 < K; k0 += 32) {
        const bf16x8 a = *(const LAS bf16x8*)(A + r * lda + k0 + q * 8);
        const bf16x8 b = *(const LAS bf16x8*)(Bt + r * ldb + k0 + q * 8);
        acc = __builtin_amdgcn_mfma_f32_16x16x32_bf16(a, b, acc, 0, 0, 0);
    }
    return acc;
}

__device__ __forceinline__ void transpose_item(const float* W, int K, int N, bf16* WT, LAS float* scr, int item, int lane) {
    const int nblk = N / 32, kb = item / nblk, nb = item % nblk, k0 = 64 * kb, n0 = 32 * nb;
    float tv[32];
#pragma unroll
    for (int i = 0; i < 32; ++i) tv[i] = W[(size_t)(k0 + 2 * i + (lane >> 5)) * N + n0 + (lane & 31)];
#pragma unroll
    for (int i = 0; i < 32; ++i) scr[(2 * i + (lane >> 5)) * 33 + (lane & 31)] = tv[i];
    asm volatile("s_waitcnt lgkmcnt(0)" ::: "memory");
    const int c = lane & 7;
#pragma unroll
    for (int j = 0; j < 4; ++j) { const int n = (lane >> 3) + 8 * j; const LAS float* s = scr + (8 * c) * 33 + n;
        u32x4 o; o.x = pk2(s[0 * 33], s[1 * 33]); o.y = pk2(s[2 * 33], s[3 * 33]); o.z = pk2(s[4 * 33], s[5 * 33]); o.w = pk2(s[6 * 33], s[7 * 33]);
        *(u32x4*)(WT + (size_t)(n0 + n) * K + k0 + 8 * c) = o; }
    asm volatile("s_waitcnt lgkmcnt(0)" ::: "memory");
}

__device__ __forceinline__ void convert_weights(const Params& P, LAS unsigned char* lds, int l, int gw, int NGW, int wave, int lane, int item_lo, int item_hi) {
    LAS float* scr = (LAS float*)(lds + wave * 8448);
    constexpr int I_IN = 16 * 72, I_OUT = 16 * 32, I_1 = 16 * 128, I_2 = 64 * 32, I_L = I_IN + I_OUT + I_1 + I_2;
    unsigned char* wt = P.ws + WS_WT + (size_t)l * WT_LAYER;
    for (int it = item_lo + gw; it < item_hi; it += NGW) {
        int r = it;
        if (r < I_IN) { transpose_item(P.w_in + (size_t)l * DM * INW, DM, INW, (bf16*)(wt + WT_IN), scr, r, lane); continue; } r -= I_IN;
        if (r < I_OUT) { transpose_item(P.w_out + (size_t)l * DM * DM, DM, DM, (bf16*)(wt + WT_OUT), scr, r, lane); continue; } r -= I_OUT;
        if (r < I_1) { transpose_item(P.w_mlp1 + (size_t)l * DM * DFF, DM, DFF, (bf16*)(wt + WT_W1), scr, r, lane); continue; } r -= I_1;
        transpose_item(P.w_mlp2 + (size_t)l * DFF * DM, DFF, DM, (bf16*)(wt + WT_W2), scr, r, lane);
    }
}

__device__ __forceinline__ void ph_prologue(const Params& P, LAS unsigned char* lds) {
    const int tid = otid(), lane = tid & 63, wave = __builtin_amdgcn_readfirstlane(tid >> 6);
    unsigned char* ws = P.ws;
    {
        const int gt = blockIdx.x * NTHREADS + tid, nt = gridDim.x * NTHREADS;
        float2* rope = (float2*)(ws + WS_ROPE);
        for (int i = gt; i < 64 * 16; i += nt) { const int p = i >> 4, f = i & 15;
            const float inv = exp2f(-(float)f * (13.287712379549449f / 16.0f));
            const float a = (float)p * inv; rope[i] = make_float2(__cosf(a), __sinf(a)); }
        bf16* PWT = (bf16*)(ws + WS_PWT);
        for (int i = gt; i < 2 * 4 * 64 * 64; i += nt) { const int lg = i >> 12, d = (i >> 6) & 63, c = i & 63; PWT[i] = (bf16)f2bf(P.pool_w[(size_t)(lg * 64 + c) * 64 + d]); }
        float* LB = (float*)(ws + WS_LB);
        for (int i = gt; i < 512; i += nt) { const float h0 = P.hg_lower[i], h1 = P.hg_lower[512 + i];
            LB[i] = 0.f; LB[512 + i] = 1.f / (1.f + __expf(h0 - h1)); }
    }
    if (blockIdx.x < 192) {
        LAS float* sc = (LAS float*)lds;
        LAS float* red = (LAS float*)(lds + 36864);
        for (int i = tid; i < 9 * 1024; i += NTHREADS) { const int r = i >> 10, k = i & 1023; const float v = r < 8 ? P.c[r * 1024 + k] : P.c_ctx[k]; sc[i] = siluf(v); }
        __syncthreads();
        float* MOD = (float*)(ws + WS_MOD);
        for (int u = blockIdx.x; u < 192; u += gridDim.x) {
            const int l = u / 96, n0 = (u % 96) * 64;
            const float* W = P.w_ada + (size_t)l * 1024 * 6144 + n0 + lane;
            float acc[9];
#pragma unroll
            for (int r = 0; r < 9; ++r) acc[r] = 0.f;
#pragma unroll 1
            for (int kb = 128 * wave; kb < 128 * wave + 128; kb += 32) { float wv[32];
#pragma unroll
                for (int i = 0; i < 32; ++i) wv[i] = W[(size_t)(kb + i) * 6144];
#pragma unroll
                for (int i = 0; i < 32; ++i) {
#pragma unroll
                    for (int r = 0; r < 9; ++r) acc[r] += sc[r * 1024 + kb + i] * wv[i]; } }
#pragma unroll
            for (int r = 0; r < 9; ++r) red[(wave * 9 + r) * 64 + lane] = acc[r];
            __syncthreads();
            for (int i = tid; i < 576; i += NTHREADS) { const int r = i >> 6, cc = i & 63; float s = P.b_ada[l * 6144 + n0 + cc];
#pragma unroll
                for (int w = 0; w < 8; ++w) s += red[(w * 9 + r) * 64 + cc];
                MOD[(size_t)(l * 9 + r) * 6144 + n0 + cc] = s; }
            __syncthreads();
        }
    }
    __syncthreads();
    convert_weights(P, lds, 0, blockIdx.x * 8 + wave, gridDim.x * 8, wave, lane, 0, 1152);
}

__device__ __forceinline__ void ph_norm_mod(const float* xlat, const float* xctx, int nrows, const float* w, const float* modl, int sh_off, int s_off, bf16* out, const float* p1 = nullptr, const float* p2 = nullptr, const float* p3 = nullptr, int row0 = 0) {
    const int tid = otid(), lane = tid & 63, gw = blockIdx.x * 8 + (tid >> 6), NGW = gridDim.x * 8;
    const int per = (nrows - row0 + NGW - 1) / NGW, start = row0 + gw * per, end = min(start + per, nrows);
    int cur = -1; f32x4 cv[4], hv[4];
#pragma unroll
    for (int j = 0; j < 4; ++j) { cv[j] = (f32x4){0.f, 0.f, 0.f, 0.f}; hv[j] = cv[j]; }
    for (int r0 = start; r0 < end; r0 += 3) {
        f32x4 v[3][4];
#pragma unroll
        for (int u = 0; u < 3; ++u) { const int row = r0 + u;
            if (row < end) { const float* xr = row < ML ? xlat + (size_t)row * DM : xctx + (size_t)(row - ML) * DM;
#pragma unroll
                for (int j = 0; j < 4; ++j) { v[u][j] = *(const f32x4*)(xr + 4 * lane + 256 * j);
                    if (p1 && row >= ML) { const size_t po = (size_t)(row - ML) * DM + 4 * lane + 256 * j; v[u][j] = v[u][j] + (*(const f32x4*)(p1 + po) + *(const f32x4*)(p2 + po) + *(const f32x4*)(p3 + po)); } } }
            else {
#pragma unroll
                for (int j = 0; j < 4; ++j) v[u][j] = (f32x4){0.f, 0.f, 0.f, 0.f}; } }
#pragma unroll
        for (int u = 0; u < 3; ++u) { const int row = r0 + u;
            if (row < end) {
                float ss = 0.f;
#pragma unroll
                for (int j = 0; j < 4; ++j) ss += (v[u][j].x * v[u][j].x + v[u][j].y * v[u][j].y) + (v[u][j].z * v[u][j].z + v[u][j].w * v[u][j].w);
                const float rstd = rsqrtf(wave_sum(ss) * (1.f / DM) + EPSN);
                const int mr = row < ML ? (row >> 11) : 8;
                if (mr != cur) { cur = mr; const float* md = modl + (size_t)mr * 6144;
#pragma unroll
                    for (int j = 0; j < 4; ++j) { const int col = 4 * lane + 256 * j; cv[j] = *(const f32x4*)(w + col) * (1.f + *(const f32x4*)(md + s_off + col)); hv[j] = *(const f32x4*)(md + sh_off + col); } }
#pragma unroll
                for (int j = 0; j < 4; ++j) { const int col = 4 * lane + 256 * j; const f32x4 o = v[u][j] * rstd * cv[j] + hv[j];
                    u32x2 pk; pk.x = pk2(o.x, o.y); pk.y = pk2(o.z, o.w); *(u32x2*)(out + (size_t)row * DM + col) = pk; } } }
    }
}
__device__ __forceinline__ void ph_final_norm(const float* x, const float* w, float* out) {
    const int tid = otid(), lane = tid & 63, gw = blockIdx.x * 8 + (tid >> 6), NGW = gridDim.x * 8;
    const int per = (ML + NGW - 1) / NGW, start = gw * per, end = min(start + per, ML);
    f32x4 wv[4];
#pragma unroll
    for (int j = 0; j < 4; ++j) wv[j] = *(const f32x4*)(w + 4 * lane + 256 * j);
    for (int r0 = start; r0 < end; r0 += 4) {
        f32x4 v[4][4];
#pragma unroll
        for (int u = 0; u < 4; ++u) { const int row = min(r0 + u, end - 1);
#pragma unroll
            for (int j = 0; j < 4; ++j) v[u][j] = *(const f32x4*)(x + (size_t)row * DM + 4 * lane + 256 * j); }
#pragma unroll
        for (int u = 0; u < 4; ++u) { const int row = r0 + u;
            if (row < end) { float ss = 0.f;
#pragma unroll
                for (int j = 0; j < 4; ++j) ss += (v[u][j].x * v[u][j].x + v[u][j].y * v[u][j].y) + (v[u][j].z * v[u][j].z + v[u][j].w * v[u][j].w);
                const float rstd = rsqrtf(wave_sum(ss) * (1.f / DM) + EPSN);
#pragma unroll
                for (int j = 0; j < 4; ++j) *(f32x4*)(out + (size_t)row * DM + 4 * lane + 256 * j) = v[u][j] * rstd * wv[j]; } }
    }
}

__device__ __forceinline__ void pool_unit(LAS unsigned char* lds, const bf16* Z, bf16* Y, const bf16* PWT_l, const float* pool_scale_l, int T) {
    const int tid = otid(), lane = tid & 63, wave = __builtin_amdgcn_readfirstlane(tid >> 6), r = lane & 15, quad = lane >> 4;
    LAS float* Pf = (LAS float*)lds;
    LAS bf16* Dt = (LAS bf16*)lds;
    LAS bf16* Wt = (LAS bf16*)(lds + 81920);
    int t0, n, rowbase;
    if (T < 256) { rowbase = (T >> 5) * SEQ; t0 = (T & 31) * 64; n = SEQ; } else { const int Tc = T - 256; rowbase = ML + (Tc >> 2) * CTXL; t0 = (Tc & 3) * 64; n = CTXL; }
#pragma unroll
    for (int i = 0; i < 5; ++i) { const int idx = tid + NTHREADS * i, rr = idx >> 5, c8 = idx & 31, t = t0 - 8 + rr;
        u32x4 v = {0u, 0u, 0u, 0u};
        if (t >= 0 && t < n) v = *(const u32x4*)(Z + (size_t)(rowbase + t) * INW + ZP + c8 * 8);
        f32x4 lo4 = {bfe(v, 0), bfe(v, 1), bfe(v, 2), bfe(v, 3)}, hi4 = {bfe(v, 4), bfe(v, 5), bfe(v, 6), bfe(v, 7)};
        *(LAS f32x4*)(Pf + rr * 256 + c8 * 8) = lo4; *(LAS f32x4*)(Pf + rr * 256 + c8 * 8 + 4) = hi4; }
#pragma unroll
    for (int i = 0; i < 4; ++i) { const int idx = tid + NTHREADS * i, row = idx >> 3, ch8 = idx & 7;
        *(LAS u32x4*)(Wt + row * 72 + ch8 * 8) = *(const u32x4*)(PWT_l + row * 64 + ch8 * 8); }
    __syncthreads();
    const int c = tid & 255, hf = tid >> 8, half = 1 << (c >> 6);
    float dv[32];
    {
        const int rb = 32 * hf + 8;
        float sacc = 0.f;
        for (int j = -half; j < half; ++j) sacc += Pf[(rb + j) * 256 + c];
#pragma unroll
        for (int i = 0; i < 32; ++i) { const int t = t0 + 32 * hf + i; const int lo = max(t - half, 0), hi = min(t + half, n);
            dv[i] = sacc * rcpf_((float)(hi - lo)) - Pf[(rb + i) * 256 + c];
            if (i < 31) sacc += Pf[(rb + i + half) * 256 + c] - Pf[(rb + i - half) * 256 + c]; }
    }
    __syncthreads();
#pragma unroll
    for (int i = 0; i < 32; ++i) Dt[(32 * hf + i) * 264 + c] = (bf16)f2bf(dv[i]);
    __syncthreads();
#pragma unroll
    for (int e = 0; e < 8; ++e) { const int tt = wave * 8 + e, g = tt >> 4, d0 = ((tt >> 2) & 3) * 16, tau0 = (tt & 3) * 16;
        f32x4 acc = {0.f, 0.f, 0.f, 0.f};
        acc = mma16(Wt + (g * 64 + d0) * 72, 72, Dt + tau0 * 264 + g * 64, 264, 64, acc, lane);
        const f32x4 sc = *(const f32x4*)(pool_scale_l + 64 * g + d0 + quad * 4);
        u32x2 pk; pk.x = pk2(acc[0] * sc[0], acc[1] * sc[1]); pk.y = pk2(acc[2] * sc[2], acc[3] * sc[3]);
        *(u32x2*)(Y + (size_t)(rowbase + t0 + tau0 + r) * DM + 64 * g + d0 + quad * 4) = pk; }
    __syncthreads();
}

__device__ __forceinline__ bf16x8 rope8(const u32x4& own, const u32x4& par, const LAS f32x2* cs, bool first, float scale) {
    bf16x8 o;
    float t[8];
#pragma unroll
    for (int j = 0; j < 8; ++j) { const float a = bfe(own, j), b = bfe(par, j); const f32x2 c = cs[j];
        t[j] = (first ? a * c.x - b * c.y : a * c.x + b * c.y) * scale; }
    u32x4 w; w.x = pk2(t[0], t[1]); w.y = pk2(t[2], t[3]); w.z = pk2(t[4], t[5]); w.w = pk2(t[6], t[7]);
    return __builtin_bit_cast(bf16x8, w);
}
__device__ __forceinline__ bf16x8 scale8(const u32x4& own, float scale) {
    float t[8];
#pragma unroll
    for (int j = 0; j < 8; ++j) t[j] = bfe(own, j) * scale;
    u32x4 w; w.x = pk2(t[0], t[1]); w.y = pk2(t[2], t[3]); w.z = pk2(t[4], t[5]); w.w = pk2(t[6], t[7]);
    return __builtin_bit_cast(bf16x8, w);
}

__device__ __forceinline__ void attn_unit(LAS unsigned char* lds, const bf16* Z, bf16* Y, const float* sink_l, const float2* rope, int unit) {
    const int tid = otid(), lane = tid & 63, wave = __builtin_amdgcn_readfirstlane(tid >> 6), r = lane & 15, quad = lane >> 4;
    LAS bf16* Ks = (LAS bf16*)lds;
    LAS bf16* Vt = (LAS bf16*)(lds + 36864);
    const bool lat = unit < 512;
    int b, kh, qrow0, qpos0, ntiles, tlo;
    if (lat) { b = unit >> 6; const int n = (unit & 63) >> 1; kh = unit & 1; qpos0 = 64 * n; qrow0 = b * SEQ + qpos0; tlo = n == 0 ? 2 : (n == 1 ? 1 : 0); const int thi = n == 31 ? 3 : (n == 30 ? 4 : 5); ntiles = 4 + thi - tlo; }
    else { const int cu = unit - 512; b = cu >> 3; const int qb4 = (cu & 7) >> 1; kh = cu & 1; qpos0 = 0; qrow0 = ML + b * CTXL + 64 * qb4; tlo = 0; ntiles = 4; }
    const int hh = wave >> 1, qhead = kh * 4 + hh, qw0 = (wave & 1) * 32;
    LAS f32x2* ropeL = (LAS f32x2*)(lds + 73728);
    ropeL[tid] = ((const f32x2*)rope)[tid]; ropeL[tid + NTHREADS] = ((const f32x2*)rope)[tid + NTHREADS];
    __syncthreads();
    const float QSC = 0.125f * 1.4426950408889634f;
    bf16x8 qf[2][2];
#pragma unroll
    for (int qb = 0; qb < 2; ++qb)
#pragma unroll
        for (int ks = 0; ks < 2; ++ks) {
            const int qi = qw0 + qb * 16 + r;
            const bf16* ptr = Z + (size_t)(qrow0 + qi) * INW + ZQ + qhead * 64 + ks * 32;
            const u32x4 own = *(const u32x4*)(ptr + quad * 8);
            if (lat) { const u32x4 par = *(const u32x4*)(ptr + (quad ^ 2) * 8); const int pos = qpos0 + qi; const int p = ks == 0 ? (pos >> 6) : (pos & 63);
                qf[qb][ks] = rope8(own, par, ropeL + p * 16 + (quad & 1) * 8, quad < 2, QSC); }
            else qf[qb][ks] = scale8(own, QSC);
        }
    const float sk = sink_l[qhead] * 1.4426950408889634f;
    float mrun[2], lrun[2]; f32x4 o[2][4];
#pragma unroll
    for (int qb = 0; qb < 2; ++qb) { mrun[qb] = sk; lrun[qb] = quad == 0 ? 1.f : 0.f;
#pragma unroll
        for (int db = 0; db < 4; ++db) o[qb][db] = (f32x4){0.f, 0.f, 0.f, 0.f}; }
    const int skey = tid >> 3, c8 = tid & 7;
    u32x4 kown, kpar, vv;
    auto tile_rows = [&](int idx, int& rowbase, int& kpos0) { if (idx < 4) { rowbase = ML + b * CTXL + 64 * idx; kpos0 = -100000; } else { kpos0 = qpos0 - 128 + 64 * (tlo + idx - 4); rowbase = b * SEQ + kpos0; } };
    auto prefetch = [&](int idx) { int rowbase, kpos0; tile_rows(idx, rowbase, kpos0);
        const bf16* zr = Z + (size_t)(rowbase + skey) * INW;
        kown = *(const u32x4*)(zr + ZK + kh * 64 + c8 * 8); kpar = *(const u32x4*)(zr + ZK + kh * 64 + (c8 ^ 2) * 8); vv = *(const u32x4*)(zr + ZV + kh * 64 + c8 * 8); };
    auto stage_store = [&](int idx, int buf) {
        int rowbase, kpos0; tile_rows(idx, rowbase, kpos0);
        LAS bf16* Kb = Ks + buf * 9216; LAS bf16* Vb = Vt + buf * 9216;
        bf16x8 kk;
        if (kpos0 >= 0) { const int pos = kpos0 + skey; const int p = (c8 < 4) ? (pos >> 6) : (pos & 63);
            kk = rope8(kown, kpar, ropeL + p * 16 + (c8 & 1) * 8, (c8 & 3) < 2, 1.0f); }
        else kk = __builtin_bit_cast(bf16x8, kown);
        *(LAS bf16x8*)(Kb + skey * 72 + c8 * 8) = kk;
#pragma unroll
        for (int j = 0; j < 8; ++j) Vb[(c8 * 8 + j) * 72 + skey] = (bf16)((vv[j >> 1] >> ((j & 1) * 16)) & 0xffffu);
    };
    prefetch(0);
    __syncthreads();
    stage_store(0, 0);
    if (ntiles > 1) prefetch(1);
    __syncthreads();
    for (int it = 0; it < ntiles; ++it) {
        int rowbase, kpos0; tile_rows(it, rowbase, kpos0);
        const LAS bf16* Kc = Ks + (it & 1) * 9216; const LAS bf16* Vc = Vt + (it & 1) * 9216;
        bf16x8 kf[4][2], vf[4][2];
#pragma unroll
        for (int kb = 0; kb < 4; ++kb)
#pragma unroll
            for (int ks = 0; ks < 2; ++ks) kf[kb][ks] = *(const LAS bf16x8*)(Kc + (kb * 16 + r) * 72 + ks * 32 + quad * 8);
#pragma unroll
        for (int db = 0; db < 4; ++db)
#pragma unroll
            for (int k2 = 0; k2 < 2; ++k2) { const u32x2 a = *(const LAS u32x2*)(Vc + (db * 16 + r) * 72 + 32 * k2 + 4 * quad), c = *(const LAS u32x2*)(Vc + (db * 16 + r) * 72 + 32 * k2 + 16 + 4 * quad);
                u32x4 w; w.x = a.x; w.y = a.y; w.z = c.x; w.w = c.y; vf[db][k2] = __builtin_bit_cast(bf16x8, w); }
#pragma unroll
        for (int qb = 0; qb < 2; ++qb) {
            f32x4 st[4];
#pragma unroll
            for (int kb = 0; kb < 4; ++kb) { st[kb] = (f32x4){0.f, 0.f, 0.f, 0.f};
#pragma unroll
                for (int ks = 0; ks < 2; ++ks) st[kb] = __builtin_amdgcn_mfma_f32_16x16x32_bf16(kf[kb][ks], qf[qb][ks], st[kb], 0, 0, 0); }
            if (kpos0 >= 0) { const int qpos = qpos0 + qw0 + qb * 16 + r;
#pragma unroll
                for (int kb = 0; kb < 4; ++kb)
#pragma unroll
                    for (int j = 0; j < 4; ++j) { const int dd = qpos - (kpos0 + kb * 16 + quad * 4 + j); if (dd > 128 || dd < -128) st[kb][j] = -1e30f; } }
            float mx = -3e38f;
#pragma unroll
            for (int kb = 0; kb < 4; ++kb)
#pragma unroll
                for (int j = 0; j < 4; ++j) mx = fmaxf(mx, st[kb][j]);
            mx = xmax32(xmax16(mx));
            const float mnew = fmaxf(mrun[qb], mx), alpha = __builtin_amdgcn_exp2f(mrun[qb] - mnew); mrun[qb] = mnew;
            float ps = 0.f;
#pragma unroll
            for (int kb = 0; kb < 4; ++kb)
#pragma unroll
                for (int j = 0; j < 4; ++j) { const float pv = __builtin_amdgcn_exp2f(st[kb][j] - mnew); ps += pv; st[kb][j] = pv; }
            lrun[qb] = lrun[qb] * alpha + ps;
#pragma unroll
            for (int db = 0; db < 4; ++db) o[qb][db] = o[qb][db] * alpha;
#pragma unroll
            for (int k2 = 0; k2 < 2; ++k2) { u32x4 w; w.x = pk2(st[2 * k2][0], st[2 * k2][1]); w.y = pk2(st[2 * k2][2], st[2 * k2][3]); w.z = pk2(st[2 * k2 + 1][0], st[2 * k2 + 1][1]); w.w = pk2(st[2 * k2 + 1][2], st[2 * k2 + 1][3]);
                const bf16x8 pb = __builtin_bit_cast(bf16x8, w);
#pragma unroll
                for (int db = 0; db < 4; ++db) o[qb][db] = __builtin_amdgcn_mfma_f32_16x16x32_bf16(vf[db][k2], pb, o[qb][db], 0, 0, 0); }
        }
        if (it + 1 < ntiles) { stage_store(it + 1, (it + 1) & 1); if (it + 2 < ntiles) prefetch(it + 2); }
        __syncthreads();
    }
#pragma unroll
    for (int qb = 0; qb < 2; ++qb) { float lt = xsum32(xsum16(lrun[qb])); const float inv = rcpf_(lt);
        bf16* yr = Y + (size_t)(qrow0 + qw0 + qb * 16 + r) * DM + 256 + qhead * 64 + quad * 4;
#pragma unroll
        for (int db = 0; db < 4; ++db) { u32x2 pk; pk.x = pk2(o[qb][db][0] * inv, o[qb][db][1] * inv); pk.y = pk2(o[qb][db][2] * inv, o[qb][db][3] * inv); *(u32x2*)(yr + db * 16) = pk; } }
    __syncthreads();
}

__device__ __forceinline__ int hg_row(int b, int step, int dir, int tau) {
    if (dir == 0) return step < 4 ? ML + b * CTXL + 64 * step + tau : b * SEQ + 64 * (step - 4) + tau;
    return step < 4 ? ML + b * CTXL + 64 * (3 - step) + 63 - tau : b * SEQ + 64 * (35 - step) + 63 - tau;
}
__device__ __forceinline__ void hg_stage(LAS bf16* dst, const bf16* Z, int b, int step, int dir, int col0, int tid) {
    const int tau = tid >> 3, c8 = tid & 7;
    *(LAS u32x4*)(dst + tau * 72 + c8 * 8) = *(const u32x4*)(Z + (size_t)hg_row(b, step, dir, tau) * INW + col0 + c8 * 8);
}
__device__ __forceinline__ float hg_gates(const LAS bf16* RAWF, LAS float* TOT, float lb, float (&kk)[8], float (&bb)[8], int lane, int wave, float (&cend)[3], int rs = 72) {
    float run = 0.f;
#pragma unroll
    for (int i = 0; i < 8; ++i) { const float fp = bf2f(RAWF[(8 * wave + i) * rs + lane]);
        const float e = __expf(fp);
        const float om = (1.f - lb) * rcpf_(1.f + e);
        kk[i] = om; run += __logf(1.f - om); bb[i] = run; }
    TOT[wave * 64 + lane] = run;
    __syncthreads();
    float pre = 0.f, tot = 0.f;
#pragma unroll
    for (int s = 0; s < 8; ++s) { const float t = TOT[s * 64 + lane]; tot += t; if (s < wave) pre += t; if (s == 1) cend[0] = tot; if (s == 3) cend[1] = tot; if (s == 5) cend[2] = tot; }
#pragma unroll
    for (int i = 0; i < 8; ++i) bb[i] += pre;
    return tot;
}

struct HuPre { u32x4 f, v; bool valid; };
__device__ __forceinline__ HuPre hu_load(const bf16* Z, int u, int tid) {
    const int chain = u / 36, step = u % 36, b = chain >> 3, h = (chain >> 1) & 3, dir = chain & 1;
    const int tau = tid >> 3, c8 = tid & 7;
    const bf16* zr = Z + (size_t)hg_row(b, step, dir, tau) * INW + h * 64 + c8 * 8;
    HuPre p; p.f = *(const u32x4*)(zr + (dir ? ZFB : ZFF)); p.v = *(const u32x4*)(zr + ZHI); p.valid = true; return p;
}
__device__ __forceinline__ void hgU_unit(LAS unsigned char* lds, const bf16* Z, const float* LBl, float* Sbuf, float* DEC, int u, HuPre& pre, int u_next) {
    const int tid = otid(), lane = tid & 63, wave = __builtin_amdgcn_readfirstlane(tid >> 6), r = lane & 15, quad = lane >> 4;
    LAS bf16* KH = (LAS bf16*)lds;
    LAS bf16* VT = (LAS bf16*)(lds + 9216);
    LAS float* TOT = (LAS float*)(lds + 18432);
    LAS bf16* RAWF = (LAS bf16*)(lds + 20480);
    LAS bf16* RAWV = (LAS bf16*)(lds + 29696);
    const int chain = u / 36, step = u % 36, b = chain >> 3, h = (chain >> 1) & 3, dir = chain & 1;
    const float lb = LBl[dir * 256 + h * 64 + lane];
    if (!pre.valid) pre = hu_load(Z, u, tid);
    { const int tau = tid >> 3, c8 = tid & 7; *(LAS u32x4*)(RAWF + tau * 72 + c8 * 8) = pre.f; *(LAS u32x4*)(RAWV + tau * 72 + c8 * 8) = pre.v; }
    __syncthreads();
    if (u_next >= 0) pre = hu_load(Z, u_next, tid); else pre.valid = false;
    float kk[8], bb[8];
    float cend_[3];
    const float bend = hg_gates(RAWF, TOT, lb, kk, bb, lane, wave, cend_);
    float kh[8];
    u32x4 x;
#pragma unroll
    for (int i = 0; i < 8; ++i) kh[i] = kk[i] * __expf(bend - bb[i]);
#pragma unroll
    for (int i = 0; i < 4; ++i) x[i] = (unsigned)RAWV[(8 * wave + 2 * i) * 72 + lane] | ((unsigned)RAWV[(8 * wave + 2 * i + 1) * 72 + lane] << 16);
    { u32x4 w; w.x = pk2(kh[0], kh[1]); w.y = pk2(kh[2], kh[3]); w.z = pk2(kh[4], kh[5]); w.w = pk2(kh[6], kh[7]); *(LAS u32x4*)(KH + lane * 72 + 8 * wave) = w;
      *(LAS u32x4*)(VT + lane * 72 + 8 * wave) = x; }
    if (wave == 0) DEC[(size_t)u * 64 + lane] = __expf(bend);
    __syncthreads();
#pragma unroll
    for (int e = 0; e < 2; ++e) { const int tt = 2 * wave + e, v0 = (tt >> 2) * 16, k0 = (tt & 3) * 16;
        f32x4 acc = {0.f, 0.f, 0.f, 0.f};
        acc = mma16(VT + v0 * 72, 72, KH + k0 * 72, 72, 64, acc, lane);
#pragma unroll
        for (int j = 0; j < 4; ++j) Sbuf[(size_t)u * 4096 + (v0 + quad * 4 + j) * 64 + k0 + r] = acc[j]; }
    __syncthreads();
}

__device__ __forceinline__ void hg_chain(LAS unsigned char* lds, const bf16* Z, const float* LBl, float* Sbuf, int chain) {
    const int tid = otid(), lane = tid & 63, wave = __builtin_amdgcn_readfirstlane(tid >> 6), r = lane & 15, quad = lane >> 4;
    LAS bf16* KH = (LAS bf16*)lds;
    LAS bf16* VT = (LAS bf16*)(lds + 9216);
    LAS float* TOT = (LAS float*)(lds + 18432);
    LAS bf16* RAWF = (LAS bf16*)(lds + 20480);
    LAS bf16* RAWV = (LAS bf16*)(lds + 29696);
    LAS float* DECL = (LAS float*)(lds + 57344);
    const int h = (chain >> 1) & 3, dir = chain & 1;
    const float lb = LBl[dir * 256 + h * 64 + lane];
    f32x4 st[2];
    st[0] = (f32x4){0.f, 0.f, 0.f, 0.f}; st[1] = st[0];
    HuPre pre = hu_load(Z, chain * 36, tid);
    __syncthreads();
    { const int tau = tid >> 3, c8 = tid & 7; *(LAS u32x4*)(RAWF + tau * 72 + c8 * 8) = pre.f; *(LAS u32x4*)(RAWV + tau * 72 + c8 * 8) = pre.v; }
    pre = hu_load(Z, chain * 36 + 1, tid);
    __syncthreads();
#pragma unroll 1
    for (int step = 0; step < 36; ++step) {
        const int u = chain * 36 + step;
        LAS bf16* RF = RAWF + (step & 1) * 9216;
        LAS bf16* RV = RAWV + (step & 1) * 9216;
        float kk[8], bb[8], cend_[3];
        const float bend = hg_gates(RF, TOT, lb, kk, bb, lane, wave, cend_);
        float kh[8]; u32x4 x;
#pragma unroll
        for (int i = 0; i < 8; ++i) kh[i] = kk[i] * __expf(bend - bb[i]);
#pragma unroll
        for (int i = 0; i < 4; ++i) x[i] = (unsigned)RV[(8 * wave + 2 * i) * 72 + lane] | ((unsigned)RV[(8 * wave + 2 * i + 1) * 72 + lane] << 16);
        { u32x4 w; w.x = pk2(kh[0], kh[1]); w.y = pk2(kh[2], kh[3]); w.z = pk2(kh[4], kh[5]); w.w = pk2(kh[6], kh[7]); *(LAS u32x4*)(KH + lane * 72 + 8 * wave) = w;
          *(LAS u32x4*)(VT + lane * 72 + 8 * wave) = x; }
        if (wave == 0) DECL[lane] = __expf(bend);
        if (step + 1 < 36) { const int tau = tid >> 3, c8 = tid & 7; LAS bf16* NF = RAWF + ((step + 1) & 1) * 9216; LAS bf16* NV = RAWV + ((step + 1) & 1) * 9216;
            *(LAS u32x4*)(NF + tau * 72 + c8 * 8) = pre.f; *(LAS u32x4*)(NV + tau * 72 + c8 * 8) = pre.v;
            if (step + 2 < 36) pre = hu_load(Z, u + 2, tid); }
        __syncthreads();
#pragma unroll
        for (int e = 0; e < 2; ++e) { const int tt = 2 * wave + e, v0 = (tt >> 2) * 16, k0 = (tt & 3) * 16;
            f32x4 acc = {0.f, 0.f, 0.f, 0.f};
            acc = mma16(VT + v0 * 72, 72, KH + k0 * 72, 72, 64, acc, lane);
            const float dk = DECL[k0 + r];
#pragma unroll
            for (int j = 0; j < 4; ++j) { Sbuf[(size_t)u * 4096 + (v0 + quad * 4 + j) * 64 + k0 + r] = st[e][j]; st[e][j] = dk * st[e][j] + acc[j]; } }
    }
    __syncthreads();
}

__device__ __forceinline__ void ph_hg_scan(float* __restrict__ Sbuf, const float* __restrict__ DEC) {
    const int gt = blockIdx.x * NTHREADS + otid(), nt = gridDim.x * NTHREADS;
    for (int i = gt; i < 64 * 4096; i += nt) { const int chain = i >> 12, e = i & 4095, k = e & 63;
        float* __restrict__ sp = Sbuf + (size_t)chain * 36 * 4096 + e; const float* __restrict__ dp = DEC + (size_t)chain * 36 * 64 + k;
        float s = 0.f;
#pragma unroll 1
        for (int s0 = 0; s0 < 36; s0 += 12) {
            float uu[12], dd[12];
#pragma unroll
            for (int j = 0; j < 12; ++j) { uu[j] = sp[(size_t)(s0 + j) * 4096]; dd[j] = dp[(s0 + j) * 64]; }
#pragma unroll
            for (int j = 0; j < 12; ++j) { sp[(size_t)(s0 + j) * 4096] = s; s = dd[j] * s + uu[j]; }
        } }
}

constexpr int HO_RAWQ = 0, HO_RAWF = 9216, HO_RAWV = 18432, HO_QE = 27648, HO_KT = 36864, HO_KD = 46080, HO_VT = 55296, HO_ST = 64512, HO_AM = 73728, HO_QOFF = 82944, HO_OB = 96768, HO_TOT = 114176, HO_BEND = 116224, HO_ST1 = 117248;
struct HoPre { u32x4 q, f, v; f32x4 s0, s1; };
__device__ __forceinline__ void ho_decode(int it, int l, int& b, int& cstep, int& h) {
    if (l == 0) { b = it / 144; cstep = (it % 144) >> 2; h = it & 3; } else { b = it >> 7; cstep = 4 + ((it & 127) >> 2); h = it & 3; }
}
__device__ __forceinline__ HoPre ho_load(const bf16* Z, const float* Sbuf, int b, int cstep, int h, int dir, int tid) {
    const int step = dir == 0 ? cstep : (cstep < 4 ? 3 - cstep : 39 - cstep);
    const int uidx = ((b * 4 + h) * 2 + dir) * 36 + step;
    const int tau = tid >> 3, c8 = tid & 7;
    const bf16* zr = Z + (size_t)hg_row(b, step, dir, tau) * INW + h * 64 + c8 * 8;
    HoPre p; p.q = *(const u32x4*)(zr + ZHQ); p.f = *(const u32x4*)(zr + (dir ? ZFB : ZFF)); p.v = *(const u32x4*)(zr + ZHI);
    const float* sp = Sbuf + (size_t)uidx * 4096 + tau * 64 + c8 * 8; p.s0 = *(const f32x4*)sp; p.s1 = *(const f32x4*)(sp + 4);
    return p;
}
constexpr int H2_RAW = 0  , H2_QE = 49152, H2_KT = 58368, H2_KD = 67584, H2_VT = 76800, H2_ST = 86016  ,
              H2_AM = 104448, H2_QOFF = 113664, H2_OB = 127488, H2_TOT = 144896;
static_assert(H2_TOT + 2048 <= LDS_BYTES - 256, "hgO LDS map");
__device__ __forceinline__ HoPre ho_load_k(const bf16* Z, const float* Sbuf, int l, int it0, int G, int k, int tid) {
    int b, cstep, h; ho_decode(it0 + (k >> 1) * G, l, b, cstep, h);
    return ho_load(Z, Sbuf, b, cstep, h, k & 1, tid);
}
__device__ __forceinline__ void ho_stage(LAS unsigned char* lds, const HoPre& pre, int set, int dirbuf, int tid) {
    const int tau = tid >> 3, c8 = tid & 7;
    LAS bf16* R = (LAS bf16*)(lds + H2_RAW + set * 24576);
    *(LAS u32x4*)(R + tau * 64 + c8 * 8) = pre.q; *(LAS u32x4*)(R + 4096 + tau * 64 + c8 * 8) = pre.f; *(LAS u32x4*)(R + 8192 + tau * 64 + c8 * 8) = pre.v;
    u32x4 w; w.x = pk2(pre.s0.x, pre.s0.y); w.y = pk2(pre.s0.z, pre.s0.w); w.z = pk2(pre.s1.x, pre.s1.y); w.w = pk2(pre.s1.z, pre.s1.w);
    *(LAS u32x4*)((LAS bf16*)(lds + H2_ST + dirbuf * 9216) + tau * 72 + c8 * 8) = w;
}
__device__ __forceinline__ void ph_hgO(LAS unsigned char* lds, const bf16* Z, bf16* Y, const float* LBl, const float* Sbuf, const float* hg_norm_w_l, int l, int n_u) {
    const int it0 = blockIdx.x, G = (int)gridDim.x; if (it0 >= n_u) return;
    const int nk = 2 * ((n_u - it0 + G - 1) / G);
    const int tid = otid(), lane = tid & 63, wave = __builtin_amdgcn_readfirstlane(tid >> 6), r = lane & 15, quad = lane >> 4;
    LAS bf16* QE = (LAS bf16*)(lds + H2_QE); LAS bf16* KT = (LAS bf16*)(lds + H2_KT); LAS bf16* KD = (LAS bf16*)(lds + H2_KD); LAS bf16* VT = (LAS bf16*)(lds + H2_VT);
    LAS bf16* AM = (LAS bf16*)(lds + H2_AM); LAS bf16* QOFF = (LAS bf16*)(lds + H2_QOFF);
    LAS float* OB = (LAS float*)(lds + H2_OB);
    LAS float* TOT = (LAS float*)(lds + H2_TOT);
    HoPre pre = ho_load_k(Z, Sbuf, l, it0, G, 0, tid);
    ho_stage(lds, pre, 0, 0, tid);
    if (nk > 1) pre = ho_load_k(Z, Sbuf, l, it0, G, 1, tid);
    __syncthreads();
#pragma unroll 1
    for (int k = 0; k < nk; ++k) {
        const int dir = k & 1;
        int b, cstep, h; ho_decode(it0 + (k >> 1) * G, l, b, cstep, h);
        const float lb = LBl[dir * 256 + h * 64 + lane];
        const LAS bf16* RAWQ = (const LAS bf16*)(lds + H2_RAW + dir * 24576); const LAS bf16* RAWF = RAWQ + 4096; const LAS bf16* RAWV = RAWQ + 8192;
        const LAS bf16* ST = (const LAS bf16*)(lds + H2_ST + dir * 9216);
        float kk[8], bb[8], cend[3];
        const float btot = hg_gates(RAWF, TOT, lb, kk, bb, lane, wave, cend, 64);
        { u32x4 x;
#pragma unroll
          for (int i = 0; i < 4; ++i) x[i] = (unsigned)RAWV[(8 * wave + 2 * i) * 64 + lane] | ((unsigned)RAWV[(8 * wave + 2 * i + 1) * 64 + lane] << 16);
          *(LAS u32x4*)(VT + lane * 72 + 8 * wave) = x; }
        { const int jj = wave >> 1;
          const float b0 = cend[0], b1 = cend[1], b2 = cend[2];
          const float be = jj == 0 ? b0 : (jj == 1 ? b1 : (jj == 2 ? b2 : btot));
          const float bs = jj == 0 ? 0.f : (jj == 1 ? b0 : (jj == 2 ? b1 : b2));
          const float Es = __expf(bs);
          const float H0 = jj >= 2 ? __expf(bs - b0) : 1.f, H1 = jj >= 3 ? __expf(bs - b1) : 1.f;
#pragma unroll
          for (int i2 = 0; i2 < 4; ++i2) { const int tau = 8 * wave + 2 * i2;
              const float ba = bb[2 * i2], bb_ = bb[2 * i2 + 1], ka = kk[2 * i2], kb_ = kk[2 * i2 + 1];
              const float qa = siluf(bf2f(RAWQ[tau * 64 + lane])) * __expf(ba - bs), qb_ = siluf(bf2f(RAWQ[(tau + 1) * 64 + lane])) * __expf(bb_ - bs);
              unsigned w;
              w = pk2(qa * Es, qb_ * Es); QE[tau * 72 + lane] = (bf16)(w & 0xffffu); QE[(tau + 1) * 72 + lane] = (bf16)(w >> 16);
              w = pk2(ka * __expf(be - ba), kb_ * __expf(be - bb_)); KT[tau * 72 + lane] = (bf16)(w & 0xffffu); KT[(tau + 1) * 72 + lane] = (bf16)(w >> 16);
              w = pk2(ka * __expf(fminf(bs - ba, 80.f)), kb_ * __expf(fminf(bs - bb_, 80.f))); KD[tau * 72 + lane] = (bf16)(w & 0xffffu); KD[(tau + 1) * 72 + lane] = (bf16)(w >> 16);
              if (jj >= 1) { w = pk2(qa * H0, qb_ * H0); QOFF[(tau - 16) * 72 + lane] = (bf16)(w & 0xffffu); QOFF[(tau - 15) * 72 + lane] = (bf16)(w >> 16); }
              if (jj >= 2) { w = pk2(qa * H1, qb_ * H1); QOFF[(48 + tau - 32) * 72 + lane] = (bf16)(w & 0xffffu); QOFF[(48 + tau - 31) * 72 + lane] = (bf16)(w >> 16); }
              if (jj >= 3) { w = pk2(qa, qb_); QOFF[(80 + tau - 48) * 72 + lane] = (bf16)(w & 0xffffu); QOFF[(80 + tau - 47) * 72 + lane] = (bf16)(w >> 16); } } }
        if (k + 1 < nk) { ho_stage(lds, pre, 1 - dir, 1 - dir, tid); if (k + 2 < nk) pre = ho_load_k(Z, Sbuf, l, it0, G, k + 2, tid); }
        __syncthreads();
#pragma unroll
        for (int ee = 0; ee < 2; ++ee) { const int bi = 2 * wave + ee, i = bi >> 2, j = bi & 3;
            if (j <= i) {
                const LAS bf16* qa = (j < i) ? QOFF + ((j == 0 ? 0 : (j == 1 ? 48 : 80)) + 16 * (i - j - 1)) * 72
                                             : (i == 0 ? QE : QOFF + (i == 1 ? 0 : (i == 2 ? 48 : 80)) * 72);
                const LAS bf16* ka = (j < i) ? KT + 16 * j * 72 : KD + 16 * i * 72;
                f32x4 acc = {0.f, 0.f, 0.f, 0.f};
                acc = mma16(qa, 72, ka, 72, 64, acc, lane);
#pragma unroll
                for (int jj = 0; jj < 4; ++jj) { const float v = (j < i || r <= quad * 4 + jj) ? acc[jj] : 0.f; AM[(16 * i + quad * 4 + jj) * 72 + 16 * j + r] = (bf16)f2bf(v); } }
            else {
#pragma unroll
                for (int jj = 0; jj < 4; ++jj) AM[(16 * i + quad * 4 + jj) * 72 + 16 * j + r] = (bf16)0; } }
        __syncthreads();
#pragma unroll
        for (int e = 0; e < 2; ++e) { const int tt = 2 * wave + e, tau0 = (tt >> 2) * 16, v0 = (tt & 3) * 16;
            f32x4 acc = {0.f, 0.f, 0.f, 0.f};
            acc = mma16(AM + tau0 * 72, 72, VT + v0 * 72, 72, tau0 < 32 ? 32 : 64, acc, lane);
            acc = mma16(QE + tau0 * 72, 72, ST + v0 * 72, 72, 64, acc, lane);
#pragma unroll
            for (int j = 0; j < 4; ++j) { const int tau = tau0 + quad * 4 + j; const int t = dir == 0 ? tau : 63 - tau;
                if (dir == 0) OB[t * 68 + v0 + r] = acc[j]; else OB[t * 68 + v0 + r] += acc[j]; } }
        if (dir == 1) {
            __syncthreads();
            const float nw = hg_norm_w_l[lane];
            const int rowbase = cstep < 4 ? ML + b * CTXL + 64 * cstep : b * SEQ + 64 * (cstep - 4);
#pragma unroll
            for (int i = 0; i < 8; ++i) { const int t = 8 * wave + i; const float v = OB[t * 68 + lane];
                const float rstd = rsqrtf(wave_sum(v * v) * (1.f / 64.f) + EPSN);
                const float gt = bf2f(Z[(size_t)(rowbase + t) * INW + ZHG + h * 64 + lane]);
                Y[(size_t)(rowbase + t) * DM + 768 + h * 64 + lane] = (bf16)f2bf(v * rstd * nw * siluf(gt)); }
        }
    }
    __syncthreads();
}

__device__ __forceinline__ void flat_barrier(unsigned* ctr, unsigned target) {
    __builtin_amdgcn_fence(__ATOMIC_RELEASE, "agent");
    asm volatile("s_waitcnt vmcnt(0)" ::: "memory");
    __syncthreads();
    if (threadIdx.x == 0) {
        __hip_atomic_fetch_add(ctr, 1u, __ATOMIC_RELEASE, __HIP_MEMORY_SCOPE_AGENT);
        while (__hip_atomic_load(ctr, __ATOMIC_ACQUIRE, __HIP_MEMORY_SCOPE_AGENT) < target) __builtin_amdgcn_s_sleep(2);
    }
    __syncthreads();
    __builtin_amdgcn_fence(__ATOMIC_ACQUIRE, "agent");
    asm volatile("s_waitcnt vmcnt(0)" ::: "memory");
}
#define XB_TMO      128
#define XB_XCNT(j)  (256  + 64 * (j))
#define XB_XSUB(j)  (1280 + 64 * (j))
#define XB_XGEN(j)  (2304 + 64 * (j))
#define XB_TOP      3328
#define XB_TOPGEN   3392
#define XCD_BAR_WORDS 3456
#define XB_SPIN_CAP (1u << 18)

__device__ __forceinline__ unsigned xb_ld(unsigned* p)              { return __hip_atomic_load(p, __ATOMIC_RELAXED, __HIP_MEMORY_SCOPE_AGENT); }
__device__ __forceinline__ unsigned xb_add(unsigned* p, unsigned v) { return __hip_atomic_fetch_add(p, v, __ATOMIC_RELAXED, __HIP_MEMORY_SCOPE_AGENT); }
__device__ __forceinline__ unsigned xb_xcc_id() { return (unsigned)__builtin_amdgcn_s_getreg((3 << 11) | 20) & 0xFu; }
#define XB_SPIN(cond, bar) do { unsigned _sp = 0; while (cond) { __builtin_amdgcn_s_sleep(1); \
    if ((++_sp & 255u) == 0u) { if (xb_ld(&(bar)[XB_TMO])) break; if (_sp > XB_SPIN_CAP) { atomicAdd(&(bar)[XB_TMO], 1u); break; } } } } while (0)

struct XcdBarrier {
    unsigned* bar; unsigned x;
    volatile LAS unsigned* st;
};

__device__ __forceinline__ XcdBarrier xcd_barrier_post(unsigned* bar, volatile LAS unsigned* st) {
    XcdBarrier b; b.bar = bar; b.x = xb_xcc_id(); b.st = st;
    if (threadIdx.x == 0) (void)xb_add(&bar[XB_XCNT(b.x)], 1u);
    return b;
}
__device__ __forceinline__ void xcd_barrier_complete(unsigned* bar, unsigned x, unsigned& nloc, unsigned& nx) {
    const unsigned G = gridDim.x * gridDim.y * gridDim.z;
    unsigned sum, cnt, mine, sp = 0u;
    for (;;) {
        sum = 0u; cnt = 0u; mine = 0u;
#pragma unroll
        for (unsigned j = 0; j < 16; ++j) { const unsigned c = xb_ld(&bar[XB_XCNT(j)]); sum += c; cnt += (c > 0u) ? 1u : 0u; mine = (j == x) ? c : mine; }
        if (sum == G) break;
        __builtin_amdgcn_s_sleep(1);
        if ((++sp & 255u) == 0u) { if (xb_ld(&bar[XB_TMO])) break; if (sp > XB_SPIN_CAP) { atomicAdd(&bar[XB_TMO], 1u); break; } }
    }
    nloc = mine > 0u ? mine : 1u; nx = cnt > 0u ? cnt : 1u;
}

__device__ __forceinline__ void xcd_barrier(const XcdBarrier& b) {
    asm volatile("s_waitcnt vmcnt(0)" ::: "memory");
    __syncthreads();
    if (threadIdx.x == 0) {
        unsigned* bar = b.bar;
        __builtin_amdgcn_s_waitcnt(0);
        unsigned nloc = b.st[0], nx = b.st[1];
        if (nloc == 0u) { xcd_barrier_complete(bar, b.x, nloc, nx); b.st[0] = nloc; b.st[1] = nx; }
        const unsigned old = xb_add(&bar[XB_XSUB(b.x)], 1u);
        const unsigned gen = old / nloc;
        if (old + 1u == (gen + 1u) * nloc) {
            __builtin_amdgcn_fence(__ATOMIC_RELEASE, "agent");
            asm volatile("s_waitcnt vmcnt(0)" ::: "memory");
            const unsigned og = xb_add(&bar[XB_TOP], 1u);
            const unsigned tg = og / nx;
            if (og + 1u == (tg + 1u) * nx) xb_add(&bar[XB_TOPGEN], 1u);
            else XB_SPIN(xb_ld(&bar[XB_TOPGEN]) == tg, bar);
            __builtin_amdgcn_fence(__ATOMIC_ACQUIRE, "agent");
            xb_add(&bar[XB_XGEN(b.x)], 1u);
            asm volatile("s_waitcnt vmcnt(0)" ::: "memory");
        } else {
            XB_SPIN(xb_ld(&bar[XB_XGEN(b.x)]) == gen, bar);
            __builtin_amdgcn_fence(__ATOMIC_ACQUIRE, "agent");
            asm volatile("s_waitcnt vmcnt(0)" ::: "memory");
        }
    }
    __syncthreads();
}

constexpr int NPHASE = 20;
#ifndef EN_MASK
#define EN_MASK 0x3ff
#endif
#define EN(k) (((EN_MASK) >> (k)) & 1)
#ifndef REP_OP0
#define REP_OP0 1
#endif
#ifndef REP_SYNC
#define REP_SYNC 0
#endif
#ifndef REP_PRO
#define REP_PRO 1
#endif
#ifndef REP_NORM
#define REP_NORM 1
#endif
#ifndef REP_MIX1
#define REP_MIX1 1
#endif
#ifndef REP_HGO
#define REP_HGO 1
#endif
#ifndef REP_GZ
#define REP_GZ 1
#endif
#ifndef REP_ATT
#define REP_ATT 1
#endif
#ifndef REP_HU
#define REP_HU 1
#endif
#ifndef REP_POOL
#define REP_POOL 1
#endif
typedef __attribute__((address_space(4))) const Params CParams;
__device__ __forceinline__ CParams* kparams() { CParams* p = (CParams*)__builtin_amdgcn_kernarg_segment_ptr(); asm volatile("" : "+s"(p)); return p; }
__device__ __forceinline__ Params ldparams(CParams* k) { Params P;
    P.x = k->x; P.c = k->c; P.ctx = k->ctx; P.c_ctx = k->c_ctx; P.w_ada = k->w_ada; P.b_ada = k->b_ada; P.norm1_w = k->norm1_w; P.w_in = k->w_in; P.pool_w = k->pool_w; P.pool_scale = k->pool_scale;
    P.attn_sink = k->attn_sink; P.hg_lower = k->hg_lower; P.hg_norm_w = k->hg_norm_w; P.w_out = k->w_out; P.norm2_w = k->norm2_w; P.w_mlp1 = k->w_mlp1; P.w_mlp2 = k->w_mlp2; P.final_norm_w = k->final_norm_w;
    P.out = k->out; P.ws = k->ws; P.ph_lo = k->ph_lo; P.ph_hi = k->ph_hi; return P; }
#define WSP(T, off) ((T*)(P.ws + (off)))
__global__ void __launch_bounds__(NTHREADS, 2) fwd_kernel(Params Parg) {
    extern __shared__ __attribute__((aligned(16))) unsigned char lds_raw[];
    LAS unsigned char* lds = (LAS unsigned char*)lds_raw;
    cg::grid_group grid = cg::this_grid();
    const int lo = Parg.ph_lo, hi = Parg.ph_hi;
    volatile LAS unsigned* bst = (volatile LAS unsigned*)(lds + LDS_BYTES - 256);
    if (threadIdx.x == 0) { bst[0] = 0u; bst[1] = 0u; }
    __syncthreads();
    const XcdBarrier xbar = xcd_barrier_post((unsigned*)(Parg.ws + WS_CTL), bst);
#define IN(k) (lo <= (k) && (k) < hi)
#define SEAM(k) do { if (IN(k) && IN((k) + 1)) { if (lo < 0) grid.sync(); else xcd_barrier(xbar); } } while (0)
    if (EN(0) && IN(0)) for (int rep = 0; rep < REP_PRO; ++rep) { const Params P = ldparams(kparams()); ph_prologue(P, lds); }
    SEAM(0);
#pragma unroll 1
    for (int l = 0; l < 2; ++l) {
        const int pb = 1 + 9 * l;
        const int mrows = l == 0 ? MT : ML;
        if (EN(1) && IN(pb + 0)) for (int rep = 0; rep < REP_NORM; ++rep) { const Params P = ldparams(kparams());
            ph_norm_mod(l == 0 ? P.x : P.out, l == 0 ? P.ctx : WSP(const float, WS_XC), MT, P.norm1_w + l * DM, WSP(const float, WS_MOD) + (size_t)l * 9 * 6144, 0, 1024, WSP(bf16, WS_ACT),
                        l == 0 ? (const float*)nullptr : WSP(const float, WS_P1), WSP(const float, WS_P2), WSP(const float, WS_P3), (l == 1 && gridDim.x == 256) ? ML : 0); }
        SEAM(pb + 0);
        if (EN(2) && IN(pb + 1)) for (int rep = 0; rep < REP_GZ; ++rep) { const Params P = ldparams(kparams());
            pg8::Gemm g{WSP(const bf16, WS_ACT), WSP(const bf16, WS_WT + (size_t)l * WT_LAYER + WT_IN), MT, INW, DM, DM}; pg8::StaticOrder S; S.init(MT, INW, gridDim.x, blockIdx.x);
            pg8::EpiBf E{WSP(bf16, WS_Z), INW, 0}; pg8::gemm_phase<pg8::EpiBf, pg8::StaticOrder, true, true>(lds, g, S, E);
            if (l == 0) {
                const int G = (int)gridDim.x, nun = (MT / 256) * (INW / 256), rem = nun % G, first = rem == 0 ? 0 : rem, nb = G - first;
                if ((int)blockIdx.x >= first) { const int t_ = otid(); const int w_ = __builtin_amdgcn_readfirstlane(t_ >> 6);
                    convert_weights(P, lds, 0, ((int)blockIdx.x - first) * 8 + w_, nb * 8, w_, t_ & 63, 1152, 5760); } } }
        SEAM(pb + 1);
        if (IN(pb + 2)) for (int rep = 0; rep < REP_MIX1; ++rep) { const Params P = ldparams(kparams());
            const bf16* Z = WSP(const bf16, WS_Z); bf16* ACT = WSP(bf16, WS_ACT);
            const int n_attn = l == 0 ? 576 : 512, n_pool = l == 0 ? 288 : 256, G = (int)gridDim.x, bx = (int)blockIdx.x;
            const int NCH = 64;
            if (G >= 2 * NCH) {
                if (bx < NCH) { if (EN(4)) hg_chain(lds, Z, WSP(const float, WS_LB) + l * 512, WSP(float, WS_S), bx); }
                else for (int it = bx - NCH; it < n_attn; it += G - NCH) { if (EN(3)) attn_unit(lds, Z, ACT, P.attn_sink + l * 8, WSP(const float2, WS_ROPE), it); }
            } else {
                for (int c = bx; c < NCH; c += G) hg_chain(lds, Z, WSP(const float, WS_LB) + l * 512, WSP(float, WS_S), c);
                for (int it = bx; it < n_attn; it += G) attn_unit(lds, Z, ACT, P.attn_sink + l * 8, WSP(const float2, WS_ROPE), it);
            }
            __syncthreads();
            {
                int j0 = bx, jstep = G;
                if (G == 256) {
                    if (l == 1) { j0 = bx >= 192 ? bx - 192 : n_pool; jstep = 64; }
                    else { if (bx >= 192) { j0 = bx - 192; jstep = 64; if (0) {} }
                           else if (bx < 160) { j0 = 128 + bx; jstep = 1024; }
                           else { j0 = n_pool; } }
                }
                const int jlim = (G == 256 && l == 0 && bx >= 192) ? 128 : n_pool;
                if (EN(5)) for (int j = j0; j < jlim; j += jstep) pool_unit(lds, Z, ACT, WSP(const bf16, WS_PWT) + (size_t)l * 4 * 64 * 64, P.pool_scale + l * 256, j);
            }
        }
        SEAM(pb + 2);
        if (EN(7) && IN(pb + 4)) for (int rep = 0; rep < REP_HGO; ++rep) { const Params P = ldparams(kparams());
            const int n_u = l == 0 ? 8 * 36 * 4 : 8 * 32 * 4;
            ph_hgO(lds, WSP(const bf16, WS_Z), WSP(bf16, WS_ACT), WSP(const float, WS_LB) + l * 512, WSP(const float, WS_S), P.hg_norm_w + l * 64, l, n_u);
        }
        SEAM(pb + 4);
        const bool fuse_n2 = (gridDim.x == 256);
        if (EN(8) && IN(pb + 5) && fuse_n2) { const Params P = ldparams(kparams());
            { pg8::Gemm g{WSP(const bf16, WS_ACT), WSP(const bf16, WS_WT + (size_t)l * WT_LAYER + WT_OUT), ML, DM, DM, DM}; pg8::StaticOrder S; S.init(ML, DM, gridDim.x, blockIdx.x);
              const float* modl = WSP(const float, WS_MOD) + (size_t)l * 9 * 6144;
              pg8::EpiNorm2 E{l == 0 ? P.x : P.out, P.out, modl + 2048, P.norm2_w + l * DM, modl + 4096, modl + 3072, WSP(bf16, WS_ACT), WSP(unsigned long long, WS_FSLOT + (l == 0 ? 1536 : 512) * 1024), WSP(unsigned, WS_CTL) + (l == 0 ? 16384 : 8192), EPSN, 0, -1};
              pg8::gemm_phase<pg8::EpiNorm2, pg8::StaticOrder, false, true>(lds, g, S, E); }
            if (l == 0) {
                pg8::Gemm g{WSP(const bf16, WS_ACT), WSP(const bf16, WS_WT + WT_OUT), MT, DM, DM, DM}; pg8::SplitOrder S{64, 8, 4, 1, (int)gridDim.x, (int)blockIdx.x};
                const float* mod0 = WSP(const float, WS_MOD);
                pg8::EpiNorm2 E{P.ctx, WSP(float, WS_XC), mod0 + 2048, P.norm2_w, mod0 + 4096, mod0 + 3072, WSP(bf16, WS_ACT), WSP(unsigned long long, WS_FSLOT + 2048 * 1024), WSP(unsigned, WS_CTL) + 20480, EPSN, 64, 8};
                pg8::gemm_phase<pg8::EpiNorm2, pg8::SplitOrder, false, true>(lds, g, S, E);
                if ((int)blockIdx.x >= 32) { const int t_ = otid(); const int w_ = __builtin_amdgcn_readfirstlane(t_ >> 6);
                    convert_weights(P, lds, 1, ((int)blockIdx.x - 32) * 8 + w_, ((int)gridDim.x - 32) * 8, w_, t_ & 63, 0, 5760); } } }
        if (EN(8) && IN(pb + 5) && !fuse_n2) for (int rep = 0; rep < (l == 0 ? REP_OP0 : 1); ++rep) { const Params P = ldparams(kparams());
            pg8::Gemm g{WSP(const bf16, WS_ACT), WSP(const bf16, WS_WT + (size_t)l * WT_LAYER + WT_OUT), mrows, DM, DM, DM}; pg8::StaticOrder S; S.init(mrows, DM, gridDim.x, blockIdx.x);
            pg8::EpiRes E{l == 0 ? P.x : P.out, l == 0 ? P.ctx : WSP(const float, WS_XC), P.out, WSP(float, WS_XC), WSP(const float, WS_MOD) + (size_t)l * 9 * 6144 + 2048};
            pg8::gemm_phase<pg8::EpiRes, pg8::StaticOrder, true, true>(lds, g, S, E);
            if (l == 0) {
                const int G = (int)gridDim.x, nun = (MT / 256) * (DM / 256), rem = nun % G, first = rem == 0 ? 0 : rem, nb = G - first;
                if ((int)blockIdx.x >= first) { const int t_ = otid(); const int w_ = __builtin_amdgcn_readfirstlane(t_ >> 6);
                    convert_weights(P, lds, 1, ((int)blockIdx.x - first) * 8 + w_, nb * 8, w_, t_ & 63, 0, 5760); } } }
        if (!fuse_n2) SEAM(pb + 5);
        if (EN(1) && IN(pb + 6) && !fuse_n2) for (int rep = 0; rep < REP_NORM; ++rep) { const Params P = ldparams(kparams());
            ph_norm_mod(P.out, WSP(const float, WS_XC), mrows, P.norm2_w + l * DM, WSP(const float, WS_MOD) + (size_t)l * 9 * 6144, 3072, 4096, WSP(bf16, WS_ACT), nullptr, nullptr, nullptr, fuse_n2 ? ML : 0); }
        SEAM(pb + 6);
        if (EN(2) && IN(pb + 7)) for (int rep = 0; rep < REP_GZ; ++rep) { const Params P = ldparams(kparams());
            pg8::Gemm g{WSP(const bf16, WS_ACT), WSP(const bf16, WS_WT + (size_t)l * WT_LAYER + WT_W1), mrows, DFF, DM, DM}; pg8::StaticOrder S; S.init(mrows, DFF, gridDim.x, blockIdx.x);
            pg8::EpiBf E{WSP(bf16, WS_HH), DFF, 1}; pg8::gemm_phase<pg8::EpiBf, pg8::StaticOrder, true, true>(lds, g, S, E); }
        SEAM(pb + 7);
        if (EN(8) && IN(pb + 8)) { const Params P = ldparams(kparams());
            if (l == 1 && gridDim.x == 256) {
              pg8::Gemm g{WSP(const bf16, WS_HH), WSP(const bf16, WS_WT + (size_t)l * WT_LAYER + WT_W2), ML, DM, DFF, DFF}; pg8::StaticOrder S; S.init(ML, DM, gridDim.x, blockIdx.x);
              pg8::EpiFinal E{P.out, P.out, WSP(const float, WS_MOD) + (size_t)l * 9 * 6144 + 5120, P.final_norm_w, WSP(unsigned long long, WS_FSLOT), WSP(unsigned, WS_CTL) + 4096, EPSN};
              pg8::gemm_phase<pg8::EpiFinal, pg8::StaticOrder, false, true>(lds, g, S, E); }
            else
            if (l == 0 && gridDim.x == 256) {
              pg8::Gemm g{WSP(const bf16, WS_HH), WSP(const bf16, WS_WT + WT_W2), ML, DM, DFF, DFF}; pg8::StaticOrder S; S.init(ML, DM, gridDim.x, blockIdx.x);
              const float* mod0 = WSP(const float, WS_MOD); const float* mod1 = mod0 + 9 * 6144;
              pg8::EpiNorm2 E{P.out, P.out, mod0 + 5120, P.norm1_w + DM, mod1 + 1024, mod1 + 0, WSP(bf16, WS_ACT), WSP(unsigned long long, WS_FSLOT + 1024 * 1024), WSP(unsigned, WS_CTL) + 12288, EPSN, 0, -1};
              pg8::gemm_phase<pg8::EpiNorm2, pg8::StaticOrder, false, true>(lds, g, S, E); }
            else
            { pg8::Gemm g{WSP(const bf16, WS_HH), WSP(const bf16, WS_WT + (size_t)l * WT_LAYER + WT_W2), ML, DM, DFF, DFF}; pg8::StaticOrder S; S.init(ML, DM, gridDim.x, blockIdx.x);
              pg8::EpiRes E{P.out, WSP(const float, WS_XC), P.out, WSP(float, WS_XC), WSP(const float, WS_MOD) + (size_t)l * 9 * 6144 + 5120};
              pg8::gemm_phase<pg8::EpiRes, pg8::StaticOrder, true, true>(lds, g, S, E); }
            if (l == 0) {
              pg8::Gemm g{WSP(const bf16, WS_HH), WSP(const bf16, WS_WT + WT_W2), MT, DM, 1024, DFF}; pg8::SplitOrder S{64, 8, 4, 4, (int)gridDim.x, (int)blockIdx.x};
              pg8::EpiPart E{WSP(float, WS_XC), WSP(float, WS_P1), WSP(float, WS_P2), WSP(float, WS_P3), WSP(const float, WS_MOD) + 8 * 6144 + 5120};
              pg8::gemm_phase<pg8::EpiPart, pg8::SplitOrder, true, true>(lds, g, S, E); } }
        if (!(l == 1 && gridDim.x == 256)) SEAM(pb + 8);
    }
    for (int rep = 0; rep < REP_SYNC; ++rep) xcd_barrier(xbar);
    if (EN(9) && IN(19) && gridDim.x != 256) { const Params P = ldparams(kparams()); ph_final_norm(P.out, P.final_norm_w, P.out); }
#undef IN
#undef SEAM
}

#ifndef N_LAUNCH_MODE
#define N_LAUNCH_MODE 1
#endif
extern "C" void kernel_launch(void* const* d_in, const int* in_sizes, int n_in, void* d_out, int out_size, void* d_ws, size_t ws_size, hipStream_t stream) {
    static int grid = 0;
    if (grid == 0) {
        if (n_in != 18 || out_size != ML * DM || ws_size < WS_END) { fprintf(stderr, "kernel_launch: unexpected shapes (n_in %d out %d ws %zu)\n", n_in, out_size, ws_size); grid = -1; return; }
        int dev = 0, cus = 0, per_cu = 0;
        hipGetDevice(&dev); hipDeviceGetAttribute(&cus, hipDeviceAttributeMultiprocessorCount, dev);
        hipFuncSetAttribute((const void*)fwd_kernel, hipFuncAttributeMaxDynamicSharedMemorySize, LDS_BYTES);
        hipOccupancyMaxActiveBlocksPerMultiprocessor(&per_cu, (const void*)fwd_kernel, NTHREADS, LDS_BYTES);
        if (per_cu < 1) { fprintf(stderr, "kernel_launch: occupancy query returned %d\n", per_cu); per_cu = 1; }
        grid = cus * per_cu;
        fprintf(stderr, "kernel_launch: cus %d per_cu %d grid %d\n", cus, per_cu, grid);
    }
    if (grid < 0) return;
    hipMemsetAsync((unsigned char*)d_ws + WS_CTL, 0, CTL_BYTES, stream);
    Params p{};
    const float** pp = (const float**)&p;
    for (int i = 0; i < 18; ++i) pp[i] = (const float*)d_in[i];
    p.out = (float*)d_out; p.ws = (unsigned char*)d_ws;
#if N_LAUNCH_MODE == 1
    p.ph_lo = 0; p.ph_hi = NPHASE;
    void* args[] = {&p};
    hipError_t e = hipLaunchCooperativeKernel((const void*)fwd_kernel, dim3(grid), dim3(NTHREADS), args, LDS_BYTES, stream);
    if (e != hipSuccess) fprintf(stderr, "cooperative launch failed: %s (grid %d)\n", hipGetErrorString(e), grid);
#else
    for (int k = 0; k < NPHASE; ++k) { p.ph_lo = k; p.ph_hi = k + 1;
        hipLaunchKernelGGL(fwd_kernel, dim3(grid), dim3(NTHREADS), LDS_BYTES, stream, p); }
#endif
}
```

```cpp
#include <hip/hip_runtime.h>
#include <hip/hip_cooperative_groups.h>
#include <cstdio>
#include <cstdint>
namespace cg = cooperative_groups;
namespace pg8 {
#define PG8_LAS __attribute__((address_space(3)))
typedef unsigned short bf16_t;
typedef short bf16x8 __attribute__((ext_vector_type(8)));
typedef float f32x4 __attribute__((ext_vector_type(4)));
typedef unsigned u32x4 __attribute__((ext_vector_type(4)));
constexpr int BM = 256, BK = 64, HALF = 128, HTB = HALF * BK * 2  , STAGE_BYTES = 8 * HTB, NXCD = 8, WGM = 4;

__host__ __device__ __forceinline__ int lds_byte(int r, int c) { const int st = (r >> 4) * 2 + (c >> 5), rr = r & 15, cc = c & 31, ob = rr * 64 + cc * 2; return st * 1024 + (ob ^ (((ob >> 9) & 1) << 5)); }
__host__ __device__ __forceinline__ void stage_rc(int b, int& R, int& C) { const int st = b / 1024, sb = b % 1024, swz = sb ^ (((sb >> 9) & 1) << 5); R = (st >> 1) * 16 + swz / 64; C = (st & 1) * 32 + (swz % 64) / 2; }
__host__ __device__ __forceinline__ int perm32(int rho) { const int n = rho >> 4, i = rho & 15; return 8 * (i >> 2) + 4 * n + (i & 3); }

struct Unit { int pm, pn, ks; };
struct Gemm { const bf16_t* A; const bf16_t* Bt; int M, N, K, ld; };

struct StaticOrder {
    int nM, nN, nwg, G, c;
    __host__ __device__ void init(int M, int N, int G_, int c_) { nM = M / BM; nN = N / BM; nwg = nM * nN; G = G_; c = c_; }
    __host__ __device__ bool next(int i, Unit& u) const {
        const long L = (long)i * G + c; if (L >= nwg) return false;
        int wgid = (int)L; { const int q = nwg / NXCD, r = nwg % NXCD, xcd = wgid % NXCD, off = wgid / NXCD; wgid = (xcd < r ? xcd * (q + 1) : r * (q + 1) + (xcd - r) * q) + off; }
        const int nig = WGM * nN, gid = wgid / nig, fm = gid * WGM, gsz = (nM - fm) < WGM ? (nM - fm) : WGM;
        u.pm = fm + ((wgid % nig) % gsz); u.pn = (wgid % nig) / gsz; u.ks = 0; return true;
    }
    __device__ __forceinline__ void a_ready(const Unit&) const {}
    __device__ __forceinline__ void done(const Unit&) const {}
};
__device__ __forceinline__ unsigned cvt_pk_bf16(float lo, float hi) { unsigned r; asm volatile("v_cvt_pk_bf16_f32 %0, %1, %2" : "=v"(r) : "v"(lo), "v"(hi)); return r; }
typedef float f32x2 __attribute__((ext_vector_type(2)));
struct EpiBf {
    static constexpr bool PERM = true, AFTER_DRAIN = false;
    bf16_t* O; int ldc; int act;
    __device__ __forceinline__ void operator()(const f32x4 (&acc)[2][2][4][2], const Unit& u, int wr, int wc, int fr, int fq) const {
        const int row0 = u.pm * BM + wr * 64 + fr; const int col0 = u.pn * BM + wc * 32 + 8 * fq;
#pragma unroll
        for (int ai = 0; ai < 2; ++ai)
#pragma unroll
            for (int m = 0; m < 4; ++m) { bf16_t* rowp = O + (size_t)(row0 + ai * HALF + m * 16) * ldc + col0;
#pragma unroll
                for (int bj = 0; bj < 2; ++bj) { f32x4 v0 = acc[ai][bj][m][0], v1 = acc[ai][bj][m][1];
                    if (act) {
#pragma unroll
                        for (int e = 0; e < 4; ++e) { float a = fmaxf(v0[e], 0.f), b = fmaxf(v1[e], 0.f); v0[e] = a * a; v1[e] = b * b; } }
                    u32x4 w; w.x = cvt_pk_bf16(v0[0], v0[1]); w.y = cvt_pk_bf16(v0[2], v0[3]); w.z = cvt_pk_bf16(v1[0], v1[1]); w.w = cvt_pk_bf16(v1[2], v1[3]);
                    *(u32x4*)(rowp + bj * HALF) = w; } }
    }
};
struct EpiRes {
    static constexpr bool PERM = false, AFTER_DRAIN = false;
    const float* res_lat; const float* res_ctx; float* out_lat; float* out_ctx; const float* gate;
    __device__ __forceinline__ void operator()(const f32x4 (&acc)[2][2][4][2], const Unit& u, int wr, int wc, int fr, int fq) const {
        const bool lat = u.pm < 64;
        const float* res = lat ? res_lat + (size_t)u.pm * BM * 1024 : res_ctx + (size_t)(u.pm - 64) * BM * 1024;
        float* out = lat ? out_lat + (size_t)u.pm * BM * 1024 : out_ctx + (size_t)(u.pm - 64) * BM * 1024;
        const float* g = gate + (size_t)(lat ? (u.pm >> 3) : 8) * 6144;
        const int col0 = u.pn * BM + wc * 32 + 4 * fq;
        f32x4 gv[2][2];
#pragma unroll
        for (int bj = 0; bj < 2; ++bj)
#pragma unroll
            for (int n = 0; n < 2; ++n) gv[bj][n] = *(const f32x4*)(g + col0 + bj * HALF + n * 16);
#pragma unroll
        for (int ai = 0; ai < 2; ++ai)
#pragma unroll
            for (int m = 0; m < 4; ++m) { const size_t off = (size_t)(ai * HALF + wr * 64 + m * 16 + fr) * 1024 + col0;
#pragma unroll
                for (int bj = 0; bj < 2; ++bj)
#pragma unroll
                    for (int n = 0; n < 2; ++n) { const f32x4 r = *(const f32x4*)(res + off + bj * HALF + n * 16);
                        *(f32x4*)(out + off + bj * HALF + n * 16) = r + gv[bj][n] * acc[ai][bj][m][n]; } }
    }
};

struct SplitOrder {
    int pm0, npm, nN, nks, G, c;
    __device__ __forceinline__ bool next(int i, Unit& u) const { const int L = i * G + c; if (L >= npm * nN * nks) return false;
        u.ks = L % nks; const int t = L / nks; u.pn = t % nN; u.pm = pm0 + t / nN; return true; }
    __device__ __forceinline__ void a_ready(const Unit&) const {}
    __device__ __forceinline__ void done(const Unit&) const {}
};
struct EpiPart {
    static constexpr bool PERM = false, AFTER_DRAIN = false;
    float* xc; float* p1; float* p2; float* p3; const float* gate;
    __device__ __forceinline__ void operator()(const f32x4 (&acc)[2][2][4][2], const Unit& u, int wr, int wc, int fr, int fq) const {
        float* base = u.ks == 0 ? xc : (u.ks == 1 ? p1 : (u.ks == 2 ? p2 : p3));
        float* out = base + (size_t)(u.pm - 64) * BM * 1024;
        const bool inplace = u.ks == 0;
        const int col0 = u.pn * BM + wc * 32 + 4 * fq;
        f32x4 gv[2][2];
#pragma unroll
        for (int bj = 0; bj < 2; ++bj)
#pragma unroll
            for (int n = 0; n < 2; ++n) gv[bj][n] = *(const f32x4*)(gate + col0 + bj * HALF + n * 16);
#pragma unroll
        for (int ai = 0; ai < 2; ++ai)
#pragma unroll
            for (int m = 0; m < 4; ++m) { const size_t off = (size_t)(ai * HALF + wr * 64 + m * 16 + fr) * 1024 + col0;
#pragma unroll
                for (int bj = 0; bj < 2; ++bj)
#pragma unroll
                    for (int n = 0; n < 2; ++n) { f32x4 v = gv[bj][n] * acc[ai][bj][m][n]; float* p = out + off + bj * HALF + n * 16;
                        if (inplace) v = v + *(const f32x4*)p;
                        *(f32x4*)p = v; } }
    }
};

typedef unsigned epi_u32x2 __attribute__((ext_vector_type(2)));
struct EpiFinal {
    static constexpr bool PERM = false, AFTER_DRAIN = true;
    const float* res; float* out; const float* gate; const float* w; unsigned long long* slots; unsigned* cnt; float eps;
    __device__ __forceinline__ void operator()(const f32x4 (&)[2][2][4][2], const Unit&, int, int, int, int) const {}
    __device__ __forceinline__ void fused(f32x4 (&acc)[2][2][4][2], const Unit& u, int wr, int wc, int fr, int fq, PG8_LAS unsigned char* lds, int wid, int lane) const {
        const float* rs = res + (size_t)u.pm * BM * 1024; float* o = out + (size_t)u.pm * BM * 1024;
        const float* g = gate + (size_t)(u.pm >> 3) * 6144;
        const int col0 = u.pn * BM + wc * 32 + 4 * fq;
        PG8_LAS float* Pp = (PG8_LAS float*)lds;
        PG8_LAS float* Sr = (PG8_LAS float*)(lds + 4096);
        f32x4 gv[2][2];
#pragma unroll
        for (int bj = 0; bj < 2; ++bj)
#pragma unroll
            for (int n = 0; n < 2; ++n) gv[bj][n] = *(const f32x4*)(g + col0 + bj * HALF + n * 16);
#pragma unroll
        for (int ai = 0; ai < 2; ++ai)
#pragma unroll
            for (int m = 0; m < 4; ++m) { const int row = ai * HALF + wr * 64 + m * 16 + fr; const size_t off = (size_t)row * 1024 + col0; float s = 0.f;
#pragma unroll
                for (int bj = 0; bj < 2; ++bj)
#pragma unroll
                    for (int n = 0; n < 2; ++n) { const f32x4 r = *(const f32x4*)(rs + off + bj * HALF + n * 16); const f32x4 x = r + gv[bj][n] * acc[ai][bj][m][n]; acc[ai][bj][m][n] = x;
                        s += (x[0] * x[0] + x[1] * x[1]) + (x[2] * x[2] + x[3] * x[3]); }
                { const epi_u32x2 t = __builtin_amdgcn_permlane16_swap(__float_as_uint(s), __float_as_uint(s), false, false); s = __uint_as_float(t.x) + __uint_as_float(t.y); }
                { const epi_u32x2 t = __builtin_amdgcn_permlane32_swap(__float_as_uint(s), __float_as_uint(s), false, false); s = __uint_as_float(t.x) + __uint_as_float(t.y); }
                if (fq == 0) Pp[row * 4 + wc] = s; }
        asm volatile("s_waitcnt lgkmcnt(0)" ::: "memory"); __builtin_amdgcn_s_barrier(); asm volatile("" ::: "memory");
        const int tid = wid * 64 + lane;
        if (tid < 256) { const f32x4 p = *(const PG8_LAS f32x4*)(Pp + tid * 4); const float tot = (p[0] + p[1]) + (p[2] + p[3]);
            __hip_atomic_store(slots + ((size_t)(u.pm * 4 + u.pn) * 256 + tid), (unsigned long long)__float_as_uint(tot) | (1ull << 32), __ATOMIC_RELAXED, __HIP_MEMORY_SCOPE_AGENT); }
        asm volatile("s_waitcnt vmcnt(0)" ::: "memory"); __builtin_amdgcn_s_barrier(); asm volatile("" ::: "memory");
        if (tid == 0) { __hip_atomic_fetch_add(cnt + 64 * u.pm, 1u, __ATOMIC_RELAXED, __HIP_MEMORY_SCOPE_AGENT);
            unsigned sp = 0; while (__hip_atomic_load(cnt + 64 * u.pm, __ATOMIC_RELAXED, __HIP_MEMORY_SCOPE_AGENT) < 4u) { __builtin_amdgcn_s_sleep(1); if (++sp > (1u << 20)) break; } }
        asm volatile("s_waitcnt vmcnt(0) lgkmcnt(0)" ::: "memory"); __builtin_amdgcn_s_barrier(); asm volatile("" ::: "memory");
        if (tid < 256) { float tot = 0.f;
#pragma unroll
            for (int t = 0; t < 4; ++t) tot += __uint_as_float((unsigned)__hip_atomic_load(slots + ((size_t)(u.pm * 4 + t) * 256 + tid), __ATOMIC_RELAXED, __HIP_MEMORY_SCOPE_AGENT));
            Sr[tid] = 1.0f / sqrtf(tot * (1.0f / 1024.0f) + eps); }
        asm volatile("s_waitcnt vmcnt(0) lgkmcnt(0)" ::: "memory"); __builtin_amdgcn_s_barrier(); asm volatile("" ::: "memory");
        f32x4 wv[2][2];
#pragma unroll
        for (int bj = 0; bj < 2; ++bj)
#pragma unroll
            for (int n = 0; n < 2; ++n) wv[bj][n] = *(const f32x4*)(w + col0 + bj * HALF + n * 16);
#pragma unroll
        for (int ai = 0; ai < 2; ++ai)
#pragma unroll
            for (int m = 0; m < 4; ++m) { const int row = ai * HALF + wr * 64 + m * 16 + fr; const size_t off = (size_t)row * 1024 + col0; const float rstd = Sr[row];
#pragma unroll
                for (int bj = 0; bj < 2; ++bj)
#pragma unroll
                    for (int n = 0; n < 2; ++n) *(f32x4*)(o + off + bj * HALF + n * 16) = acc[ai][bj][m][n] * rstd * wv[bj][n]; }
        asm volatile("s_waitcnt lgkmcnt(0)" ::: "memory"); __builtin_amdgcn_s_barrier(); asm volatile("" ::: "memory");
    }
};

struct EpiNorm2 {
    static constexpr bool PERM = false, AFTER_DRAIN = true;
    const float* res; float* out; const float* gate; const float* nw; const float* ms; const float* msh; bf16_t* hb; unsigned long long* slots; unsigned* cnt; float eps; int pm_sub; int mrow_c;
    __device__ __forceinline__ void operator()(const f32x4 (&)[2][2][4][2], const Unit&, int, int, int, int) const {}
    __device__ __forceinline__ void fused(f32x4 (&acc)[2][2][4][2], const Unit& u, int wr, int wc, int fr, int fq, PG8_LAS unsigned char* lds, int wid, int lane) const {
        const int pl = u.pm - pm_sub;
        const float* rs = res + (size_t)pl * BM * 1024; float* o = out + (size_t)pl * BM * 1024; bf16_t* hp = hb + (size_t)u.pm * BM * 1024;
        const size_t mrow = (size_t)(mrow_c >= 0 ? mrow_c : (u.pm >> 3)) * 6144;
        const int col0 = u.pn * BM + wc * 32 + 4 * fq;
        PG8_LAS float* Pp = (PG8_LAS float*)lds;
        PG8_LAS float* Sr = (PG8_LAS float*)(lds + 4096);
        f32x4 gv[2][2];
#pragma unroll
        for (int bj = 0; bj < 2; ++bj)
#pragma unroll
            for (int n = 0; n < 2; ++n) gv[bj][n] = *(const f32x4*)(gate + mrow + col0 + bj * HALF + n * 16);
#pragma unroll
        for (int ai = 0; ai < 2; ++ai)
#pragma unroll
            for (int m = 0; m < 4; ++m) { const int row = ai * HALF + wr * 64 + m * 16 + fr; const size_t off = (size_t)row * 1024 + col0; float s = 0.f;
#pragma unroll
                for (int bj = 0; bj < 2; ++bj)
#pragma unroll
                    for (int n = 0; n < 2; ++n) { const f32x4 r = *(const f32x4*)(rs + off + bj * HALF + n * 16); const f32x4 x = r + gv[bj][n] * acc[ai][bj][m][n]; acc[ai][bj][m][n] = x;
                        *(f32x4*)(o + off + bj * HALF + n * 16) = x;
                        s += (x[0] * x[0] + x[1] * x[1]) + (x[2] * x[2] + x[3] * x[3]); }
                { const epi_u32x2 t = __builtin_amdgcn_permlane16_swap(__float_as_uint(s), __float_as_uint(s), false, false); s = __uint_as_float(t.x) + __uint_as_float(t.y); }
                { const epi_u32x2 t = __builtin_amdgcn_permlane32_swap(__float_as_uint(s), __float_as_uint(s), false, false); s = __uint_as_float(t.x) + __uint_as_float(t.y); }
                if (fq == 0) Pp[row * 4 + wc] = s; }
        asm volatile("s_waitcnt lgkmcnt(0)" ::: "memory"); __builtin_amdgcn_s_barrier(); asm volatile("" ::: "memory");
        const int tid = wid * 64 + lane;
        if (tid < 256) { const f32x4 p = *(const PG8_LAS f32x4*)(Pp + tid * 4); const float tot = (p[0] + p[1]) + (p[2] + p[3]);
            __hip_atomic_store(slots + ((size_t)(pl * 4 + u.pn) * 256 + tid), (unsigned long long)__float_as_uint(tot) | (1ull << 32), __ATOMIC_RELAXED, __HIP_MEMORY_SCOPE_AGENT); }
        asm volatile("s_waitcnt vmcnt(0)" ::: "memory"); __builtin_amdgcn_s_barrier(); asm volatile("" ::: "memory");
        if (tid == 0) { __hip_atomic_fetch_add(cnt + 64 * pl, 1u, __ATOMIC_RELAXED, __HIP_MEMORY_SCOPE_AGENT);
            unsigned sp = 0; while (__hip_atomic_load(cnt + 64 * pl, __ATOMIC_RELAXED, __HIP_MEMORY_SCOPE_AGENT) < 4u) { __builtin_amdgcn_s_sleep(1); if (++sp > (1u << 20)) break; } }
        asm volatile("s_waitcnt vmcnt(0) lgkmcnt(0)" ::: "memory"); __builtin_amdgcn_s_barrier(); asm volatile("" ::: "memory");
        if (tid < 256) { float tot = 0.f;
#pragma unroll
            for (int t = 0; t < 4; ++t) tot += __uint_as_float((unsigned)__hip_atomic_load(slots + ((size_t)(pl * 4 + t) * 256 + tid), __ATOMIC_RELAXED, __HIP_MEMORY_SCOPE_AGENT));
            Sr[tid] = 1.0f / sqrtf(tot * (1.0f / 1024.0f) + eps); }
        asm volatile("s_waitcnt vmcnt(0) lgkmcnt(0)" ::: "memory"); __builtin_amdgcn_s_barrier(); asm volatile("" ::: "memory");
        f32x4 cv[2][2], hv[2][2];
#pragma unroll
        for (int bj = 0; bj < 2; ++bj)
#pragma unroll
            for (int n = 0; n < 2; ++n) { const int c = col0 + bj * HALF + n * 16; cv[bj][n] = *(const f32x4*)(nw + c) * (1.0f + *(const f32x4*)(ms + mrow + c)); hv[bj][n] = *(const f32x4*)(msh + mrow + c); }
#pragma unroll
        for (int ai = 0; ai < 2; ++ai)
#pragma unroll
            for (int m = 0; m < 4; ++m) { const int row = ai * HALF + wr * 64 + m * 16 + fr; const size_t off = (size_t)row * 1024 + col0; const float rstd = Sr[row];
#pragma unroll
                for (int bj = 0; bj < 2; ++bj)
#pragma unroll
                    for (int n = 0; n < 2; ++n) { const f32x4 h = acc[ai][bj][m][n] * rstd * cv[bj][n] + hv[bj][n];
                        epi_u32x2 pk; pk.x = cvt_pk_bf16(h[0], h[1]); pk.y = cvt_pk_bf16(h[2], h[3]); *(epi_u32x2*)(hp + off + bj * HALF + n * 16) = pk; } }
        asm volatile("s_waitcnt lgkmcnt(0)" ::: "memory"); __builtin_amdgcn_s_barrier(); asm volatile("" ::: "memory");
    }
};
template <class Epi, class Sched, bool ALIGN_EPI = false, bool SP2 = false>
__device__ __forceinline__ void gemm_phase(PG8_LAS unsigned char* lds, const Gemm g, const Sched& S, const Epi& E) {
    int tid_o = threadIdx.x; asm volatile("" : "+v"(tid_o));
    const int tid = tid_o, wid = __builtin_amdgcn_readfirstlane(tid >> 6), lane = tid & 63, wr = wid >> 2, wc = wid & 3, fr = lane & 15, fq = lane >> 4;
    const int K = g.K, nt = K / BK;
    unsigned voffA[2], voffB[2];
#pragma unroll
    for (int i = 0; i < 2; ++i) { int R, C; stage_rc(tid * 16 + i * 8192, R, C); const int Rb = Epi::PERM ? ((R & ~31) + perm32(R & 31)) : R;
        voffA[i] = (unsigned)(R * g.ld + C) * 2u; voffB[i] = (unsigned)(Rb * g.ld + C) * 2u; }
    const size_t kstep = (size_t)(BK * 2);
    const size_t hstep = (size_t)HALF * g.ld * 2;
    const size_t tstep = 2 * hstep;
    const unsigned ldsw = (unsigned)wid * 1024u;
    const int aoff = lds_byte(wr * 64 + fr, fq * 8), boff = lds_byte(wc * 32 + fr, fq * 8);
#define PG8_SA(b, h) (((b) * 2 + (h)) * HTB)
#define PG8_SB(b, h) ((4 + (b) * 2 + (h)) * HTB)
#define PG8_STAGE(bufoff, gbase, voff) do { _Pragma("unroll") for (int _i = 0; _i < 2; ++_i) \
        __builtin_amdgcn_global_load_lds((const unsigned*)((const char*)(gbase) + (voff)[_i]), (PG8_LAS unsigned*)(lds + (bufoff) + ldsw + _i * 8192), 16, 0, 0); } while (0)
#define PG8_LDA(dst, b, h) do { _Pragma("unroll") for (int m = 0; m < 4; ++m) _Pragma("unroll") for (int k = 0; k < 2; ++k) dst[m][k] = *(const PG8_LAS bf16x8*)(lds + PG8_SA(b, h) + aoff + m * 2048 + k * 1024); } while (0)
#define PG8_LDB(dst, b, h) do { _Pragma("unroll") for (int n = 0; n < 2; ++n) _Pragma("unroll") for (int k = 0; k < 2; ++k) dst[n][k] = *(const PG8_LAS bf16x8*)(lds + PG8_SB(b, h) + boff + n * 2048 + k * 1024); } while (0)
#define PG8_MMA(ai, bj, At, Bt) do { __builtin_amdgcn_s_setprio(1); _Pragma("unroll") for (int m = 0; m < 4; ++m) _Pragma("unroll") for (int n = 0; n < 2; ++n) _Pragma("unroll") for (int k = 0; k < 2; ++k) \
        acc[ai][bj][m][n] = __builtin_amdgcn_mfma_f32_16x16x32_bf16(Bt[n][k], At[m][k], acc[ai][bj][m][n], 0, 0, 0); __builtin_amdgcn_s_setprio(0); } while (0)
#define PG8_WAIT_V(n) asm volatile("s_waitcnt vmcnt(" #n ")" ::: "memory")
#define PG8_WAIT_L(n) asm volatile("s_waitcnt lgkmcnt(" #n ")" ::: "memory")
#define PG8_BAR __builtin_amdgcn_s_barrier()
#define PG8_SCHED __builtin_amdgcn_sched_barrier(0)
    Unit cur, nxt; int ui = 0;
    if (!S.next(0, cur)) return;
    f32x4 acc[2][2][4][2];
#pragma unroll
    for (int a = 0; a < 2; ++a)
#pragma unroll
        for (int b = 0; b < 2; ++b)
#pragma unroll
            for (int m = 0; m < 4; ++m)
#pragma unroll
                for (int n = 0; n < 2; ++n) acc[a][b][m][n] = (f32x4){0.f, 0.f, 0.f, 0.f};
    bf16x8 At[4][2], B0[2][2], B1[2][2];
    const char* cA = (const char*)g.A + (size_t)cur.pm * tstep + (size_t)cur.ks * K * 2; const char* cB = (const char*)g.Bt + (size_t)cur.pn * tstep + (size_t)cur.ks * K * 2;
    S.a_ready(cur);
    if constexpr (SP2) {
        PG8_STAGE(PG8_SB(0, 0), cB, voffB); PG8_STAGE(PG8_SB(0, 1), cB + hstep, voffB); PG8_STAGE(PG8_SA(0, 0), cA, voffA); PG8_STAGE(PG8_SA(0, 1), cA + hstep, voffA);
        if (wr == 1) PG8_BAR;
        PG8_WAIT_V(2); PG8_BAR;
        PG8_STAGE(PG8_SB(1, 0), cB + kstep, voffB); PG8_STAGE(PG8_SA(1, 0), cA + kstep, voffA); PG8_STAGE(PG8_SB(1, 1), cB + hstep + kstep, voffB);
        PG8_WAIT_V(6); PG8_BAR;
    } else {
        PG8_STAGE(PG8_SB(0, 0), cB, voffB); PG8_STAGE(PG8_SA(0, 0), cA, voffA); PG8_STAGE(PG8_SB(0, 1), cB + hstep, voffB); PG8_STAGE(PG8_SA(0, 1), cA + hstep, voffA);
        if (wr == 1) PG8_BAR;
        PG8_WAIT_V(4); PG8_BAR;
        PG8_STAGE(PG8_SB(1, 0), cB + kstep, voffB); PG8_STAGE(PG8_SA(1, 0), cA + kstep, voffA); PG8_STAGE(PG8_SB(1, 1), cB + hstep + kstep, voffB);
        PG8_WAIT_V(6); PG8_BAR;
    }
    for (;;) {
        const bool has_next = S.next(ui + 1, nxt);
        const char* nA = has_next ? (const char*)g.A + (size_t)nxt.pm * tstep + (size_t)nxt.ks * K * 2 : cA; const char* nB = has_next ? (const char*)g.Bt + (size_t)nxt.pn * tstep + (size_t)nxt.ks * K * 2 : cB;
        for (int t = 0; t < nt; t += 2) {
            const bool last = (t == nt - 2);
            const char* a1 = cA + (size_t)(t + 1) * kstep;
            const char* a2 = last ? nA : cA + (size_t)(t + 2) * kstep; const char* b2 = last ? nB : cB + (size_t)(t + 2) * kstep;
            const char* a3 = a2 + kstep; const char* b3 = b2 + kstep;
            if (last && has_next) S.a_ready(nxt);
            if constexpr (SP2) {
            PG8_LDB(B0, 0, 0); PG8_LDB(B1, 0, 1); PG8_SCHED; PG8_LDA(At, 0, 0); PG8_STAGE(PG8_SA(1, 1), a1 + hstep, voffA);
            PG8_WAIT_V(8); PG8_WAIT_L(0); PG8_BAR; PG8_MMA(0, 0, At, B0); PG8_MMA(0, 1, At, B1); PG8_BAR; PG8_SCHED;
            PG8_LDA(At, 0, 1); PG8_STAGE(PG8_SB(0, 0), b2, voffB); PG8_STAGE(PG8_SB(0, 1), b2 + hstep, voffB); PG8_STAGE(PG8_SA(0, 0), a2, voffA);
            PG8_WAIT_V(8); PG8_WAIT_L(0); PG8_BAR; PG8_MMA(1, 0, At, B0); PG8_MMA(1, 1, At, B1); PG8_BAR; PG8_SCHED;
            PG8_LDB(B0, 1, 0); PG8_LDB(B1, 1, 1); PG8_SCHED; PG8_LDA(At, 1, 0); PG8_STAGE(PG8_SA(0, 1), a2 + hstep, voffA);
            PG8_WAIT_V(8); PG8_WAIT_L(0); PG8_BAR; PG8_MMA(0, 0, At, B0); PG8_MMA(0, 1, At, B1); PG8_BAR; PG8_SCHED;
            PG8_LDA(At, 1, 1); PG8_STAGE(PG8_SB(1, 0), b3, voffB); PG8_STAGE(PG8_SB(1, 1), b3 + hstep, voffB); PG8_STAGE(PG8_SA(1, 0), a3, voffA);
            PG8_WAIT_V(8); PG8_WAIT_L(0); PG8_BAR; PG8_MMA(1, 0, At, B0); PG8_MMA(1, 1, At, B1); PG8_BAR; PG8_SCHED;
            } else {
            PG8_LDB(B0, 0, 0); PG8_SCHED; PG8_LDA(At, 0, 0); PG8_STAGE(PG8_SA(1, 1), a1 + hstep, voffA);
            PG8_WAIT_L(8); PG8_BAR; PG8_WAIT_L(0); PG8_MMA(0, 0, At, B0); PG8_BAR; PG8_SCHED;
            PG8_LDB(B1, 0, 1); PG8_STAGE(PG8_SB(0, 0), b2, voffB);
            PG8_BAR; PG8_WAIT_L(0); PG8_MMA(0, 1, At, B1); PG8_BAR;
            PG8_LDA(At, 0, 1); PG8_STAGE(PG8_SA(0, 0), a2, voffA);
            PG8_BAR; PG8_WAIT_L(0); PG8_MMA(1, 0, At, B0); PG8_BAR; PG8_SCHED;
            PG8_STAGE(PG8_SB(0, 1), b2 + hstep, voffB);
            PG8_WAIT_V(6); PG8_BAR; PG8_MMA(1, 1, At, B1); PG8_BAR;
            PG8_LDB(B0, 1, 0); PG8_SCHED; PG8_LDA(At, 1, 0); PG8_STAGE(PG8_SA(0, 1), a2 + hstep, voffA);
            PG8_WAIT_L(8); PG8_BAR; PG8_WAIT_L(0); PG8_MMA(0, 0, At, B0); PG8_BAR; PG8_SCHED;
            PG8_LDB(B1, 1, 1); PG8_STAGE(PG8_SB(1, 0), b3, voffB);
            PG8_BAR; PG8_WAIT_L(0); PG8_MMA(0, 1, At, B1); PG8_BAR;
            PG8_LDA(At, 1, 1); PG8_STAGE(PG8_SA(1, 0), a3, voffA);
            PG8_BAR; PG8_WAIT_L(0); PG8_MMA(1, 0, At, B0); PG8_BAR; PG8_SCHED;
            PG8_STAGE(PG8_SB(1, 1), b3 + hstep, voffB);
            PG8_WAIT_V(6); PG8_BAR; PG8_MMA(1, 1, At, B1); PG8_BAR;
            }
        }
        if constexpr (ALIGN_EPI) { if (wr == 0) PG8_BAR; }
        if constexpr (!Epi::AFTER_DRAIN) { E(acc, cur, wr, wc, fr, fq); S.done(cur); }
        if (!has_next) break;
#pragma unroll
        for (int a = 0; a < 2; ++a)
#pragma unroll
            for (int b = 0; b < 2; ++b)
#pragma unroll
                for (int m = 0; m < 4; ++m)
#pragma unroll
                    for (int n = 0; n < 2; ++n) acc[a][b][m][n] = (f32x4){0.f, 0.f, 0.f, 0.f};
        cur = nxt; cA = nA; cB = nB; ++ui;
        if constexpr (ALIGN_EPI) { if (wr == 1) PG8_BAR; }
    }
    PG8_WAIT_V(0);
    if constexpr (!ALIGN_EPI) { if (wr == 0) PG8_BAR; }
    PG8_BAR;
    if constexpr (Epi::AFTER_DRAIN) { E.fused(acc, cur, wr, wc, fr, fq, lds, wid, lane); S.done(cur); }
#undef PG8_SA
#undef PG8_SB
#undef PG8_STAGE
#undef PG8_LDA
#undef PG8_LDB
#undef PG8_MMA
#undef PG8_WAIT_V
#undef PG8_WAIT_L
#undef PG8_BAR
#undef PG8_SCHED
}
}

#define LAS __attribute__((address_space(3)))
typedef unsigned short bf16;
typedef float f32x4 __attribute__((ext_vector_type(4)));
typedef short bf16x8 __attribute__((ext_vector_type(8)));
typedef unsigned u32x4 __attribute__((ext_vector_type(4)));
typedef unsigned u32x2 __attribute__((ext_vector_type(2)));
typedef float f32x2 __attribute__((ext_vector_type(2)));

constexpr int DM = 1024, NB = 8, SEQ = 2048, CTXL = 256;
constexpr int ML = NB * SEQ, MC = NB * CTXL, MT = ML + MC;
constexpr int INW = 2304, DFF = 4096;
constexpr int ZP = 0, ZQ = 256, ZK = 768, ZV = 896, ZHQ = 1024, ZFF = 1280, ZFB = 1536, ZHI = 1792, ZHG = 2048;
constexpr int NTHREADS = 512;
constexpr int LDS_BYTES = 147456;
constexpr float EPSN = 1e-6f;

constexpr size_t MiB = 1u << 20;
constexpr size_t WS_WT = 0;
constexpr size_t WT_LAYER = 22 * MiB + MiB / 2, WT_IN = 0, WT_OUT = 4 * MiB + MiB / 2, WT_W1 = 6 * MiB + MiB / 2, WT_W2 = 14 * MiB + MiB / 2;
constexpr size_t WS_XC = 45 * MiB;
constexpr size_t WS_ACT = 53 * MiB;
constexpr size_t WS_Z = 89 * MiB;
constexpr size_t WS_S = 170 * MiB;
constexpr size_t WS_HH = 89 * MiB;
constexpr size_t WS_MOD = 233 * MiB;
constexpr size_t WS_ROPE = WS_MOD + 512 * 1024;
constexpr size_t WS_LB = WS_ROPE + 16 * 1024;
constexpr size_t WS_DEC = WS_LB + 16 * 1024;
constexpr size_t WS_CTL = 234 * MiB + 512 * 1024;
constexpr size_t CTL_BYTES = 90112;
constexpr size_t WS_PWT = 234 * MiB + 768 * 1024;
constexpr size_t WS_P1 = 0, WS_P2 = 235 * MiB, WS_P3 = 243 * MiB;
constexpr size_t WS_FSLOT = 251 * MiB;
constexpr size_t WS_END = 254 * MiB;
static_assert(WS_DEC + 2304 * 64 * 4 <= WS_CTL && WS_CTL + CTL_BYTES <= WS_PWT && WS_PWT + 65536 <= WS_P2, "ws map");

struct Params {
    const float *x, *c, *ctx, *c_ctx, *w_ada, *b_ada, *norm1_w, *w_in, *pool_w, *pool_scale, *attn_sink, *hg_lower, *hg_norm_w, *w_out, *norm2_w, *w_mlp1, *w_mlp2, *final_norm_w;
    float* out; unsigned char* ws; int ph_lo, ph_hi;
};

__device__ __forceinline__ int otid() { int t = threadIdx.x; asm volatile("" : "+v"(t)); return t; }
__device__ __forceinline__ float bf2f(unsigned u) { return __uint_as_float(u << 16); }
__device__ __forceinline__ unsigned f2bf(float f) { unsigned u = __float_as_uint(f); return (u + 0x7fffu + ((u >> 16) & 1u)) >> 16; }
__device__ __forceinline__ unsigned pk2(float lo, float hi) { return pg8::cvt_pk_bf16(lo, hi); }
__device__ __forceinline__ float xmax16(float v) { const u32x2 r = __builtin_amdgcn_permlane16_swap(__float_as_uint(v), __float_as_uint(v), false, false); return fmaxf(__uint_as_float(r.x), __uint_as_float(r.y)); }
__device__ __forceinline__ float xmax32(float v) { const u32x2 r = __builtin_amdgcn_permlane32_swap(__float_as_uint(v), __float_as_uint(v), false, false); return fmaxf(__uint_as_float(r.x), __uint_as_float(r.y)); }
__device__ __forceinline__ float xsum16(float v) { const u32x2 r = __builtin_amdgcn_permlane16_swap(__float_as_uint(v), __float_as_uint(v), false, false); return __uint_as_float(r.x) + __uint_as_float(r.y); }
__device__ __forceinline__ float xsum32(float v) { const u32x2 r = __builtin_amdgcn_permlane32_swap(__float_as_uint(v), __float_as_uint(v), false, false); return __uint_as_float(r.x) + __uint_as_float(r.y); }
#define DPP_F(v, ctrl) __uint_as_float((unsigned)__builtin_amdgcn_update_dpp(0, (int)__float_as_uint(v), (ctrl), 0xF, 0xF, false))
__device__ __forceinline__ float wave_sum(float v) {
    v += DPP_F(v, 0xB1);
    v += DPP_F(v, 0x4E);
    v += DPP_F(v, 0x141);
    v += DPP_F(v, 0x140);
    return xsum32(xsum16(v));
}
__device__ __forceinline__ float rcpf_(float x) { return __builtin_amdgcn_rcpf(x); }
__device__ __forceinline__ float siluf(float x) { return x * rcpf_(1.f + __expf(-x)); }
__device__ __forceinline__ float bfe(const u32x4& v, int j) { const unsigned w = v[j >> 1]; return (j & 1) ? __uint_as_float(w & 0xffff0000u) : __uint_as_float(w << 16); }

__device__ __forceinline__ f32x4 mma16(const LAS bf16* A, int lda, const LAS bf16* Bt, int ldb, int K, f32x4 acc, int lane) {
    const int r = lane & 15, q = lane >> 4;
    for (int k0 = 0; k0 < K; k0 += 32) {
        const bf16x8 a = *(const LAS bf16x8*)(A + r * lda + k0 + q * 8);
        const bf16x8 b = *(const LAS bf16x8*)(Bt + r * ldb + k0 + q * 8);
        acc = __builtin_amdgcn_mfma_f32_16x16x32_bf16(a, b, acc, 0, 0, 0);
    }
    return acc;
}

__device__ __forceinline__ void transpose_item(const float* W, int K, int N, bf16* WT, LAS float* scr, int item, int lane) {
    const int nblk = N / 32, kb = item / nblk, nb = item % nblk, k0 = 64 * kb, n0 = 32 * nb;
    float tv[32];
#pragma unroll
    for (int i = 0; i < 32; ++i) tv[i] = W[(size_t)(k0 + 2 * i + (lane >> 5)) * N + n0 + (lane & 31)];
#pragma unroll
    for (int i = 0; i < 32; ++i) scr[(2 * i + (lane >> 5)) * 33 + (lane & 31)] = tv[i];
    asm volatile("s_waitcnt lgkmcnt(0)" ::: "memory");
    const int c = lane & 7;
#pragma unroll
    for (int j = 0; j < 4; ++j) { const int n = (lane >> 3) + 8 * j; const LAS float* s = scr + (8 * c) * 33 + n;
        u32x4 o; o.x = pk2(s[0 * 33], s[1 * 33]); o.y = pk2(s[2 * 33], s[3 * 33]); o.z = pk2(s[4 * 33], s[5 * 33]); o.w = pk2(s[6 * 33], s[7 * 33]);
        *(u32x4*)(WT + (size_t)(n0 + n) * K + k0 + 8 * c) = o; }
    asm volatile("s_waitcnt lgkmcnt(0)" ::: "memory");
}

__device__ __forceinline__ void convert_weights(const Params& P, LAS unsigned char* lds, int l, int gw, int NGW, int wave, int lane, int item_lo, int item_hi) {
    LAS float* scr = (LAS float*)(lds + wave * 8448);
    constexpr int I_IN = 16 * 72, I_OUT = 16 * 32, I_1 = 16 * 128, I_2 = 64 * 32, I_L = I_IN + I_OUT + I_1 + I_2;
    unsigned char* wt = P.ws + WS_WT + (size_t)l * WT_LAYER;
    for (int it = item_lo + gw; it < item_hi; it += NGW) {
        int r = it;
        if (r < I_IN) { transpose_item(P.w_in + (size_t)l * DM * INW, DM, INW, (bf16*)(wt + WT_IN), scr, r, lane); continue; } r -= I_IN;
        if (r < I_OUT) { transpose_item(P.w_out + (size_t)l * DM * DM, DM, DM, (bf16*)(wt + WT_OUT), scr, r, lane); continue; } r -= I_OUT;
        if (r < I_1) { transpose_item(P.w_mlp1 + (size_t)l * DM * DFF, DM, DFF, (bf16*)(wt + WT_W1), scr, r, lane); continue; } r -= I_1;
        transpose_item(P.w_mlp2 + (size_t)l * DFF * DM, DFF, DM, (bf16*)(wt + WT_W2), scr, r, lane);
    }
}

__device__ __forceinline__ void ph_prologue(const Params& P, LAS unsigned char* lds) {
    const int tid = otid(), lane = tid & 63, wave = __builtin_amdgcn_readfirstlane(tid >> 6);
    unsigned char* ws = P.ws;
    {
        const int gt = blockIdx.x * NTHREADS + tid, nt = gridDim.x * NTHREADS;
        float2* rope = (float2*)(ws + WS_ROPE);
        for (int i = gt; i < 64 * 16; i += nt) { const int p = i >> 4, f = i & 15;
            const float inv = exp2f(-(float)f * (13.287712379549449f / 16.0f));
            const float a = (float)p * inv; rope[i] = make_float2(__cosf(a), __sinf(a)); }
        bf16* PWT = (bf16*)(ws + WS_PWT);
        for (int i = gt; i < 2 * 4 * 64 * 64; i += nt) { const int lg = i >> 12, d = (i >> 6) & 63, c = i & 63; PWT[i] = (bf16)f2bf(P.pool_w[(size_t)(lg * 64 + c) * 64 + d]); }
        float* LB = (float*)(ws + WS_LB);
        for (int i = gt; i < 512; i += nt) { const float h0 = P.hg_lower[i], h1 = P.hg_lower[512 + i];
            LB[i] = 0.f; LB[512 + i] = 1.f / (1.f + __expf(h0 - h1)); }
    }
    if (blockIdx.x < 192) {
        LAS float* sc = (LAS float*)lds;
        LAS float* red = (LAS float*)(lds + 36864);
        for (int i = tid; i < 9 * 1024; i += NTHREADS) { const int r = i >> 10, k = i & 1023; const float v = r < 8 ? P.c[r * 1024 + k] : P.c_ctx[k]; sc[i] = siluf(v); }
        __syncthreads();
        float* MOD = (float*)(ws + WS_MOD);
        for (int u = blockIdx.x; u < 192; u += gridDim.x) {
            const int l = u / 96, n0 = (u % 96) * 64;
            const float* W = P.w_ada + (size_t)l * 1024 * 6144 + n0 + lane;
            float acc[9];
#pragma unroll
            for (int r = 0; r < 9; ++r) acc[r] = 0.f;
#pragma unroll 1
            for (int kb = 128 * wave; kb < 128 * wave + 128; kb += 32) { float wv[32];
#pragma unroll
                for (int i = 0; i < 32; ++i) wv[i] = W[(size_t)(kb + i) * 6144];
#pragma unroll
                for (int i = 0; i < 32; ++i) {
#pragma unroll
                    for (int r = 0; r < 9; ++r) acc[r] += sc[r * 1024 + kb + i] * wv[i]; } }
#pragma unroll
            for (int r = 0; r < 9; ++r) red[(wave * 9 + r) * 64 + lane] = acc[r];
            __syncthreads();
            for (int i = tid; i < 576; i += NTHREADS) { const int r = i >> 6, cc = i & 63; float s = P.b_ada[l * 6144 + n0 + cc];
#pragma unroll
                for (int w = 0; w < 8; ++w) s += red[(w * 9 + r) * 64 + cc];
                MOD[(size_t)(l * 9 + r) * 6144 + n0 + cc] = s; }
            __syncthreads();
        }
    }
    __syncthreads();
    convert_weights(P, lds, 0, blockIdx.x * 8 + wave, gridDim.x * 8, wave, lane, 0, 1152);
}

__device__ __forceinline__ void ph_norm_mod(const float* xlat, const float* xctx, int nrows, const float* w, const float* modl, int sh_off, int s_off, bf16* out, const float* p1 = nullptr, const float* p2 = nullptr, const float* p3 = nullptr, int row0 = 0) {
    const int tid = otid(), lane = tid & 63, gw = blockIdx.x * 8 + (tid >> 6), NGW = gridDim.x * 8;
    const int per = (nrows - row0 + NGW - 1) / NGW, start = row0 + gw * per, end = min(start + per, nrows);
    int cur = -1; f32x4 cv[4], hv[4];
#pragma unroll
    for (int j = 0; j < 4; ++j) { cv[j] = (f32x4){0.f, 0.f, 0.f, 0.f}; hv[j] = cv[j]; }
    for (int r0 = start; r0 < end; r0 += 3) {
        f32x4 v[3][4];
#pragma unroll
        for (int u = 0; u < 3; ++u) { const int row = r0 + u;
            if (row < end) { const float* xr = row < ML ? xlat + (size_t)row * DM : xctx + (size_t)(row - ML) * DM;
#pragma unroll
                for (int j = 0; j < 4; ++j) { v[u][j] = *(const f32x4*)(xr + 4 * lane + 256 * j);
                    if (p1 && row >= ML) { const size_t po = (size_t)(row - ML) * DM + 4 * lane + 256 * j; v[u][j] = v[u][j] + (*(const f32x4*)(p1 + po) + *(const f32x4*)(p2 + po) + *(const f32x4*)(p3 + po)); } } }
            else {
#pragma unroll
                for (int j = 0; j < 4; ++j) v[u][j] = (f32x4){0.f, 0.f, 0.f, 0.f}; } }
#pragma unroll
        for (int u = 0; u < 3; ++u) { const int row = r0 + u;
            if (row < end) {
                float ss = 0.f;
#pragma unroll
                for (int j = 0; j < 4; ++j) ss += (v[u][j].x * v[u][j].x + v[u][j].y * v[u][j].y) + (v[u][j].z * v[u][j].z + v[u][j].w * v[u][j].w);
                const float rstd = rsqrtf(wave_sum(ss) * (1.f / DM) + EPSN);
                const int mr = row < ML ? (row >> 11) : 8;
                if (mr != cur) { cur = mr; const float* md = modl + (size_t)mr * 6144;
#pragma unroll
                    for (int j = 0; j < 4; ++j) { const int col = 4 * lane + 256 * j; cv[j] = *(const f32x4*)(w + col) * (1.f + *(const f32x4*)(md + s_off + col)); hv[j] = *(const f32x4*)(md + sh_off + col); } }
#pragma unroll
                for (int j = 0; j < 4; ++j) { const int col = 4 * lane + 256 * j; const f32x4 o = v[u][j] * rstd * cv[j] + hv[j];
                    u32x2 pk; pk.x = pk2(o.x, o.y); pk.y = pk2(o.z, o.w); *(u32x2*)(out + (size_t)row * DM + col) = pk; } } }
    }
}
__device__ __forceinline__ void ph_final_norm(const float* x, const float* w, float* out) {
    const int tid = otid(), lane = tid & 63, gw = blockIdx.x * 8 + (tid >> 6), NGW = gridDim.x * 8;
    const int per = (ML + NGW - 1) / NGW, start = gw * per, end = min(start + per, ML);
    f32x4 wv[4];
#pragma unroll
    for (int j = 0; j < 4; ++j) wv[j] = *(const f32x4*)(w + 4 * lane + 256 * j);
    for (int r0 = start; r0 < end; r0 += 4) {
        f32x4 v[4][4];
#pragma unroll
        for (int u = 0; u < 4; ++u) { const int row = min(r0 + u, end - 1);
#pragma unroll
            for (int j = 0; j < 4; ++j) v[u][j] = *(const f32x4*)(x + (size_t)row * DM + 4 * lane + 256 * j); }
#pragma unroll
        for (int u = 0; u < 4; ++u) { const int row = r0 + u;
            if (row < end) { float ss = 0.f;
#pragma unroll
                for (int j = 0; j < 4; ++j) ss += (v[u][j].x * v[u][j].x + v[u][j].y * v[u][j].y) + (v[u][j].z * v[u][j].z + v[u][j].w * v[u][j].w);
                const float rstd = rsqrtf(wave_sum(ss) * (1.f / DM) + EPSN);
#pragma unroll
                for (int j = 0; j < 4; ++j) *(f32x4*)(out + (size_t)row * DM + 4 * lane + 256 * j) = v[u][j] * rstd * wv[j]; } }
    }
}

__device__ __forceinline__ void pool_unit(LAS unsigned char* lds, const bf16* Z, bf16* Y, const bf16* PWT_l, const float* pool_scale_l, int T) {
    const int tid = otid(), lane = tid & 63, wave = __builtin_amdgcn_readfirstlane(tid >> 6), r = lane & 15, quad = lane >> 4;
    LAS float* Pf = (LAS float*)lds;
    LAS bf16* Dt = (LAS bf16*)lds;
    LAS bf16* Wt = (LAS bf16*)(lds + 81920);
    int t0, n, rowbase;
    if (T < 256) { rowbase = (T >> 5) * SEQ; t0 = (T & 31) * 64; n = SEQ; } else { const int Tc = T - 256; rowbase = ML + (Tc >> 2) * CTXL; t0 = (Tc & 3) * 64; n = CTXL; }
#pragma unroll
    for (int i = 0; i < 5; ++i) { const int idx = tid + NTHREADS * i, rr = idx >> 5, c8 = idx & 31, t = t0 - 8 + rr;
        u32x4 v = {0u, 0u, 0u, 0u};
        if (t >= 0 && t < n) v = *(const u32x4*)(Z + (size_t)(rowbase + t) * INW + ZP + c8 * 8);
        f32x4 lo4 = {bfe(v, 0), bfe(v, 1), bfe(v, 2), bfe(v, 3)}, hi4 = {bfe(v, 4), bfe(v, 5), bfe(v, 6), bfe(v, 7)};
        *(LAS f32x4*)(Pf + rr * 256 + c8 * 8) = lo4; *(LAS f32x4*)(Pf + rr * 256 + c8 * 8 + 4) = hi4; }
#pragma unroll
    for (int i = 0; i < 4; ++i) { const int idx = tid + NTHREADS * i, row = idx >> 3, ch8 = idx & 7;
        *(LAS u32x4*)(Wt + row * 72 + ch8 * 8) = *(const u32x4*)(PWT_l + row * 64 + ch8 * 8); }
    __syncthreads();
    const int c = tid & 255, hf = tid >> 8, half = 1 << (c >> 6);
    float dv[32];
    {
        const int rb = 32 * hf + 8;
        float sacc = 0.f;
        for (int j = -half; j < half; ++j) sacc += Pf[(rb + j) * 256 + c];
#pragma unroll
        for (int i = 0; i < 32; ++i) { const int t = t0 + 32 * hf + i; const int lo = max(t - half, 0), hi = min(t + half, n);
            dv[i] = sacc * rcpf_((float)(hi - lo)) - Pf[(rb + i) * 256 + c];
            if (i < 31) sacc += Pf[(rb + i + half) * 256 + c] - Pf[(rb + i - half) * 256 + c]; }
    }
    __syncthreads();
#pragma unroll
    for (int i = 0; i < 32; ++i) Dt[(32 * hf + i) * 264 + c] = (bf16)f2bf(dv[i]);
    __syncthreads();
#pragma unroll
    for (int e = 0; e < 8; ++e) { const int tt = wave * 8 + e, g = tt >> 4, d0 = ((tt >> 2) & 3) * 16, tau0 = (tt & 3) * 16;
        f32x4 acc = {0.f, 0.f, 0.f, 0.f};
        acc = mma16(Wt + (g * 64 + d0) * 72, 72, Dt + tau0 * 264 + g * 64, 264, 64, acc, lane);
        const f32x4 sc = *(const f32x4*)(pool_scale_l + 64 * g + d0 + quad * 4);
        u32x2 pk; pk.x = pk2(acc[0] * sc[0], acc[1] * sc[1]); pk.y = pk2(acc[2] * sc[2], acc[3] * sc[3]);
        *(u32x2*)(Y + (size_t)(rowbase + t0 + tau0 + r) * DM + 64 * g + d0 + quad * 4) = pk; }
    __syncthreads();
}

__device__ __forceinline__ bf16x8 rope8(const u32x4& own, const u32x4& par, const LAS f32x2* cs, bool first, float scale) {
    bf16x8 o;
    float t[8];
#pragma unroll
    for (int j = 0; j < 8; ++j) { const float a = bfe(own, j), b = bfe(par, j); const f32x2 c = cs[j];
        t[j] = (first ? a * c.x - b * c.y : a * c.x + b * c.y) * scale; }
    u32x4 w; w.x = pk2(t[0], t[1]); w.y = pk2(t[2], t[3]); w.z = pk2(t[4], t[5]); w.w = pk2(t[6], t[7]);
    return __builtin_bit_cast(bf16x8, w);
}
__device__ __forceinline__ bf16x8 scale8(const u32x4& own, float scale) {
    float t[8];
#pragma unroll
    for (int j = 0; j < 8; ++j) t[j] = bfe(own, j) * scale;
    u32x4 w; w.x = pk2(t[0], t[1]); w.y = pk2(t[2], t[3]); w.z = pk2(t[4], t[5]); w.w = pk2(t[6], t[7]);
    return __builtin_bit_cast(bf16x8, w);
}

__device__ __forceinline__ void attn_unit(LAS unsigned char* lds, const bf16* Z, bf16* Y, const float* sink_l, const float2* rope, int unit) {
    const int tid = otid(), lane = tid & 63, wave = __builtin_amdgcn_readfirstlane(tid >> 6), r = lane & 15, quad = lane >> 4;
    LAS bf16* Ks = (LAS bf16*)lds;
    LAS bf16* Vt = (LAS bf16*)(lds + 36864);
    const bool lat = unit < 512;
    int b, kh, qrow0, qpos0, ntiles, tlo;
    if (lat) { b = unit >> 6; const int n = (unit & 63) >> 1; kh = unit & 1; qpos0 = 64 * n; qrow0 = b * SEQ + qpos0; tlo = n == 0 ? 2 : (n == 1 ? 1 : 0); const int thi = n == 31 ? 3 : (n == 30 ? 4 : 5); ntiles = 4 + thi - tlo; }
    else { const int cu = unit - 512; b = cu >> 3; const int qb4 = (cu & 7) >> 1; kh = cu & 1; qpos0 = 0; qrow0 = ML + b * CTXL + 64 * qb4; tlo = 0; ntiles = 4; }
    const int hh = wave >> 1, qhead = kh * 4 + hh, qw0 = (wave & 1) * 32;
    LAS f32x2* ropeL = (LAS f32x2*)(lds + 73728);
    ropeL[tid] = ((const f32x2*)rope)[tid]; ropeL[tid + NTHREADS] = ((const f32x2*)rope)[tid + NTHREADS];
    __syncthreads();
    const float QSC = 0.125f * 1.4426950408889634f;
    bf16x8 qf[2][2];
#pragma unroll
    for (int qb = 0; qb < 2; ++qb)
#pragma unroll
        for (int ks = 0; ks < 2; ++ks) {
            const int qi = qw0 + qb * 16 + r;
            const bf16* ptr = Z + (size_t)(qrow0 + qi) * INW + ZQ + qhead * 64 + ks * 32;
            const u32x4 own = *(const u32x4*)(ptr + quad * 8);
            if (lat) { const u32x4 par = *(const u32x4*)(ptr + (quad ^ 2) * 8); const int pos = qpos0 + qi; const int p = ks == 0 ? (pos >> 6) : (pos & 63);
                qf[qb][ks] = rope8(own, par, ropeL + p * 16 + (quad & 1) * 8, quad < 2, QSC); }
            else qf[qb][ks] = scale8(own, QSC);
        }
    const float sk = sink_l[qhead] * 1.4426950408889634f;
    float mrun[2], lrun[2]; f32x4 o[2][4];
#pragma unroll
    for (int qb = 0; qb < 2; ++qb) { mrun[qb] = sk; lrun[qb] = quad == 0 ? 1.f : 0.f;
#pragma unroll
        for (int db = 0; db < 4; ++db) o[qb][db] = (f32x4){0.f, 0.f, 0.f, 0.f}; }
    const int skey = tid >> 3, c8 = tid & 7;
    u32x4 kown, kpar, vv;
    auto tile_rows = [&](int idx, int& rowbase, int& kpos0) { if (idx < 4) { rowbase = ML + b * CTXL + 64 * idx; kpos0 = -100000; } else { kpos0 = qpos0 - 128 + 64 * (tlo + idx - 4); rowbase = b * SEQ + kpos0; } };
    auto prefetch = [&](int idx) { int rowbase, kpos0; tile_rows(idx, rowbase, kpos0);
        const bf16* zr = Z + (size_t)(rowbase + skey) * INW;
        kown = *(const u32x4*)(zr + ZK + kh * 64 + c8 * 8); kpar = *(const u32x4*)(zr + ZK + kh * 64 + (c8 ^ 2) * 8); vv = *(const u32x4*)(zr + ZV + kh * 64 + c8 * 8); };
    auto stage_store = [&](int idx, int buf) {
        int rowbase, kpos0; tile_rows(idx, rowbase, kpos0);
        LAS bf16* Kb = Ks + buf * 9216; LAS bf16* Vb = Vt + buf * 9216;
        bf16x8 kk;
        if (kpos0 >= 0) { const int pos = kpos0 + skey; const int p = (c8 < 4) ? (pos >> 6) : (pos & 63);
            kk = rope8(kown, kpar, ropeL + p * 16 + (c8 & 1) * 8, (c8 & 3) < 2, 1.0f); }
        else kk = __builtin_bit_cast(bf16x8, kown);
        *(LAS bf16x8*)(Kb + skey * 72 + c8 * 8) = kk;
#pragma unroll
        for (int j = 0; j < 8; ++j) Vb[(c8 * 8 + j) * 72 + skey] = (bf16)((vv[j >> 1] >> ((j & 1) * 16)) & 0xffffu);
    };
    prefetch(0);
    __syncthreads();
    stage_store(0, 0);
    if (ntiles > 1) prefetch(1);
    __syncthreads();
    for (int it = 0; it < ntiles; ++it) {
        int rowbase, kpos0; tile_rows(it, rowbase, kpos0);
        const LAS bf16* Kc = Ks + (it & 1) * 9216; const LAS bf16* Vc = Vt + (it & 1) * 9216;
        bf16x8 kf[4][2], vf[4][2];
#pragma unroll
        for (int kb = 0; kb < 4; ++kb)
#pragma unroll
            for (int ks = 0; ks < 2; ++ks) kf[kb][ks] = *(const LAS bf16x8*)(Kc + (kb * 16 + r) * 72 + ks * 32 + quad * 8);
#pragma unroll
        for (int db = 0; db < 4; ++db)
#pragma unroll
            for (int k2 = 0; k2 < 2; ++k2) { const u32x2 a = *(const LAS u32x2*)(Vc + (db * 16 + r) * 72 + 32 * k2 + 4 * quad), c = *(const LAS u32x2*)(Vc + (db * 16 + r) * 72 + 32 * k2 + 16 + 4 * quad);
                u32x4 w; w.x = a.x; w.y = a.y; w.z = c.x; w.w = c.y; vf[db][k2] = __builtin_bit_cast(bf16x8, w); }
#pragma unroll
        for (int qb = 0; qb < 2; ++qb) {
            f32x4 st[4];
#pragma unroll
            for (int kb = 0; kb < 4; ++kb) { st[kb] = (f32x4){0.f, 0.f, 0.f, 0.f};
#pragma unroll
                for (int ks = 0; ks < 2; ++ks) st[kb] = __builtin_amdgcn_mfma_f32_16x16x32_bf16(kf[kb][ks], qf[qb][ks], st[kb], 0, 0, 0); }
            if (kpos0 >= 0) { const int qpos = qpos0 + qw0 + qb * 16 + r;
#pragma unroll
                for (int kb = 0; kb < 4; ++kb)
#pragma unroll
                    for (int j = 0; j < 4; ++j) { const int dd = qpos - (kpos0 + kb * 16 + quad * 4 + j); if (dd > 128 || dd < -128) st[kb][j] = -1e30f; } }
            float mx = -3e38f;
#pragma unroll
            for (int kb = 0; kb < 4; ++kb)
#pragma unroll
                for (int j = 0; j < 4; ++j) mx = fmaxf(mx, st[kb][j]);
            mx = xmax32(xmax16(mx));
            const float mnew = fmaxf(mrun[qb], mx), alpha = __builtin_amdgcn_exp2f(mrun[qb] - mnew); mrun[qb] = mnew;
            float ps = 0.f;
#pragma unroll
            for (int kb = 0; kb < 4; ++kb)
#pragma unroll
                for (int j = 0; j < 4; ++j) { const float pv = __builtin_amdgcn_exp2f(st[kb][j] - mnew); ps += pv; st[kb][j] = pv; }
            lrun[qb] = lrun[qb] * alpha + ps;
#pragma unroll
            for (int db = 0; db < 4; ++db) o[qb][db] = o[qb][db] * alpha;
#pragma unroll
            for (int k2 = 0; k2 < 2; ++k2) { u32x4 w; w.x = pk2(st[2 * k2][0], st[2 * k2][1]); w.y = pk2(st[2 * k2][2], st[2 * k2][3]); w.z = pk2(st[2 * k2 + 1][0], st[2 * k2 + 1][1]); w.w = pk2(st[2 * k2 + 1][2], st[2 * k2 + 1][3]);
                const bf16x8 pb = __builtin_bit_cast(bf16x8, w);
#pragma unroll
                for (int db = 0; db < 4; ++db) o[qb][db] = __builtin_amdgcn_mfma_f32_16x16x32_bf16(vf[db][k2], pb, o[qb][db], 0, 0, 0); }
        }
        if (it + 1 < ntiles) { stage_store(it + 1, (it + 1) & 1); if (it + 2 < ntiles) prefetch(it + 2); }
        __syncthreads();
    }
#pragma unroll
    for (int qb = 0; qb < 2; ++qb) { float lt = xsum32(xsum16(lrun[qb])); const float inv = rcpf_(lt);
        bf16* yr = Y + (size_t)(qrow0 + qw0 + qb * 16 + r) * DM + 256 + qhead * 64 + quad * 4;
#pragma unroll
        for (int db = 0; db < 4; ++db) { u32x2 pk; pk.x = pk2(o[qb][db][0] * inv, o[qb][db][1] * inv); pk.y = pk2(o[qb][db][2] * inv, o[qb][db][3] * inv); *(u32x2*)(yr + db * 16) = pk; } }
    __syncthreads();
}

__device__ __forceinline__ int hg_row(int b, int step, int dir, int tau) {
    if (dir == 0) return step < 4 ? ML + b * CTXL + 64 * step + tau : b * SEQ + 64 * (step - 4) + tau;
    return step < 4 ? ML + b * CTXL + 64 * (3 - step) + 63 - tau : b * SEQ + 64 * (35 - step) + 63 - tau;
}
__device__ __forceinline__ void hg_stage(LAS bf16* dst, const bf16* Z, int b, int step, int dir, int col0, int tid) {
    const int tau = tid >> 3, c8 = tid & 7;
    *(LAS u32x4*)(dst + tau * 72 + c8 * 8) = *(const u32x4*)(Z + (size_t)hg_row(b, step, dir, tau) * INW + col0 + c8 * 8);
}
__device__ __forceinline__ float hg_gates(const LAS bf16* RAWF, LAS float* TOT, float lb, float (&kk)[8], float (&bb)[8], int lane, int wave, float (&cend)[3], int rs = 72) {
    float run = 0.f;
#pragma unroll
    for (int i = 0; i < 8; ++i) { const float fp = bf2f(RAWF[(8 * wave + i) * rs + lane]);
        const float e = __expf(fp);
        const float om = (1.f - lb) * rcpf_(1.f + e);
        kk[i] = om; run += __logf(1.f - om); bb[i] = run; }
    TOT[wave * 64 + lane] = run;
    __syncthreads();
    float pre = 0.f, tot = 0.f;
#pragma unroll
    for (int s = 0; s < 8; ++s) { const float t = TOT[s * 64 + lane]; tot += t; if (s < wave) pre += t; if (s == 1) cend[0] = tot; if (s == 3) cend[1] = tot; if (s == 5) cend[2] = tot; }
#pragma unroll
    for (int i = 0; i < 8; ++i) bb[i] += pre;
    return tot;
}

struct HuPre { u32x4 f, v; bool valid; };
__device__ __forceinline__ HuPre hu_load(const bf16* Z, int u, int tid) {
    const int chain = u / 36, step = u % 36, b = chain >> 3, h = (chain >> 1) & 3, dir = chain & 1;
    const int tau = tid >> 3, c8 = tid & 7;
    const bf16* zr = Z + (size_t)hg_row(b, step, dir, tau) * INW + h * 64 + c8 * 8;
    HuPre p; p.f = *(const u32x4*)(zr + (dir ? ZFB : ZFF)); p.v = *(const u32x4*)(zr + ZHI); p.valid = true; return p;
}
__device__ __forceinline__ void hgU_unit(LAS unsigned char* lds, const bf16* Z, const float* LBl, float* Sbuf, float* DEC, int u, HuPre& pre, int u_next) {
    const int tid = otid(), lane = tid & 63, wave = __builtin_amdgcn_readfirstlane(tid >> 6), r = lane & 15, quad = lane >> 4;
    LAS bf16* KH = (LAS bf16*)lds;
    LAS bf16* VT = (LAS bf16*)(lds + 9216);
    LAS float* TOT = (LAS float*)(lds + 18432);
    LAS bf16* RAWF = (LAS bf16*)(lds + 20480);
    LAS bf16* RAWV = (LAS bf16*)(lds + 29696);
    const int chain = u / 36, step = u % 36, b = chain >> 3, h = (chain >> 1) & 3, dir = chain & 1;
    const float lb = LBl[dir * 256 + h * 64 + lane];
    if (!pre.valid) pre = hu_load(Z, u, tid);
    { const int tau = tid >> 3, c8 = tid & 7; *(LAS u32x4*)(RAWF + tau * 72 + c8 * 8) = pre.f; *(LAS u32x4*)(RAWV + tau * 72 + c8 * 8) = pre.v; }
    __syncthreads();
    if (u_next >= 0) pre = hu_load(Z, u_next, tid); else pre.valid = false;
    float kk[8], bb[8];
    float cend_[3];
    const float bend = hg_gates(RAWF, TOT, lb, kk, bb, lane, wave, cend_);
    float kh[8];
    u32x4 x;
#pragma unroll
    for (int i = 0; i < 8; ++i) kh[i] = kk[i] * __expf(bend - bb[i]);
#pragma unroll
    for (int i = 0; i < 4; ++i) x[i] = (unsigned)RAWV[(8 * wave + 2 * i) * 72 + lane] | ((unsigned)RAWV[(8 * wave + 2 * i + 1) * 72 + lane] << 16);
    { u32x4 w; w.x = pk2(kh[0], kh[1]); w.y = pk2(kh[2], kh[3]); w.z = pk2(kh[4], kh[5]); w.w = pk2(kh[6], kh[7]); *(LAS u32x4*)(KH + lane * 72 + 8 * wave) = w;
      *(LAS u32x4*)(VT + lane * 72 + 8 * wave) = x; }
    if (wave == 0) DEC[(size_t)u * 64 + lane] = __expf(bend);
    __syncthreads();
#pragma unroll
    for (int e = 0; e < 2; ++e) { const int tt = 2 * wave + e, v0 = (tt >> 2) * 16, k0 = (tt & 3) * 16;
        f32x4 acc = {0.f, 0.f, 0.f, 0.f};
        acc = mma16(VT + v0 * 72, 72, KH + k0 * 72, 72, 64, acc, lane);
#pragma unroll
        for (int j = 0; j < 4; ++j) Sbuf[(size_t)u * 4096 + (v0 + quad * 4 + j) * 64 + k0 + r] = acc[j]; }
    __syncthreads();
}

__device__ __forceinline__ void hg_chain(LAS unsigned char* lds, const bf16* Z, const float* LBl, float* Sbuf, int chain) {
    const int tid = otid(), lane = tid & 63, wave = __builtin_amdgcn_readfirstlane(tid >> 6), r = lane & 15, quad = lane >> 4;
    LAS bf16* KH = (LAS bf16*)lds;
    LAS bf16* VT = (LAS bf16*)(lds + 9216);
    LAS float* TOT = (LAS float*)(lds + 18432);
    LAS bf16* RAWF = (LAS bf16*)(lds + 20480);
    LAS bf16* RAWV = (LAS bf16*)(lds + 29696);
    LAS float* DECL = (LAS float*)(lds + 57344);
    const int h = (chain >> 1) & 3, dir = chain & 1;
    const float lb = LBl[dir * 256 + h * 64 + lane];
    f32x4 st[2];
    st[0] = (f32x4){0.f, 0.f, 0.f, 0.f}; st[1] = st[0];
    HuPre pre = hu_load(Z, chain * 36, tid);
    __syncthreads();
    { const int tau = tid >> 3, c8 = tid & 7; *(LAS u32x4*)(RAWF + tau * 72 + c8 * 8) = pre.f; *(LAS u32x4*)(RAWV + tau * 72 + c8 * 8) = pre.v; }
    pre = hu_load(Z, chain * 36 + 1, tid);
    __syncthreads();
#pragma unroll 1
    for (int step = 0; step < 36; ++step) {
        const int u = chain * 36 + step;
        LAS bf16* RF = RAWF + (step & 1) * 9216;
        LAS bf16* RV = RAWV + (step & 1) * 9216;
        float kk[8], bb[8], cend_[3];
        const float bend = hg_gates(RF, TOT, lb, kk, bb, lane, wave, cend_);
        float kh[8]; u32x4 x;
#pragma unroll
        for (int i = 0; i < 8; ++i) kh[i] = kk[i] * __expf(bend - bb[i]);
#pragma unroll
        for (int i = 0; i < 4; ++i) x[i] = (unsigned)RV[(8 * wave + 2 * i) * 72 + lane] | ((unsigned)RV[(8 * wave + 2 * i + 1) * 72 + lane] << 16);
        { u32x4 w; w.x = pk2(kh[0], kh[1]); w.y = pk2(kh[2], kh[3]); w.z = pk2(kh[4], kh[5]); w.w = pk2(kh[6], kh[7]); *(LAS u32x4*)(KH + lane * 72 + 8 * wave) = w;
          *(LAS u32x4*)(VT + lane * 72 + 8 * wave) = x; }
        if (wave == 0) DECL[lane] = __expf(bend);
        if (step + 1 < 36) { const int tau = tid >> 3, c8 = tid & 7; LAS bf16* NF = RAWF + ((step + 1) & 1) * 9216; LAS bf16* NV = RAWV + ((step + 1) & 1) * 9216;
            *(LAS u32x4*)(NF + tau * 72 + c8 * 8) = pre.f; *(LAS u32x4*)(NV + tau * 72 + c8 * 8) = pre.v;
            if (step + 2 < 36) pre = hu_load(Z, u + 2, tid); }
        __syncthreads();
#pragma unroll
        for (int e = 0; e < 2; ++e) { const int tt = 2 * wave + e, v0 = (tt >> 2) * 16, k0 = (tt & 3) * 16;
            f32x4 acc = {0.f, 0.f, 0.f, 0.f};
            acc = mma16(VT + v0 * 72, 72, KH + k0 * 72, 72, 64, acc, lane);
            const float dk = DECL[k0 + r];
#pragma unroll
            for (int j = 0; j < 4; ++j) { Sbuf[(size_t)u * 4096 + (v0 + quad * 4 + j) * 64 + k0 + r] = st[e][j]; st[e][j] = dk * st[e][j] + acc[j]; } }
    }
    __syncthreads();
}

__device__ __forceinline__ void ph_hg_scan(float* __restrict__ Sbuf, const float* __restrict__ DEC) {
    const int gt = blockIdx.x * NTHREADS + otid(), nt = gridDim.x * NTHREADS;
    for (int i = gt; i < 64 * 4096; i += nt) { const int chain = i >> 12, e = i & 4095, k = e & 63;
        float* __restrict__ sp = Sbuf + (size_t)chain * 36 * 4096 + e; const float* __restrict__ dp = DEC + (size_t)chain * 36 * 64 + k;
        float s = 0.f;
#pragma unroll 1
        for (int s0 = 0; s0 < 36; s0 += 12) {
            float uu[12], dd[12];
#pragma unroll
            for (int j = 0; j < 12; ++j) { uu[j] = sp[(size_t)(s0 + j) * 4096]; dd[j] = dp[(s0 + j) * 64]; }
#pragma unroll
            for (int j = 0; j < 12; ++j) { sp[(size_t)(s0 + j) * 4096] = s; s = dd[j] * s + uu[j]; }
        } }
}

constexpr int HO_RAWQ = 0, HO_RAWF = 9216, HO_RAWV = 18432, HO_QE = 27648, HO_KT = 36864, HO_KD = 46080, HO_VT = 55296, HO_ST = 64512, HO_AM = 73728, HO_QOFF = 82944, HO_OB = 96768, HO_TOT = 114176, HO_BEND = 116224, HO_ST1 = 117248;
struct HoPre { u32x4 q, f, v; f32x4 s0, s1; };
__device__ __forceinline__ void ho_decode(int it, int l, int& b, int& cstep, int& h) {
    if (l == 0) { b = it / 144; cstep = (it % 144) >> 2; h = it & 3; } else { b = it >> 7; cstep = 4 + ((it & 127) >> 2); h = it & 3; }
}
__device__ __forceinline__ HoPre ho_load(const bf16* Z, const float* Sbuf, int b, int cstep, int h, int dir, int tid) {
    const int step = dir == 0 ? cstep : (cstep < 4 ? 3 - cstep : 39 - cstep);
    const int uidx = ((b * 4 + h) * 2 + dir) * 36 + step;
    const int tau = tid >> 3, c8 = tid & 7;
    const bf16* zr = Z + (size_t)hg_row(b, step, dir, tau) * INW + h * 64 + c8 * 8;
    HoPre p; p.q = *(const u32x4*)(zr + ZHQ); p.f = *(const u32x4*)(zr + (dir ? ZFB : ZFF)); p.v = *(const u32x4*)(zr + ZHI);
    const float* sp = Sbuf + (size_t)uidx * 4096 + tau * 64 + c8 * 8; p.s0 = *(const f32x4*)sp; p.s1 = *(const f32x4*)(sp + 4);
    return p;
}
constexpr int H2_RAW = 0  , H2_QE = 49152, H2_KT = 58368, H2_KD = 67584, H2_VT = 76800, H2_ST = 86016  ,
              H2_AM = 104448, H2_QOFF = 113664, H2_OB = 127488, H2_TOT = 144896;
static_assert(H2_TOT + 2048 <= LDS_BYTES - 256, "hgO LDS map");
__device__ __forceinline__ HoPre ho_load_k(const bf16* Z, const float* Sbuf, int l, int it0, int G, int k, int tid) {
    int b, cstep, h; ho_decode(it0 + (k >> 1) * G, l, b, cstep, h);
    return ho_load(Z, Sbuf, b, cstep, h, k & 1, tid);
}
__device__ __forceinline__ void ho_stage(LAS unsigned char* lds, const HoPre& pre, int set, int dirbuf, int tid) {
    const int tau = tid >> 3, c8 = tid & 7;
    LAS bf16* R = (LAS bf16*)(lds + H2_RAW + set * 24576);
    *(LAS u32x4*)(R + tau * 64 + c8 * 8) = pre.q; *(LAS u32x4*)(R + 4096 + tau * 64 + c8 * 8) = pre.f; *(LAS u32x4*)(R + 8192 + tau * 64 + c8 * 8) = pre.v;
    u32x4 w; w.x = pk2(pre.s0.x, pre.s0.y); w.y = pk2(pre.s0.z, pre.s0.w); w.z = pk2(pre.s1.x, pre.s1.y); w.w = pk2(pre.s1.z, pre.s1.w);
    *(LAS u32x4*)((LAS bf16*)(lds + H2_ST + dirbuf * 9216) + tau * 72 + c8 * 8) = w;
}
__device__ __forceinline__ void ph_hgO(LAS unsigned char* lds, const bf16* Z, bf16* Y, const float* LBl, const float* Sbuf, const float* hg_norm_w_l, int l, int n_u) {
    const int it0 = blockIdx.x, G = (int)gridDim.x; if (it0 >= n_u) return;
    const int nk = 2 * ((n_u - it0 + G - 1) / G);
    const int tid = otid(), lane = tid & 63, wave = __builtin_amdgcn_readfirstlane(tid >> 6), r = lane & 15, quad = lane >> 4;
    LAS bf16* QE = (LAS bf16*)(lds + H2_QE); LAS bf16* KT = (LAS bf16*)(lds + H2_KT); LAS bf16* KD = (LAS bf16*)(lds + H2_KD); LAS bf16* VT = (LAS bf16*)(lds + H2_VT);
    LAS bf16* AM = (LAS bf16*)(lds + H2_AM); LAS bf16* QOFF = (LAS bf16*)(lds + H2_QOFF);
    LAS float* OB = (LAS float*)(lds + H2_OB);
    LAS float* TOT = (LAS float*)(lds + H2_TOT);
    HoPre pre = ho_load_k(Z, Sbuf, l, it0, G, 0, tid);
    ho_stage(lds, pre, 0, 0, tid);
    if (nk > 1) pre = ho_load_k(Z, Sbuf, l, it0, G, 1, tid);
    __syncthreads();
#pragma unroll 1
    for (int k = 0; k < nk; ++k) {
        const int dir = k & 1;
        int b, cstep, h; ho_decode(it0 + (k >> 1) * G, l, b, cstep, h);
        const float lb = LBl[dir * 256 + h * 64 + lane];
        const LAS bf16* RAWQ = (const LAS bf16*)(lds + H2_RAW + dir * 24576); const LAS bf16* RAWF = RAWQ + 4096; const LAS bf16* RAWV = RAWQ + 8192;
        const LAS bf16* ST = (const LAS bf16*)(lds + H2_ST + dir * 9216);
        float kk[8], bb[8], cend[3];
        const float btot = hg_gates(RAWF, TOT, lb, kk, bb, lane, wave, cend, 64);
        { u32x4 x;
#pragma unroll
          for (int i = 0; i < 4; ++i) x[i] = (unsigned)RAWV[(8 * wave + 2 * i) * 64 + lane] | ((unsigned)RAWV[(8 * wave + 2 * i + 1) * 64 + lane] << 16);
          *(LAS u32x4*)(VT + lane * 72 + 8 * wave) = x; }
        { const int jj = wave >> 1;
          const float b0 = cend[0], b1 = cend[1], b2 = cend[2];
          const float be = jj == 0 ? b0 : (jj == 1 ? b1 : (jj == 2 ? b2 : btot));
          const float bs = jj == 0 ? 0.f : (jj == 1 ? b0 : (jj == 2 ? b1 : b2));
          const float Es = __expf(bs);
          const float H0 = jj >= 2 ? __expf(bs - b0) : 1.f, H1 = jj >= 3 ? __expf(bs - b1) : 1.f;
#pragma unroll
          for (int i2 = 0; i2 < 4; ++i2) { const int tau = 8 * wave + 2 * i2;
              const float ba = bb[2 * i2], bb_ = bb[2 * i2 + 1], ka = kk[2 * i2], kb_ = kk[2 * i2 + 1];
              const float qa = siluf(bf2f(RAWQ[tau * 64 + lane])) * __expf(ba - bs), qb_ = siluf(bf2f(RAWQ[(tau + 1) * 64 + lane])) * __expf(bb_ - bs);
              unsigned w;
              w = pk2(qa * Es, qb_ * Es); QE[tau * 72 + lane] = (bf16)(w & 0xffffu); QE[(tau + 1) * 72 + lane] = (bf16)(w >> 16);
              w = pk2(ka * __expf(be - ba), kb_ * __expf(be - bb_)); KT[tau * 72 + lane] = (bf16)(w & 0xffffu); KT[(tau + 1) * 72 + lane] = (bf16)(w >> 16);
              w = pk2(ka * __expf(fminf(bs - ba, 80.f)), kb_ * __expf(fminf(bs - bb_, 80.f))); KD[tau * 72 + lane] = (bf16)(w & 0xffffu); KD[(tau + 1) * 72 + lane] = (bf16)(w >> 16);
              if (jj >= 1) { w = pk2(qa * H0, qb_ * H0); QOFF[(tau - 16) * 72 + lane] = (bf16)(w & 0xffffu); QOFF[(tau - 15) * 72 + lane] = (bf16)(w >> 16); }
              if (jj >= 2) { w = pk2(qa * H1, qb_ * H1); QOFF[(48 + tau - 32) * 72 + lane] = (bf16)(w & 0xffffu); QOFF[(48 + tau - 31) * 72 + lane] = (bf16)(w >> 16); }
              if (jj >= 3) { w = pk2(qa, qb_); QOFF[(80 + tau - 48) * 72 + lane] = (bf16)(w & 0xffffu); QOFF[(80 + tau - 47) * 72 + lane] = (bf16)(w >> 16); } } }
        if (k + 1 < nk) { ho_stage(lds, pre, 1 - dir, 1 - dir, tid); if (k + 2 < nk) pre = ho_load_k(Z, Sbuf, l, it0, G, k + 2, tid); }
        __syncthreads();
#pragma unroll
        for (int ee = 0; ee < 2; ++ee) { const int bi = 2 * wave + ee, i = bi >> 2, j = bi & 3;
            if (j <= i) {
                const LAS bf16* qa = (j < i) ? QOFF + ((j == 0 ? 0 : (j == 1 ? 48 : 80)) + 16 * (i - j - 1)) * 72
                                             : (i == 0 ? QE : QOFF + (i == 1 ? 0 : (i == 2 ? 48 : 80)) * 72);
                const LAS bf16* ka = (j < i) ? KT + 16 * j * 72 : KD + 16 * i * 72;
                f32x4 acc = {0.f, 0.f, 0.f, 0.f};
                acc = mma16(qa, 72, ka, 72, 64, acc, lane);
#pragma unroll
                for (int jj = 0; jj < 4; ++jj) { const float v = (j < i || r <= quad * 4 + jj) ? acc[jj] : 0.f; AM[(16 * i + quad * 4 + jj) * 72 + 16 * j + r] = (bf16)f2bf(v); } }
            else {
#pragma unroll
                for (int jj = 0; jj < 4; ++jj) AM[(16 * i + quad * 4 + jj) * 72 + 16 * j + r] = (bf16)0; } }
        __syncthreads();
#pragma unroll
        for (int e = 0; e < 2; ++e) { const int tt = 2 * wave + e, tau0 = (tt >> 2) * 16, v0 = (tt & 3) * 16;
            f32x4 acc = {0.f, 0.f, 0.f, 0.f};
            acc = mma16(AM + tau0 * 72, 72, VT + v0 * 72, 72, tau0 < 32 ? 32 : 64, acc, lane);
            acc = mma16(QE + tau0 * 72, 72, ST + v0 * 72, 72, 64, acc, lane);
#pragma unroll
            for (int j = 0; j < 4; ++j) { const int tau = tau0 + quad * 4 + j; const int t = dir == 0 ? tau : 63 - tau;
                if (dir == 0) OB[t * 68 + v0 + r] = acc[j]; else OB[t * 68 + v0 + r] += acc[j]; } }
        if (dir == 1) {
            __syncthreads();
            const float nw = hg_norm_w_l[lane];
            const int rowbase = cstep < 4 ? ML + b * CTXL + 64 * cstep : b * SEQ + 64 * (cstep - 4);
#pragma unroll
            for (int i = 0; i < 8; ++i) { const int t = 8 * wave + i; const float v = OB[t * 68 + lane];
                const float rstd = rsqrtf(wave_sum(v * v) * (1.f / 64.f) + EPSN);
                const float gt = bf2f(Z[(size_t)(rowbase + t) * INW + ZHG + h * 64 + lane]);
                Y[(size_t)(rowbase + t) * DM + 768 + h * 64 + lane] = (bf16)f2bf(v * rstd * nw * siluf(gt)); }
        }
    }
    __syncthreads();
}

__device__ __forceinline__ void flat_barrier(unsigned* ctr, unsigned target) {
    __builtin_amdgcn_fence(__ATOMIC_RELEASE, "agent");
    asm volatile("s_waitcnt vmcnt(0)" ::: "memory");
    __syncthreads();
    if (threadIdx.x == 0) {
        __hip_atomic_fetch_add(ctr, 1u, __ATOMIC_RELEASE, __HIP_MEMORY_SCOPE_AGENT);
        while (__hip_atomic_load(ctr, __ATOMIC_ACQUIRE, __HIP_MEMORY_SCOPE_AGENT) < target) __builtin_amdgcn_s_sleep(2);
    }
    __syncthreads();
    __builtin_amdgcn_fence(__ATOMIC_ACQUIRE, "agent");
    asm volatile("s_waitcnt vmcnt(0)" ::: "memory");
}
#define XB_TMO      128
#define XB_XCNT(j)  (256  + 64 * (j))
#define XB_XSUB(j)  (1280 + 64 * (j))
#define XB_XGEN(j)  (2304 + 64 * (j))
#define XB_TOP      3328
#define XB_TOPGEN   3392
#define XCD_BAR_WORDS 3456
#define XB_SPIN_CAP (1u << 18)

__device__ __forceinline__ unsigned xb_ld(unsigned* p)              { return __hip_atomic_load(p, __ATOMIC_RELAXED, __HIP_MEMORY_SCOPE_AGENT); }
__device__ __forceinline__ unsigned xb_add(unsigned* p, unsigned v) { return __hip_atomic_fetch_add(p, v, __ATOMIC_RELAXED, __HIP_MEMORY_SCOPE_AGENT); }
__device__ __forceinline__ unsigned xb_xcc_id() { return (unsigned)__builtin_amdgcn_s_getreg((3 << 11) | 20) & 0xFu; }
#define XB_SPIN(cond, bar) do { unsigned _sp = 0; while (cond) { __builtin_amdgcn_s_sleep(1); \
    if ((++_sp & 255u) == 0u) { if (xb_ld(&(bar)[XB_TMO])) break; if (_sp > XB_SPIN_CAP) { atomicAdd(&(bar)[XB_TMO], 1u); break; } } } } while (0)

struct XcdBarrier {
    unsigned* bar; unsigned x;
    volatile LAS unsigned* st;
};

__device__ __forceinline__ XcdBarrier xcd_barrier_post(unsigned* bar, volatile LAS unsigned* st) {
    XcdBarrier b; b.bar = bar; b.x = xb_xcc_id(); b.st = st;
    if (threadIdx.x == 0) (void)xb_add(&bar[XB_XCNT(b.x)], 1u);
    return b;
}
__device__ __forceinline__ void xcd_barrier_complete(unsigned* bar, unsigned x, unsigned& nloc, unsigned& nx) {
    const unsigned G = gridDim.x * gridDim.y * gridDim.z;
    unsigned sum, cnt, mine, sp = 0u;
    for (;;) {
        sum = 0u; cnt = 0u; mine = 0u;
#pragma unroll
        for (unsigned j = 0; j < 16; ++j) { const unsigned c = xb_ld(&bar[XB_XCNT(j)]); sum += c; cnt += (c > 0u) ? 1u : 0u; mine = (j == x) ? c : mine; }
        if (sum == G) break;
        __builtin_amdgcn_s_sleep(1);
        if ((++sp & 255u) == 0u) { if (xb_ld(&bar[XB_TMO])) break; if (sp > XB_SPIN_CAP) { atomicAdd(&bar[XB_TMO], 1u); break; } }
    }
    nloc = mine > 0u ? mine : 1u; nx = cnt > 0u ? cnt : 1u;
}

__device__ __forceinline__ void xcd_barrier(const XcdBarrier& b) {
    asm volatile("s_waitcnt vmcnt(0)" ::: "memory");
    __syncthreads();
    if (threadIdx.x == 0) {
        unsigned* bar = b.bar;
        __builtin_amdgcn_s_waitcnt(0);
        unsigned nloc = b.st[0], nx = b.st[1];
        if (nloc == 0u) { xcd_barrier_complete(bar, b.x, nloc, nx); b.st[0] = nloc; b.st[1] = nx; }
        const unsigned old = xb_add(&bar[XB_XSUB(b.x)], 1u);
        const unsigned gen = old / nloc;
        if (old + 1u == (gen + 1u) * nloc) {
            __builtin_amdgcn_fence(__ATOMIC_RELEASE, "agent");
            asm volatile("s_waitcnt vmcnt(0)" ::: "memory");
            const unsigned og = xb_add(&bar[XB_TOP], 1u);
            const unsigned tg = og / nx;
            if (og + 1u == (tg + 1u) * nx) xb_add(&bar[XB_TOPGEN], 1u);
            else XB_SPIN(xb_ld(&bar[XB_TOPGEN]) == tg, bar);
            __builtin_amdgcn_fence(__ATOMIC_ACQUIRE, "agent");
            xb_add(&bar[XB_XGEN(b.x)], 1u);
            asm volatile("s_waitcnt vmcnt(0)" ::: "memory");
        } else {
            XB_SPIN(xb_ld(&bar[XB_XGEN(b.x)]) == gen, bar);
            __builtin_amdgcn_fence(__ATOMIC_ACQUIRE, "agent");
            asm volatile("s_waitcnt vmcnt(0)" ::: "memory");
        }
    }
    __syncthreads();
}

constexpr int NPHASE = 20;
#ifndef EN_MASK
#define EN_MASK 0x3ff
#endif
#define EN(k) (((EN_MASK) >> (k)) & 1)
#ifndef REP_OP0
#define REP_OP0 1
#endif
#ifndef REP_SYNC
#define REP_SYNC 0
#endif
#ifndef REP_PRO
#define REP_PRO 1
#endif
#ifndef REP_NORM
#define REP_NORM 1
#endif
#ifndef REP_MIX1
#define REP_MIX1 1
#endif
#ifndef REP_HGO
#define REP_HGO 1
#endif
#ifndef REP_GZ
#define REP_GZ 1
#endif
#ifndef REP_ATT
#define REP_ATT 1
#endif
#ifndef REP_HU
#define REP_HU 1
#endif
#ifndef REP_POOL
#define REP_POOL 1
#endif
typedef __attribute__((address_space(4))) const Params CParams;
__device__ __forceinline__ CParams* kparams() { CParams* p = (CParams*)__builtin_amdgcn_kernarg_segment_ptr(); asm volatile("" : "+s"(p)); return p; }
__device__ __forceinline__ Params ldparams(CParams* k) { Params P;
    P.x = k->x; P.c = k->c; P.ctx = k->ctx; P.c_ctx = k->c_ctx; P.w_ada = k->w_ada; P.b_ada = k->b_ada; P.norm1_w = k->norm1_w; P.w_in = k->w_in; P.pool_w = k->pool_w; P.pool_scale = k->pool_scale;
    P.attn_sink = k->attn_sink; P.hg_lower = k->hg_lower; P.hg_norm_w = k->hg_norm_w; P.w_out = k->w_out; P.norm2_w = k->norm2_w; P.w_mlp1 = k->w_mlp1; P.w_mlp2 = k->w_mlp2; P.final_norm_w = k->final_norm_w;
    P.out = k->out; P.ws = k->ws; P.ph_lo = k->ph_lo; P.ph_hi = k->ph_hi; return P; }
#define WSP(T, off) ((T*)(P.ws + (off)))
__global__ void __launch_bounds__(NTHREADS, 2) fwd_kernel(Params Parg) {
    extern __shared__ __attribute__((aligned(16))) unsigned char lds_raw[];
    LAS unsigned char* lds = (LAS unsigned char*)lds_raw;
    cg::grid_group grid = cg::this_grid();
    const int lo = Parg.ph_lo, hi = Parg.ph_hi;
    volatile LAS unsigned* bst = (volatile LAS unsigned*)(lds + LDS_BYTES - 256);
    if (threadIdx.x == 0) { bst[0] = 0u; bst[1] = 0u; }
    __syncthreads();
    const XcdBarrier xbar = xcd_barrier_post((unsigned*)(Parg.ws + WS_CTL), bst);
#define IN(k) (lo <= (k) && (k) < hi)
#define SEAM(k) do { if (IN(k) && IN((k) + 1)) { if (lo < 0) grid.sync(); else xcd_barrier(xbar); } } while (0)
    if (EN(0) && IN(0)) for (int rep = 0; rep < REP_PRO; ++rep) { const Params P = ldparams(kparams()); ph_prologue(P, lds); }
    SEAM(0);
#pragma unroll 1
    for (int l = 0; l < 2; ++l) {
        const int pb = 1 + 9 * l;
        const int mrows = l == 0 ? MT : ML;
        if (EN(1) && IN(pb + 0)) for (int rep = 0; rep < REP_NORM; ++rep) { const Params P = ldparams(kparams());
            ph_norm_mod(l == 0 ? P.x : P.out, l == 0 ? P.ctx : WSP(const float, WS_XC), MT, P.norm1_w + l * DM, WSP(const float, WS_MOD) + (size_t)l * 9 * 6144, 0, 1024, WSP(bf16, WS_ACT),
                        l == 0 ? (const float*)nullptr : WSP(const float, WS_P1), WSP(const float, WS_P2), WSP(const float, WS_P3), (l == 1 && gridDim.x == 256) ? ML : 0); }
        SEAM(pb + 0);
        if (EN(2) && IN(pb + 1)) for (int rep = 0; rep < REP_GZ; ++rep) { const Params P = ldparams(kparams());
            pg8::Gemm g{WSP(const bf16, WS_ACT), WSP(const bf16, WS_WT + (size_t)l * WT_LAYER + WT_IN), MT, INW, DM, DM}; pg8::StaticOrder S; S.init(MT, INW, gridDim.x, blockIdx.x);
            pg8::EpiBf E{WSP(bf16, WS_Z), INW, 0}; pg8::gemm_phase<pg8::EpiBf, pg8::StaticOrder, true, true>(lds, g, S, E);
            if (l == 0) {
                const int G = (int)gridDim.x, nun = (MT / 256) * (INW / 256), rem = nun % G, first = rem == 0 ? 0 : rem, nb = G - first;
                if ((int)blockIdx.x >= first) { const int t_ = otid(); const int w_ = __builtin_amdgcn_readfirstlane(t_ >> 6);
                    convert_weights(P, lds, 0, ((int)blockIdx.x - first) * 8 + w_, nb * 8, w_, t_ & 63, 1152, 5760); } } }
        SEAM(pb + 1);
        if (IN(pb + 2)) for (int rep = 0; rep < REP_MIX1; ++rep) { const Params P = ldparams(kparams());
            const bf16* Z = WSP(const bf16, WS_Z); bf16* ACT = WSP(bf16, WS_ACT);
            const int n_attn = l == 0 ? 576 : 512, n_pool = l == 0 ? 288 : 256, G = (int)gridDim.x, bx = (int)blockIdx.x;
            const int NCH = 64;
            if (G >= 2 * NCH) {
                if (bx < NCH) { if (EN(4)) hg_chain(lds, Z, WSP(const float, WS_LB) + l * 512, WSP(float, WS_S), bx); }
                else for (int it = bx - NCH; it < n_attn; it += G - NCH) { if (EN(3)) attn_unit(lds, Z, ACT, P.attn_sink + l * 8, WSP(const float2, WS_ROPE), it); }
            } else {
                for (int c = bx; c < NCH; c += G) hg_chain(lds, Z, WSP(const float, WS_LB) + l * 512, WSP(float, WS_S), c);
                for (int it = bx; it < n_attn; it += G) attn_unit(lds, Z, ACT, P.attn_sink + l * 8, WSP(const float2, WS_ROPE), it);
            }
            __syncthreads();
            {
                int j0 = bx, jstep = G;
                if (G == 256) {
                    if (l == 1) { j0 = bx >= 192 ? bx - 192 : n_pool; jstep = 64; }
                    else { if (bx >= 192) { j0 = bx - 192; jstep = 64; if (0) {} }
                           else if (bx < 160) { j0 = 128 + bx; jstep = 1024; }
                           else { j0 = n_pool; } }
                }
                const int jlim = (G == 256 && l == 0 && bx >= 192) ? 128 : n_pool;
                if (EN(5)) for (int j = j0; j < jlim; j += jstep) pool_unit(lds, Z, ACT, WSP(const bf16, WS_PWT) + (size_t)l * 4 * 64 * 64, P.pool_scale + l * 256, j);
            }
        }
        SEAM(pb + 2);
        if (EN(7) && IN(pb + 4)) for (int rep = 0; rep < REP_HGO; ++rep) { const Params P = ldparams(kparams());
            const int n_u = l == 0 ? 8 * 36 * 4 : 8 * 32 * 4;
            ph_hgO(lds, WSP(const bf16, WS_Z), WSP(bf16, WS_ACT), WSP(const float, WS_LB) + l * 512, WSP(const float, WS_S), P.hg_norm_w + l * 64, l, n_u);
        }
        SEAM(pb + 4);
        const bool fuse_n2 = (gridDim.x == 256);
        if (EN(8) && IN(pb + 5) && fuse_n2) { const Params P = ldparams(kparams());
            { pg8::Gemm g{WSP(const bf16, WS_ACT), WSP(const bf16, WS_WT + (size_t)l * WT_LAYER + WT_OUT), ML, DM, DM, DM}; pg8::StaticOrder S; S.init(ML, DM, gridDim.x, blockIdx.x);
              const float* modl = WSP(const float, WS_MOD) + (size_t)l * 9 * 6144;
              pg8::EpiNorm2 E{l == 0 ? P.x : P.out, P.out, modl + 2048, P.norm2_w + l * DM, modl + 4096, modl + 3072, WSP(bf16, WS_ACT), WSP(unsigned long long, WS_FSLOT + (l == 0 ? 1536 : 512) * 1024), WSP(unsigned, WS_CTL) + (l == 0 ? 16384 : 8192), EPSN, 0, -1};
              pg8::gemm_phase<pg8::EpiNorm2, pg8::StaticOrder, false, true>(lds, g, S, E); }
            if (l == 0) {
                pg8::Gemm g{WSP(const bf16, WS_ACT), WSP(const bf16, WS_WT + WT_OUT), MT, DM, DM, DM}; pg8::SplitOrder S{64, 8, 4, 1, (int)gridDim.x, (int)blockIdx.x};
                const float* mod0 = WSP(const float, WS_MOD);
                pg8::EpiNorm2 E{P.ctx, WSP(float, WS_XC), mod0 + 2048, P.norm2_w, mod0 + 4096, mod0 + 3072, WSP(bf16, WS_ACT), WSP(unsigned long long, WS_FSLOT + 2048 * 1024), WSP(unsigned, WS_CTL) + 20480, EPSN, 64, 8};
                pg8::gemm_phase<pg8::EpiNorm2, pg8::SplitOrder, false, true>(lds, g, S, E);
                if ((int)blockIdx.x >= 32) { const int t_ = otid(); const int w_ = __builtin_amdgcn_readfirstlane(t_ >> 6);
                    convert_weights(P, lds, 1, ((int)blockIdx.x - 32) * 8 + w_, ((int)gridDim.x - 32) * 8, w_, t_ & 63, 0, 5760); } } }
        if (EN(8) && IN(pb + 5) && !fuse_n2) for (int rep = 0; rep < (l == 0 ? REP_OP0 : 1); ++rep) { const Params P = ldparams(kparams());
            pg8::Gemm g{WSP(const bf16, WS_ACT), WSP(const bf16, WS_WT + (size_t)l * WT_LAYER + WT_OUT), mrows, DM, DM, DM}; pg8::StaticOrder S; S.init(mrows, DM, gridDim.x, blockIdx.x);
            pg8::EpiRes E{l == 0 ? P.x : P.out, l == 0 ? P.ctx : WSP(const float, WS_XC), P.out, WSP(float, WS_XC), WSP(const float, WS_MOD) + (size_t)l * 9 * 6144 + 2048};
            pg8::gemm_phase<pg8::EpiRes, pg8::StaticOrder, true, true>(lds, g, S, E);
            if (l == 0) {
                const int G = (int)gridDim.x, nun = (MT / 256) * (DM / 256), rem = nun % G, first = rem == 0 ? 0 : rem, nb = G - first;
                if ((int)blockIdx.x >= first) { const int t_ = otid(); const int w_ = __builtin_amdgcn_readfirstlane(t_ >> 6);
                    convert_weights(P, lds, 1, ((int)blockIdx.x - first) * 8 + w_, nb * 8, w_, t_ & 63, 0, 5760); } } }
        if (!fuse_n2) SEAM(pb + 5);
        if (EN(1) && IN(pb + 6) && !fuse_n2) for (int rep = 0; rep < REP_NORM; ++rep) { const Params P = ldparams(kparams());
            ph_norm_mod(P.out, WSP(const float, WS_XC), mrows, P.norm2_w + l * DM, WSP(const float, WS_MOD) + (size_t)l * 9 * 6144, 3072, 4096, WSP(bf16, WS_ACT), nullptr, nullptr, nullptr, fuse_n2 ? ML : 0); }
        SEAM(pb + 6);
        if (EN(2) && IN(pb + 7)) for (int rep = 0; rep < REP_GZ; ++rep) { const Params P = ldparams(kparams());
            pg8::Gemm g{WSP(const bf16, WS_ACT), WSP(const bf16, WS_WT + (size_t)l * WT_LAYER + WT_W1), mrows, DFF, DM, DM}; pg8::StaticOrder S; S.init(mrows, DFF, gridDim.x, blockIdx.x);
            pg8::EpiBf E{WSP(bf16, WS_HH), DFF, 1}; pg8::gemm_phase<pg8::EpiBf, pg8::StaticOrder, true, true>(lds, g, S, E); }
        SEAM(pb + 7);
        if (EN(8) && IN(pb + 8)) { const Params P = ldparams(kparams());
            if (l == 1 && gridDim.x == 256) {
              pg8::Gemm g{WSP(const bf16, WS_HH), WSP(const bf16, WS_WT + (size_t)l * WT_LAYER + WT_W2), ML, DM, DFF, DFF}; pg8::StaticOrder S; S.init(ML, DM, gridDim.x, blockIdx.x);
              pg8::EpiFinal E{P.out, P.out, WSP(const float, WS_MOD) + (size_t)l * 9 * 6144 + 5120, P.final_norm_w, WSP(unsigned long long, WS_FSLOT), WSP(unsigned, WS_CTL) + 4096, EPSN};
              pg8::gemm_phase<pg8::EpiFinal, pg8::StaticOrder, false, true>(lds, g, S, E); }
            else
            if (l == 0 && gridDim.x == 256) {
              pg8::Gemm g{WSP(const bf16, WS_HH), WSP(const bf16, WS_WT + WT_W2), ML, DM, DFF, DFF}; pg8::StaticOrder S; S.init(ML, DM, gridDim.x, blockIdx.x);
              const float* mod0 = WSP(const float, WS_MOD); const float* mod1 = mod0 + 9 * 6144;
              pg8::EpiNorm2 E{P.out, P.out, mod0 + 5120, P.norm1_w + DM, mod1 + 1024, mod1 + 0, WSP(bf16, WS_ACT), WSP(unsigned long long, WS_FSLOT + 1024 * 1024), WSP(unsigned, WS_CTL) + 12288, EPSN, 0, -1};
              pg8::gemm_phase<pg8::EpiNorm2, pg8::StaticOrder, false, true>(lds, g, S, E); }
            else
            { pg8::Gemm g{WSP(const bf16, WS_HH), WSP(const bf16, WS_WT + (size_t)l * WT_LAYER + WT_W2), ML, DM, DFF, DFF}; pg8::StaticOrder S; S.init(ML, DM, gridDim.x, blockIdx.x);
              pg8::EpiRes E{P.out, WSP(const float, WS_XC), P.out, WSP(float, WS_XC), WSP(const float, WS_MOD) + (size_t)l * 9 * 6144 + 5120};
              pg8::gemm_phase<pg8::EpiRes, pg8::StaticOrder, true, true>(lds, g, S, E); }
            if (l == 0) {
              pg8::Gemm g{WSP(const bf16, WS_HH), WSP(const bf16, WS_WT + WT_W2), MT, DM, 1024, DFF}; pg8::SplitOrder S{64, 8, 4, 4, (int)gridDim.x, (int)blockIdx.x};
              pg8::EpiPart E{WSP(float, WS_XC), WSP(float, WS_P1), WSP(float, WS_P2), WSP(float, WS_P3), WSP(const float, WS_MOD) + 8 * 6144 + 5120};
              pg8::gemm_phase<pg8::EpiPart, pg8::SplitOrder, true, true>(lds, g, S, E); } }
        if (!(l == 1 && gridDim.x == 256)) SEAM(pb + 8);
    }
    for (int rep = 0; rep < REP_SYNC; ++rep) xcd_barrier(xbar);
    if (EN(9) && IN(19) && gridDim.x != 256) { const Params P = ldparams(kparams()); ph_final_norm(P.out, P.final_norm_w, P.out); }
#undef IN
#undef SEAM
}

#ifndef N_LAUNCH_MODE
#define N_LAUNCH_MODE 1
#endif
extern "C" void kernel_launch(void* const* d_in, const int* in_sizes, int n_in, void* d_out, int out_size, void* d_ws, size_t ws_size, hipStream_t stream) {
    static int grid = 0;
    if (grid == 0) {
        if (n_in != 18 || out_size != ML * DM || ws_size < WS_END) { fprintf(stderr, "kernel_launch: unexpected shapes (n_in %d out %d ws %zu)\n", n_in, out_size, ws_size); grid = -1; return; }
        int dev = 0, cus = 0, per_cu = 0;
        hipGetDevice(&dev); hipDeviceGetAttribute(&cus, hipDeviceAttributeMultiprocessorCount, dev);
        hipFuncSetAttribute((const void*)fwd_kernel, hipFuncAttributeMaxDynamicSharedMemorySize, LDS_BYTES);
        hipOccupancyMaxActiveBlocksPerMultiprocessor(&per_cu, (const void*)fwd_kernel, NTHREADS, LDS_BYTES);
        if (per_cu < 1) { fprintf(stderr, "kernel_launch: occupancy query returned %d\n", per_cu); per_cu = 1; }
        grid = cus * per_cu;
        fprintf(stderr, "kernel_launch: cus %d per_cu %d grid %d\n", cus, per_cu, grid);
    }
    if (grid < 0) return;
    hipMemsetAsync((unsigned char*)d_ws + WS_CTL, 0, CTL_BYTES, stream);
    Params p{};
    const float** pp = (const float**)&p;
    for (int i = 0; i < 18; ++i) pp[i] = (const float*)d_in[i];
    p.out = (float*)d_out; p.ws = (unsigned char*)d_ws;
#if N_LAUNCH_MODE == 1
    p.ph_lo = 0; p.ph_hi = NPHASE;
    void* args[] = {&p};
    hipError_t e = hipLaunchCooperativeKernel((const void*)fwd_kernel, dim3(grid), dim3(NTHREADS), args, LDS_BYTES, stream);
    if (e != hipSuccess) fprintf(stderr, "cooperative launch failed: %s (grid %d)\n", hipGetErrorString(e), grid);
#else
    for (int k = 0; k < NPHASE; ++k) { p.ph_lo = k; p.ph_hi = k + 1;
        hipLaunchKernelGGL(fwd_kernel, dim3(grid), dim3(NTHREADS), LDS_BYTES, stream, p); }
#endif
}
```

```cpp
#include <hip/hip_runtime.h>
#include <hip/hip_cooperative_groups.h>
#include <cstdio>
#include <cstdint>
namespace cg = cooperative_groups;
namespace pg8 {
#define PG8_LAS __attribute__((address_space(3)))
typedef unsigned short bf16_t;
typedef short bf16x8 __attribute__((ext_vector_type(8)));
typedef float f32x4 __attribute__((ext_vector_type(4)));
typedef unsigned u32x4 __attribute__((ext_vector_type(4)));
constexpr int BM = 256, BK = 64, HALF = 128, HTB = HALF * BK * 2  , STAGE_BYTES = 8 * HTB, NXCD = 8, WGM = 4;

__host__ __device__ __forceinline__ int lds_byte(int r, int c) { const int st = (r >> 4) * 2 + (c >> 5), rr = r & 15, cc = c & 31, ob = rr * 64 + cc * 2; return st * 1024 + (ob ^ (((ob >> 9) & 1) << 5)); }
__host__ __device__ __forceinline__ void stage_rc(int b, int& R, int& C) { const int st = b / 1024, sb = b % 1024, swz = sb ^ (((sb >> 9) & 1) << 5); R = (st >> 1) * 16 + swz / 64; C = (st & 1) * 32 + (swz % 64) / 2; }
__host__ __device__ __forceinline__ int perm32(int rho) { const int n = rho >> 4, i = rho & 15; return 8 * (i >> 2) + 4 * n + (i & 3); }

struct Unit { int pm, pn, ks; };
struct Gemm { const bf16_t* A; const bf16_t* Bt; int M, N, K, ld; };

struct StaticOrder {
    int nM, nN, nwg, G, c;
    __host__ __device__ void init(int M, int N, int G_, int c_) { nM = M / BM; nN = N / BM; nwg = nM * nN; G = G_; c = c_; }
    __host__ __device__ bool next(int i, Unit& u) const {
        const long L = (long)i * G + c; if (L >= nwg) return false;
        int wgid = (int)L; { const int q = nwg / NXCD, r = nwg % NXCD, xcd = wgid % NXCD, off = wgid / NXCD; wgid = (xcd < r ? xcd * (q + 1) : r * (q + 1) + (xcd - r) * q) + off; }
        const int nig = WGM * nN, gid = wgid / nig, fm = gid * WGM, gsz = (nM - fm) < WGM ? (nM - fm) : WGM;
        u.pm = fm + ((wgid % nig) % gsz); u.pn = (wgid % nig) / gsz; u.ks = 0; return true;
    }
    __device__ __forceinline__ void a_ready(const Unit&) const {}
    __device__ __forceinline__ void done(const Unit&) const {}
};
__device__ __forceinline__ unsigned cvt_pk_bf16(float lo, float hi) { unsigned r; asm volatile("v_cvt_pk_bf16_f32 %0, %1, %2" : "=v"(r) : "v"(lo), "v"(hi)); return r; }
typedef float f32x2 __attribute__((ext_vector_type(2)));
struct EpiBf {
    static constexpr bool PERM = true, AFTER_DRAIN = false;
    bf16_t* O; int ldc; int act;
    __device__ __forceinline__ void operator()(const f32x4 (&acc)[2][2][4][2], const Unit& u, int wr, int wc, int fr, int fq) const {
        const int row0 = u.pm * BM + wr * 64 + fr; const int col0 = u.pn * BM + wc * 32 + 8 * fq;
#pragma unroll
        for (int ai = 0; ai < 2; ++ai)
#pragma unroll
            for (int m = 0; m < 4; ++m) { bf16_t* rowp = O + (size_t)(row0 + ai * HALF + m * 16) * ldc + col0;
#pragma unroll
                for (int bj = 0; bj < 2; ++bj) { f32x4 v0 = acc[ai][bj][m][0], v1 = acc[ai][bj][m][1];
                    if (act) {
#pragma unroll
                        for (int e = 0; e < 4; ++e) { float a = fmaxf(v0[e], 0.f), b = fmaxf(v1[e], 0.f); v0[e] = a * a; v1[e] = b * b; } }
                    u32x4 w; w.x = cvt_pk_bf16(v0[0], v0[1]); w.y = cvt_pk_bf16(v0[2], v0[3]); w.z = cvt_pk_bf16(v1[0], v1[1]); w.w = cvt_pk_bf16(v1[2], v1[3]);
                    *(u32x4*)(rowp + bj * HALF) = w; } }
    }
};
struct EpiRes {
    static constexpr bool PERM = false, AFTER_DRAIN = false;
    const float* res_lat; const float* res_ctx; float* out_lat; float* out_ctx; const float* gate;
    __device__ __forceinline__ void operator()(const f32x4 (&acc)[2][2][4][2], const Unit& u, int wr, int wc, int fr, int fq) const {
        const bool lat = u.pm < 64;
        const float* res = lat ? res_lat + (size_t)u.pm * BM * 1024 : res_ctx + (size_t)(u.pm - 64) * BM * 1024;
        float* out = lat ? out_lat + (size_t)u.pm * BM * 1024 : out_ctx + (size_t)(u.pm - 64) * BM * 1024;
        const float* g = gate + (size_t)(lat ? (u.pm >> 3) : 8) * 6144;
        const int col0 = u.pn * BM + wc * 32 + 4 * fq;
        f32x4 gv[2][2];
#pragma unroll
        for (int bj = 0; bj < 2; ++bj)
#pragma unroll
            for (int n = 0; n < 2; ++n) gv[bj][n] = *(const f32x4*)(g + col0 + bj * HALF + n * 16);
#pragma unroll
        for (int ai = 0; ai < 2; ++ai)
#pragma unroll
            for (int m = 0; m < 4; ++m) { const size_t off = (size_t)(ai * HALF + wr * 64 + m * 16 + fr) * 1024 + col0;
#pragma unroll
                for (int bj = 0; bj < 2; ++bj)
#pragma unroll
                    for (int n = 0; n < 2; ++n) { const f32x4 r = *(const f32x4*)(res + off + bj * HALF + n * 16);
                        *(f32x4*)(out + off + bj * HALF + n * 16) = r + gv[bj][n] * acc[ai][bj][m][n]; } }
    }
};

struct SplitOrder {
    int pm0, npm, nN, nks, G, c;
    __device__ __forceinline__ bool next(int i, Unit& u) const { const int L = i * G + c; if (L >= npm * nN * nks) return false;
        u.ks = L % nks; const int t = L / nks; u.pn = t % nN; u.pm = pm0 + t / nN; return true; }
    __device__ __forceinline__ void a_ready(const Unit&) const {}
    __device__ __forceinline__ void done(const Unit&) const {}
};
struct EpiPart {
    static constexpr bool PERM = false, AFTER_DRAIN = false;
    float* xc; float* p1; float* p2; float* p3; const float* gate;
    __device__ __forceinline__ void operator()(const f32x4 (&acc)[2][2][4][2], const Unit& u, int wr, int wc, int fr, int fq) const {
        float* base = u.ks == 0 ? xc : (u.ks == 1 ? p1 : (u.ks == 2 ? p2 : p3));
        float* out = base + (size_t)(u.pm - 64) * BM * 1024;
        const bool inplace = u.ks == 0;
        const int col0 = u.pn * BM + wc * 32 + 4 * fq;
        f32x4 gv[2][2];
#pragma unroll
        for (int bj = 0; bj < 2; ++bj)
#pragma unroll
            for (int n = 0; n < 2; ++n) gv[bj][n] = *(const f32x4*)(gate + col0 + bj * HALF + n * 16);
#pragma unroll
        for (int ai = 0; ai < 2; ++ai)
#pragma unroll
            for (int m = 0; m < 4; ++m) { const size_t off = (size_t)(ai * HALF + wr * 64 + m * 16 + fr) * 1024 + col0;
#pragma unroll
                for (int bj = 0; bj < 2; ++bj)
#pragma unroll
                    for (int n = 0; n < 2; ++n) { f32x4 v = gv[bj][n] * acc[ai][bj][m][n]; float* p = out + off + bj * HALF + n * 16;
                        if (inplace) v = v + *(const f32x4*)p;
                        *(f32x4*)p = v; } }
    }
};

typedef unsigned epi_u32x2 __attribute__((ext_vector_type(2)));
struct EpiFinal {
    static constexpr bool PERM = false, AFTER_DRAIN = true;
    const float* res; float* out; const float* gate; const float* w; unsigned long long* slots; unsigned* cnt; float eps;
    __device__ __forceinline__ void operator()(const f32x4 (&)[2][2][4][2], const Unit&, int, int, int, int) const {}
    __device__ __forceinline__ void fused(f32x4 (&acc)[2][2][4][2], const Unit& u, int wr, int wc, int fr, int fq, PG8_LAS unsigned char* lds, int wid, int lane) const {
        const float* rs = res + (size_t)u.pm * BM * 1024; float* o = out + (size_t)u.pm * BM * 1024;
        const float* g = gate + (size_t)(u.pm >> 3) * 6144;
        const int col0 = u.pn * BM + wc * 32 + 4 * fq;
        PG8_LAS float* Pp = (PG8_LAS float*)lds;
        PG8_LAS float* Sr = (PG8_LAS float*)(lds + 4096);
        f32x4 gv[2][2];
#pragma unroll
        for (int bj = 0; bj < 2; ++bj)
#pragma unroll
            for (int n = 0; n < 2; ++n) gv[bj][n] = *(const f32x4*)(g + col0 + bj * HALF + n * 16);
#pragma unroll
        for (int ai = 0; ai < 2; ++ai)
#pragma unroll
            for (int m = 0; m < 4; ++m) { const int row = ai * HALF + wr * 64 + m * 16 + fr; const size_t off = (size_t)row * 1024 + col0; float s = 0.f;
#pragma unroll
                for (int bj = 0; bj < 2; ++bj)
#pragma unroll
                    for (int n = 0; n < 2; ++n) { const f32x4 r = *(const f32x4*)(rs + off + bj * HALF + n * 16); const f32x4 x = r + gv[bj][n] * acc[ai][bj][m][n]; acc[ai][bj][m][n] = x;
                        s += (x[0] * x[0] + x[1] * x[1]) + (x[2] * x[2] + x[3] * x[3]); }
                { const epi_u32x2 t = __builtin_amdgcn_permlane16_swap(__float_as_uint(s), __float_as_uint(s), false, false); s = __uint_as_float(t.x) + __uint_as_float(t.y); }
                { const epi_u32x2 t = __builtin_amdgcn_permlane32_swap(__float_as_uint(s), __float_as_uint(s), false, false); s = __uint_as_float(t.x) + __uint_as_float(t.y); }
                if (fq == 0) Pp[row * 4 + wc] = s; }
        asm volatile("s_waitcnt lgkmcnt(0)" ::: "memory"); __builtin_amdgcn_s_barrier(); asm volatile("" ::: "memory");
        const int tid = wid * 64 + lane;
        if (tid < 256) { const f32x4 p = *(const PG8_LAS f32x4*)(Pp + tid * 4); const float tot = (p[0] + p[1]) + (p[2] + p[3]);
            __hip_atomic_store(slots + ((size_t)(u.pm * 4 + u.pn) * 256 + tid), (unsigned long long)__float_as_uint(tot) | (1ull << 32), __ATOMIC_RELAXED, __HIP_MEMORY_SCOPE_AGENT); }
        asm volatile("s_waitcnt vmcnt(0)" ::: "memory"); __builtin_amdgcn_s_barrier(); asm volatile("" ::: "memory");
        if (tid == 0) { __hip_atomic_fetch_add(cnt + 64 * u.pm, 1u, __ATOMIC_RELAXED, __HIP_MEMORY_SCOPE_AGENT);
            unsigned sp = 0; while (__hip_atomic_load(cnt + 64 * u.pm, __ATOMIC_RELAXED, __HIP_MEMORY_SCOPE_AGENT) < 4u) { __builtin_amdgcn_s_sleep(1); if (++sp > (1u << 20)) break; } }
        asm volatile("s_waitcnt vmcnt(0) lgkmcnt(0)" ::: "memory"); __builtin_amdgcn_s_barrier(); asm volatile("" ::: "memory");
        if (tid < 256) { float tot = 0.f;
#pragma unroll
            for (int t = 0; t < 4; ++t) tot += __uint_as_float((unsigned)__hip_atomic_load(slots + ((size_t)(u.pm * 4 + t) * 256 + tid), __ATOMIC_RELAXED, __HIP_MEMORY_SCOPE_AGENT));
            Sr[tid] = 1.0f / sqrtf(tot * (1.0f / 1024.0f) + eps); }
        asm volatile("s_waitcnt vmcnt(0) lgkmcnt(0)" ::: "memory"); __builtin_amdgcn_s_barrier(); asm volatile("" ::: "memory");
        f32x4 wv[2][2];
#pragma unroll
        for (int bj = 0; bj < 2; ++bj)
#pragma unroll
            for (int n = 0; n < 2; ++n) wv[bj][n] = *(const f32x4*)(w + col0 + bj * HALF + n * 16);
#pragma unroll
        for (int ai = 0; ai < 2; ++ai)
#pragma unroll
            for (int m = 0; m < 4; ++m) { const int row = ai * HALF + wr * 64 + m * 16 + fr; const size_t off = (size_t)row * 1024 + col0; const float rstd = Sr[row];
#pragma unroll
                for (int bj = 0; bj < 2; ++bj)
#pragma unroll
                    for (int n = 0; n < 2; ++n) *(f32x4*)(o + off + bj * HALF + n * 16) = acc[ai][bj][m][n] * rstd * wv[bj][n]; }
        asm volatile("s_waitcnt lgkmcnt(0)" ::: "memory"); __builtin_amdgcn_s_barrier(); asm volatile("" ::: "memory");
    }
};

struct EpiNorm2 {
    static constexpr bool PERM = false, AFTER_DRAIN = true;
    const float* res; float* out; const float* gate; const float* nw; const float* ms; const float* msh; bf16_t* hb; unsigned long long* slots; unsigned* cnt; float eps; int pm_sub; int mrow_c;
    __device__ __forceinline__ void operator()(const f32x4 (&)[2][2][4][2], const Unit&, int, int, int, int) const {}
    __device__ __forceinline__ void fused(f32x4 (&acc)[2][2][4][2], const Unit& u, int wr, int wc, int fr, int fq, PG8_LAS unsigned char* lds, int wid, int lane) const {
        const int pl = u.pm - pm_sub;
        const float* rs = res + (size_t)pl * BM * 1024; float* o = out + (size_t)pl * BM * 1024; bf16_t* hp = hb + (size_t)u.pm * BM * 1024;
        const size_t mrow = (size_t)(mrow_c >= 0 ? mrow_c : (u.pm >> 3)) * 6144;
        const int col0 = u.pn * BM + wc * 32 + 4 * fq;
        PG8_LAS float* Pp = (PG8_LAS float*)lds;
        PG8_LAS float* Sr = (PG8_LAS float*)(lds + 4096);
        f32x4 gv[2][2];
#pragma unroll
        for (int bj = 0; bj < 2; ++bj)
#pragma unroll
            for (int n = 0; n < 2; ++n) gv[bj][n] = *(const f32x4*)(gate + mrow + col0 + bj * HALF + n * 16);
#pragma unroll
        for (int ai = 0; ai < 2; ++ai)
#pragma unroll
            for (int m = 0; m < 4; ++m) { const int row = ai * HALF + wr * 64 + m * 16 + fr; const size_t off = (size_t)row * 1024 + col0; float s = 0.f;
#pragma unroll
                for (int bj = 0; bj < 2; ++bj)
#pragma unroll
                    for (int n = 0; n < 2; ++n) { const f32x4 r = *(const f32x4*)(rs + off + bj * HALF + n * 16); const f32x4 x = r + gv[bj][n] * acc[ai][bj][m][n]; acc[ai][bj][m][n] = x;
                        *(f32x4*)(o + off + bj * HALF + n * 16) = x;
                        s += (x[0] * x[0] + x[1] * x[1]) + (x[2] * x[2] + x[3] * x[3]); }
                { const epi_u32x2 t = __builtin_amdgcn_permlane16_swap(__float_as_uint(s), __float_as_uint(s), false, false); s = __uint_as_float(t.x) + __uint_as_float(t.y); }
                { const epi_u32x2 t = __builtin_amdgcn_permlane32_swap(__float_as_uint(s), __float_as_uint(s), false, false); s = __uint_as_float(t.x) + __uint_as_float(t.y); }
                if (fq == 0) Pp[row * 4 + wc] = s; }
        asm volatile("s_waitcnt lgkmcnt(0)" ::: "memory"); __builtin_amdgcn_s_barrier(); asm volatile("" ::: "memory");
        const int tid = wid * 64 + lane;
        if (tid < 256) { const f32x4 p = *(const PG8_LAS f32x4*)(Pp + tid * 4); const float tot = (p[0] + p[1]) + (p[2] + p[3]);
            __hip_atomic_store(slots + ((size_t)(pl * 4 + u.pn) * 256 + tid), (unsigned long long)__float_as_uint(tot) | (1ull << 32), __ATOMIC_RELAXED, __HIP_MEMORY_SCOPE_AGENT); }
        asm volatile("s_waitcnt vmcnt(0)" ::: "memory"); __builtin_amdgcn_s_barrier(); asm volatile("" ::: "memory");
        if (tid == 0) { __hip_atomic_fetch_add(cnt + 64 * pl, 1u, __ATOMIC_RELAXED, __HIP_MEMORY_SCOPE_AGENT);
            unsigned sp = 0; while (__hip_atomic_load(cnt + 64 * pl, __ATOMIC_RELAXED, __HIP_MEMORY_SCOPE_AGENT) < 4u) { __builtin_amdgcn_s_sleep(1); if (++sp > (1u << 20)) break; } }
        asm volatile("s_waitcnt vmcnt(0) lgkmcnt(0)" ::: "memory"); __builtin_amdgcn_s_barrier(); asm volatile("" ::: "memory");
        if (tid < 256) { float tot = 0.f;
#pragma unroll
            for (int t = 0; t < 4; ++t) tot += __uint_as_float((unsigned)__hip_atomic_load(slots + ((size_t)(pl * 4 + t) * 256 + tid), __ATOMIC_RELAXED, __HIP_MEMORY_SCOPE_AGENT));
            Sr[tid] = 1.0f / sqrtf(tot * (1.0f / 1024.0f) + eps); }
        asm volatile("s_waitcnt vmcnt(0) lgkmcnt(0)" ::: "memory"); __builtin_amdgcn_s_barrier(); asm volatile("" ::: "memory");
        f32x4 cv[2][2], hv[2][2];
#pragma unroll
        for (int bj = 0; bj < 2; ++bj)
#pragma unroll
            for (int n = 0; n < 2; ++n) { const int c = col0 + bj * HALF + n * 16; cv[bj][n] = *(const f32x4*)(nw + c) * (1.0f + *(const f32x4*)(ms + mrow + c)); hv[bj][n] = *(const f32x4*)(msh + mrow + c); }
#pragma unroll
        for (int ai = 0; ai < 2; ++ai)
#pragma unroll
            for (int m = 0; m < 4; ++m) { const int row = ai * HALF + wr * 64 + m * 16 + fr; const size_t off = (size_t)row * 1024 + col0; const float rstd = Sr[row];
#pragma unroll
                for (int bj = 0; bj < 2; ++bj)
#pragma unroll
                    for (int n = 0; n < 2; ++n) { const f32x4 h = acc[ai][bj][m][n] * rstd * cv[bj][n] + hv[bj][n];
                        epi_u32x2 pk; pk.x = cvt_pk_bf16(h[0], h[1]); pk.y = cvt_pk_bf16(h[2], h[3]); *(epi_u32x2*)(hp + off + bj * HALF + n * 16) = pk; } }
        asm volatile("s_waitcnt lgkmcnt(0)" ::: "memory"); __builtin_amdgcn_s_barrier(); asm volatile("" ::: "memory");
    }
};
template <class Epi, class Sched, bool ALIGN_EPI = false, bool SP2 = false>
__device__ __forceinline__ void gemm_phase(PG8_LAS unsigned char* lds, const Gemm g, const Sched& S, const Epi& E) {
    int tid_o = threadIdx.x; asm volatile("" : "+v"(tid_o));
    const int tid = tid_o, wid = __builtin_amdgcn_readfirstlane(tid >> 6), lane = tid & 63, wr = wid >> 2, wc = wid & 3, fr = lane & 15, fq = lane >> 4;
    const int K = g.K, nt = K / BK;
    unsigned voffA[2], voffB[2];
#pragma unroll
    for (int i = 0; i < 2; ++i) { int R, C; stage_rc(tid * 16 + i * 8192, R, C); const int Rb = Epi::PERM ? ((R & ~31) + perm32(R & 31)) : R;
        voffA[i] = (unsigned)(R * g.ld + C) * 2u; voffB[i] = (unsigned)(Rb * g.ld + C) * 2u; }
    const size_t kstep = (size_t)(BK * 2);
    const size_t hstep = (size_t)HALF * g.ld * 2;
    const size_t tstep = 2 * hstep;
    const unsigned ldsw = (unsigned)wid * 1024u;
    const int aoff = lds_byte(wr * 64 + fr, fq * 8), boff = lds_byte(wc * 32 + fr, fq * 8);
#define PG8_SA(b, h) (((b) * 2 + (h)) * HTB)
#define PG8_SB(b, h) ((4 + (b) * 2 + (h)) * HTB)
#define PG8_STAGE(bufoff, gbase, voff) do { _Pragma("unroll") for (int _i = 0; _i < 2; ++_i) \
        __builtin_amdgcn_global_load_lds((const unsigned*)((const char*)(gbase) + (voff)[_i]), (PG8_LAS unsigned*)(lds + (bufoff) + ldsw + _i * 8192), 16, 0, 0); } while (0)
#define PG8_LDA(dst, b, h) do { _Pragma("unroll") for (int m = 0; m < 4; ++m) _Pragma("unroll") for (int k = 0; k < 2; ++k) dst[m][k] = *(const PG8_LAS bf16x8*)(lds + PG8_SA(b, h) + aoff + m * 2048 + k * 1024); } while (0)
#define PG8_LDB(dst, b, h) do { _Pragma("unroll") for (int n = 0; n < 2; ++n) _Pragma("unroll") for (int k = 0; k < 2; ++k) dst[n][k] = *(const PG8_LAS bf16x8*)(lds + PG8_SB(b, h) + boff + n * 2048 + k * 1024); } while (0)
#define PG8_MMA(ai, bj, At, Bt) do { __builtin_amdgcn_s_setprio(1); _Pragma("unroll") for (int m = 0; m < 4; ++m) _Pragma("unroll") for (int n = 0; n < 2; ++n) _Pragma("unroll") for (int k = 0; k < 2; ++k) \
        acc[ai][bj][m][n] = __builtin_amdgcn_mfma_f32_16x16x32_bf16(Bt[n][k], At[m][k], acc[ai][bj][m][n], 0, 0, 0); __builtin_amdgcn_s_setprio(0); } while (0)
#define PG8_WAIT_V(n) asm volatile("s_waitcnt vmcnt(" #n ")" ::: "memory")
#define PG8_WAIT_L(n) asm volatile("s_waitcnt lgkmcnt(" #n ")" ::: "memory")
#define PG8_BAR __builtin_amdgcn_s_barrier()
#define PG8_SCHED __builtin_amdgcn_sched_barrier(0)
    Unit cur, nxt; int ui = 0;
    if (!S.next(0, cur)) return;
    f32x4 acc[2][2][4][2];
#pragma unroll
    for (int a = 0; a < 2; ++a)
#pragma unroll
        for (int b = 0; b < 2; ++b)
#pragma unroll
            for (int m = 0; m < 4; ++m)
#pragma unroll
                for (int n = 0; n < 2; ++n) acc[a][b][m][n] = (f32x4){0.f, 0.f, 0.f, 0.f};
    bf16x8 At[4][2], B0[2][2], B1[2][2];
    const char* cA = (const char*)g.A + (size_t)cur.pm * tstep + (size_t)cur.ks * K * 2; const char* cB = (const char*)g.Bt + (size_t)cur.pn * tstep + (size_t)cur.ks * K * 2;
    S.a_ready(cur);
    if constexpr (SP2) {
        PG8_STAGE(PG8_SB(0, 0), cB, voffB); PG8_STAGE(PG8_SB(0, 1), cB + hstep, voffB); PG8_STAGE(PG8_SA(0, 0), cA, voffA); PG8_STAGE(PG8_SA(0, 1), cA + hstep, voffA);
        if (wr == 1) PG8_BAR;
        PG8_WAIT_V(2); PG8_BAR;
        PG8_STAGE(PG8_SB(1, 0), cB + kstep, voffB); PG8_STAGE(PG8_SA(1, 0), cA + kstep, voffA); PG8_STAGE(PG8_SB(1, 1), cB + hstep + kstep, voffB);
        PG8_WAIT_V(6); PG8_BAR;
    } else {
        PG8_STAGE(PG8_SB(0, 0), cB, voffB); PG8_STAGE(PG8_SA(0, 0), cA, voffA); PG8_STAGE(PG8_SB(0, 1), cB + hstep, voffB); PG8_STAGE(PG8_SA(0, 1), cA + hstep, voffA);
        if (wr == 1) PG8_BAR;
        PG8_WAIT_V(4); PG8_BAR;
        PG8_STAGE(PG8_SB(1, 0), cB + kstep, voffB); PG8_STAGE(PG8_SA(1, 0), cA + kstep, voffA); PG8_STAGE(PG8_SB(1, 1), cB + hstep + kstep, voffB);
        PG8_WAIT_V(6); PG8_BAR;
    }
    for (;;) {
        const bool has_next = S.next(ui + 1, nxt);
        const char* nA = has_next ? (const char*)g.A + (size_t)nxt.pm * tstep + (size_t)nxt.ks * K * 2 : cA; const char* nB = has_next ? (const char*)g.Bt + (size_t)nxt.pn * tstep + (size_t)nxt.ks * K * 2 : cB;
        for (int t = 0; t < nt; t += 2) {
            const bool last = (t == nt - 2);
            const char* a1 = cA + (size_t)(t + 1) * kstep;
            const char* a2 = last ? nA : cA + (size_t)(t + 2) * kstep; const char* b2 = last ? nB : cB + (size_t)(t + 2) * kstep;
            const char* a3 = a2 + kstep; const char* b3 = b2 + kstep;
            if (last && has_next) S.a_ready(nxt);
            if constexpr (SP2) {
            PG8_LDB(B0, 0, 0); PG8_LDB(B1, 0, 1); PG8_SCHED; PG8_LDA(At, 0, 0); PG8_STAGE(PG8_SA(1, 1), a1 + hstep, voffA);
            PG8_WAIT_V(8); PG8_WAIT_L(0); PG8_BAR; PG8_MMA(0, 0, At, B0); PG8_MMA(0, 1, At, B1); PG8_BAR; PG8_SCHED;
            PG8_LDA(At, 0, 1); PG8_STAGE(PG8_SB(0, 0), b2, voffB); PG8_STAGE(PG8_SB(0, 1), b2 + hstep, voffB); PG8_STAGE(PG8_SA(0, 0), a2, voffA);
            PG8_WAIT_V(8); PG8_WAIT_L(0); PG8_BAR; PG8_MMA(1, 0, At, B0); PG8_MMA(1, 1, At, B1); PG8_BAR; PG8_SCHED;
            PG8_LDB(B0, 1, 0); PG8_LDB(B1, 1, 1); PG8_SCHED; PG8_LDA(At, 1, 0); PG8_STAGE(PG8_SA(0, 1), a2 + hstep, voffA);
            PG8_WAIT_V(8); PG8_WAIT_L(0); PG8_BAR; PG8_MMA(0, 0, At, B0); PG8_MMA(0, 1, At, B1); PG8_BAR; PG8_SCHED;
            PG8_LDA(At, 1, 1); PG8_STAGE(PG8_SB(1, 0), b3, voffB); PG8_STAGE(PG8_SB(1, 1), b3 + hstep, voffB); PG8_STAGE(PG8_SA(1, 0), a3, voffA);
            PG8_WAIT_V(8); PG8_WAIT_L(0); PG8_BAR; PG8_MMA(1, 0, At, B0); PG8_MMA(1, 1, At, B1); PG8_BAR; PG8_SCHED;
            } else {
            PG8_LDB(B0, 0, 0); PG8_SCHED; PG8_LDA(At, 0, 0); PG8_STAGE(PG8_SA(1, 1), a1 + hstep, voffA);
            PG8_WAIT_L(8); PG8_BAR; PG8_WAIT_L(0); PG8_MMA(0, 0, At, B0); PG8_BAR; PG8_SCHED;
            PG8_LDB(B1, 0, 1); PG8_STAGE(PG8_SB(0, 0), b2, voffB);
            PG8_BAR; PG8_WAIT_L(0); PG8_MMA(0, 1, At, B1); PG8_BAR;
            PG8_LDA(At, 0, 1); PG8_STAGE(PG8_SA(0, 0), a2, voffA);
            PG8_BAR; PG8_WAIT_L(0); PG8_MMA(1, 0, At, B0); PG8_BAR; PG8_SCHED;
            PG8_STAGE(PG8_SB(0, 1), b2 + hstep, voffB);
            PG8_WAIT_V(6); PG8_BAR; PG8_MMA(1, 1, At, B1); PG8_BAR;
            PG8_LDB(B0, 1, 0); PG8_SCHED; PG8_LDA(At, 1, 0); PG8_STAGE(PG8_SA(0, 1), a2 + hstep, voffA);
            PG8_WAIT_L(8); PG8_BAR; PG8_WAIT_L(0); PG8_MMA(0, 0, At, B0); PG8_BAR; PG8_SCHED;
            PG8_LDB(B1, 1, 1); PG8_STAGE(PG8_SB(1, 0), b3, voffB);
            PG8_BAR; PG8_WAIT_L(0); PG8_MMA(0, 1, At, B1); PG8_BAR;
            PG8_LDA(At, 1, 1); PG8_STAGE(PG8_SA(1, 0), a3, voffA);
            PG8_BAR; PG8_WAIT_L(0); PG8_MMA(1, 0, At, B0); PG8_BAR; PG8_SCHED;
            PG8_STAGE(PG8_SB(1, 1), b3 + hstep, voffB);
            PG8_WAIT_V(6); PG8_BAR; PG8_MMA(1, 1, At, B1); PG8_BAR;
            }
        }
        if constexpr (ALIGN_EPI) { if (wr == 0) PG8_BAR; }
        if constexpr (!Epi::AFTER_DRAIN) { E(acc, cur, wr, wc, fr, fq); S.done(cur); }
        if (!has_next) break;
#pragma unroll
        for (int a = 0; a < 2; ++a)
#pragma unroll
            for (int b = 0; b < 2; ++b)
#pragma unroll
                for (int m = 0; m < 4; ++m)
#pragma unroll
                    for (int n = 0; n < 2; ++n) acc[a][b][m][n] = (f32x4){0.f, 0.f, 0.f, 0.f};
        cur = nxt; cA = nA; cB = nB; ++ui;
        if constexpr (ALIGN_EPI) { if (wr == 1) PG8_BAR; }
    }
    PG8_WAIT_V(0);
    if constexpr (!ALIGN_EPI) { if (wr == 0) PG8_BAR; }
    PG8_BAR;
    if constexpr (Epi::AFTER_DRAIN) { E.fused(acc, cur, wr, wc, fr, fq, lds, wid, lane); S.done(cur); }
#undef PG8_SA
#undef PG8_SB
#undef PG8_STAGE
#undef PG8_LDA
#undef PG8_LDB
#undef PG8_MMA
#undef PG8_WAIT_V
#undef PG8_WAIT_L
#undef PG8_BAR
#undef PG8_SCHED
}
}

#define LAS __attribute__((address_space(3)))
typedef unsigned short bf16;
typedef float f32x4 __attribute__((ext_vector_type(4)));
typedef short bf16x8 __attribute__((ext_vector_type(8)));
typedef unsigned u32x4 __attribute__((ext_vector_type(4)));
typedef unsigned u32x2 __attribute__((ext_vector_type(2)));
typedef float f32x2 __attribute__((ext_vector_type(2)));

constexpr int DM = 1024, NB = 8, SEQ = 2048, CTXL = 256;
constexpr int ML = NB * SEQ, MC = NB * CTXL, MT = ML + MC;
constexpr int INW = 2304, DFF = 4096;
constexpr int ZP = 0, ZQ = 256, ZK = 768, ZV = 896, ZHQ = 1024, ZFF = 1280, ZFB = 1536, ZHI = 1792, ZHG = 2048;
constexpr int NTHREADS = 512;
constexpr int LDS_BYTES = 147456;
constexpr float EPSN = 1e-6f;

constexpr size_t MiB = 1u << 20;
constexpr size_t WS_WT = 0;
constexpr size_t WT_LAYER = 22 * MiB + MiB / 2, WT_IN = 0, WT_OUT = 4 * MiB + MiB / 2, WT_W1 = 6 * MiB + MiB / 2, WT_W2 = 14 * MiB + MiB / 2;
constexpr size_t WS_XC = 45 * MiB;
constexpr size_t WS_ACT = 53 * MiB;
constexpr size_t WS_Z = 89 * MiB;
constexpr size_t WS_S = 170 * MiB;
constexpr size_t WS_HH = 89 * MiB;
constexpr size_t WS_MOD = 233 * MiB;
constexpr size_t WS_ROPE = WS_MOD + 512 * 1024;
constexpr size_t WS_LB = WS_ROPE + 16 * 1024;
constexpr size_t WS_DEC = WS_LB + 16 * 1024;
constexpr size_t WS_CTL = 234 * MiB + 512 * 1024;
constexpr size_t CTL_BYTES = 90112;
constexpr size_t WS_PWT = 234 * MiB + 768 * 1024;
constexpr size_t WS_P1 = 0, WS_P2 = 235 * MiB, WS_P3 = 243 * MiB;
constexpr size_t WS_FSLOT = 251 * MiB;
constexpr size_t WS_END = 254 * MiB;
static_assert(WS_DEC + 2304 * 64 * 4 <= WS_CTL && WS_CTL + CTL_BYTES <= WS_PWT && WS_PWT + 65536 <= WS_P2, "ws map");

struct Params {
    const float *x, *c, *ctx, *c_ctx, *w_ada, *b_ada, *norm1_w, *w_in, *pool_w, *pool_scale, *attn_sink, *hg_lower, *hg_norm_w, *w_out, *norm2_w, *w_mlp1, *w_mlp2, *final_norm_w;
    float* out; unsigned char* ws; int ph_lo, ph_hi;
};

__device__ __forceinline__ int otid() { int t = threadIdx.x; asm volatile("" : "+v"(t)); return t; }
__device__ __forceinline__ float bf2f(unsigned u) { return __uint_as_float(u << 16); }
__device__ __forceinline__ unsigned f2bf(float f) { unsigned u = __float_as_uint(f); return (u + 0x7fffu + ((u >> 16) & 1u)) >> 16; }
__device__ __forceinline__ unsigned pk2(float lo, float hi) { return pg8::cvt_pk_bf16(lo, hi); }
__device__ __forceinline__ float xmax16(float v) { const u32x2 r = __builtin_amdgcn_permlane16_swap(__float_as_uint(v), __float_as_uint(v), false, false); return fmaxf(__uint_as_float(r.x), __uint_as_float(r.y)); }
__device__ __forceinline__ float xmax32(float v) { const u32x2 r = __builtin_amdgcn_permlane32_swap(__float_as_uint(v), __float_as_uint(v), false, false); return fmaxf(__uint_as_float(r.x), __uint_as_float(r.y)); }
__device__ __forceinline__ float xsum16(float v) { const u32x2 r = __builtin_amdgcn_permlane16_swap(__float_as_uint(v), __float_as_uint(v), false, false); return __uint_as_float(r.x) + __uint_as_float(r.y); }
__device__ __forceinline__ float xsum32(float v) { const u32x2 r = __builtin_amdgcn_permlane32_swap(__float_as_uint(v), __float_as_uint(v), false, false); return __uint_as_float(r.x) + __uint_as_float(r.y); }
#define DPP_F(v, ctrl) __uint_as_float((unsigned)__builtin_amdgcn_update_dpp(0, (int)__float_as_uint(v), (ctrl), 0xF, 0xF, false))
__device__ __forceinline__ float wave_sum(float v) {
    v += DPP_F(v, 0xB1);
    v += DPP_F(v, 0x4E);
    v += DPP_F(v, 0x141);
    v += DPP_F(v, 0x140);
    return xsum32(xsum16(v));
}
__device__ __forceinline__ float rcpf_(float x) { return __builtin_amdgcn_rcpf(x); }
__device__ __forceinline__ float siluf(float x) { return x * rcpf_(1.f + __expf(-x)); }
__device__ __forceinline__ float bfe(const u32x4& v, int j) { const unsigned w = v[j >> 1]; return (j & 1) ? __uint_as_float(w & 0xffff0000u) : __uint_as_float(w << 16); }

__device__ __forceinline__ f32x4 mma16(const LAS bf16* A, int lda, const LAS bf16* Bt, int ldb, int K, f32x4 acc, int lane) {
    const int r = lane & 15, q = lane >> 4;
    for (int k0 = 0; k0 < K; k0 += 32) {
        const bf16x8 a = *(const LAS bf16x8*)(A + r * lda + k0 + q * 8);
        const bf16x8 b = *(const LAS bf16x8*)(Bt + r * ldb + k0 + q * 8);
        acc = __builtin_amdgcn_mfma_f32_16x16x32_bf16(a, b, acc, 0, 0, 0);
    }
    return acc;
}

__device__ __forceinline__ void transpose_item(const float* W, int K, int N, bf16* WT, LAS float* scr, int item, int lane) {
    const int nblk = N / 32, kb = item / nblk, nb = item % nblk, k0 = 64 * kb, n0 = 32 * nb;
    float tv[32];
#pragma unroll
    for (int i = 0; i < 32; ++i) tv[i] = __builtin_nontemporal_load(W + (size_t)(k0 + 2 * i + (lane >> 5)) * N + n0 + (lane & 31));
#pragma unroll
    for (int i = 0; i < 32; ++i) scr[(2 * i + (lane >> 5)) * 33 + (lane & 31)] = tv[i];
    asm volatile("s_waitcnt lgkmcnt(0)" ::: "memory");
    const int c = lane & 7;
#pragma unroll
    for (int j = 0; j < 4; ++j) { const int n = (lane >> 3) + 8 * j; const LAS float* s = scr + (8 * c) * 33 + n;
        u32x4 o; o.x = pk2(s[0 * 33], s[1 * 33]); o.y = pk2(s[2 * 33], s[3 * 33]); o.z = pk2(s[4 * 33], s[5 * 33]); o.w = pk2(s[6 * 33], s[7 * 33]);
        *(u32x4*)(WT + (size_t)(n0 + n) * K + k0 + 8 * c) = o; }
    asm volatile("s_waitcnt lgkmcnt(0)" ::: "memory");
}

__device__ __forceinline__ void convert_weights(const Params& P, LAS unsigned char* lds, int l, int gw, int NGW, int wave, int lane, int item_lo, int item_hi) {
    LAS float* scr = (LAS float*)(lds + wave * 8448);
    constexpr int I_IN = 16 * 72, I_OUT = 16 * 32, I_1 = 16 * 128, I_2 = 64 * 32, I_L = I_IN + I_OUT + I_1 + I_2;
    unsigned char* wt = P.ws + WS_WT + (size_t)l * WT_LAYER;
    for (int it = item_lo + gw; it < item_hi; it += NGW) {
        int r = it;
        if (r < I_IN) { transpose_item(P.w_in + (size_t)l * DM * INW, DM, INW, (bf16*)(wt + WT_IN), scr, r, lane); continue; } r -= I_IN;
        if (r < I_OUT) { transpose_item(P.w_out + (size_t)l * DM * DM, DM, DM, (bf16*)(wt + WT_OUT), scr, r, lane); continue; } r -= I_OUT;
        if (r < I_1) { transpose_item(P.w_mlp1 + (size_t)l * DM * DFF, DM, DFF, (bf16*)(wt + WT_W1), scr, r, lane); continue; } r -= I_1;
        transpose_item(P.w_mlp2 + (size_t)l * DFF * DM, DFF, DM, (bf16*)(wt + WT_W2), scr, r, lane);
    }
}

__device__ __forceinline__ void ph_prologue(const Params& P, LAS unsigned char* lds) {
    const int tid = otid(), lane = tid & 63, wave = __builtin_amdgcn_readfirstlane(tid >> 6);
    unsigned char* ws = P.ws;
    {
        const int gt = blockIdx.x * NTHREADS + tid, nt = gridDim.x * NTHREADS;
        float2* rope = (float2*)(ws + WS_ROPE);
        for (int i = gt; i < 64 * 16; i += nt) { const int p = i >> 4, f = i & 15;
            const float inv = exp2f(-(float)f * (13.287712379549449f / 16.0f));
            const float a = (float)p * inv; rope[i] = make_float2(__cosf(a), __sinf(a)); }
        bf16* PWT = (bf16*)(ws + WS_PWT);
        for (int i = gt; i < 2 * 4 * 64 * 64; i += nt) { const int lg = i >> 12, d = (i >> 6) & 63, c = i & 63; PWT[i] = (bf16)f2bf(P.pool_w[(size_t)(lg * 64 + c) * 64 + d]); }
        float* LB = (float*)(ws + WS_LB);
        for (int i = gt; i < 512; i += nt) { const float h0 = P.hg_lower[i], h1 = P.hg_lower[512 + i];
            LB[i] = 0.f; LB[512 + i] = 1.f / (1.f + __expf(h0 - h1)); }
    }
    if (blockIdx.x < 192) {
        LAS float* sc = (LAS float*)lds;
        LAS float* red = (LAS float*)(lds + 36864);
        for (int i = tid; i < 9 * 1024; i += NTHREADS) { const int r = i >> 10, k = i & 1023; const float v = r < 8 ? P.c[r * 1024 + k] : P.c_ctx[k]; sc[i] = siluf(v); }
        __syncthreads();
        float* MOD = (float*)(ws + WS_MOD);
        for (int u = blockIdx.x; u < 192; u += gridDim.x) {
            const int l = u / 96, n0 = (u % 96) * 64;
            const float* W = P.w_ada + (size_t)l * 1024 * 6144 + n0 + lane;
            float acc[9];
#pragma unroll
            for (int r = 0; r < 9; ++r) acc[r] = 0.f;
#pragma unroll 1
            for (int kb = 128 * wave; kb < 128 * wave + 128; kb += 32) { float wv[32];
#pragma unroll
                for (int i = 0; i < 32; ++i) wv[i] = __builtin_nontemporal_load(W + (size_t)(kb + i) * 6144);
#pragma unroll
                for (int i = 0; i < 32; ++i) {
#pragma unroll
                    for (int r = 0; r < 9; ++r) acc[r] += sc[r * 1024 + kb + i] * wv[i]; } }
#pragma unroll
            for (int r = 0; r < 9; ++r) red[(wave * 9 + r) * 64 + lane] = acc[r];
            __syncthreads();
            for (int i = tid; i < 576; i += NTHREADS) { const int r = i >> 6, cc = i & 63; float s = P.b_ada[l * 6144 + n0 + cc];
#pragma unroll
                for (int w = 0; w < 8; ++w) s += red[(w * 9 + r) * 64 + cc];
                MOD[(size_t)(l * 9 + r) * 6144 + n0 + cc] = s; }
            __syncthreads();
        }
    }
    __syncthreads();
    convert_weights(P, lds, 0, blockIdx.x * 8 + wave, gridDim.x * 8, wave, lane, 0, 1152);
}

__device__ __forceinline__ void ph_norm_mod(const float* xlat, const float* xctx, int nrows, const float* w, const float* modl, int sh_off, int s_off, bf16* out, const float* p1 = nullptr, const float* p2 = nullptr, const float* p3 = nullptr, int row0 = 0) {
    const int tid = otid(), lane = tid & 63, gw = blockIdx.x * 8 + (tid >> 6), NGW = gridDim.x * 8;
    const int per = (nrows - row0 + NGW - 1) / NGW, start = row0 + gw * per, end = min(start + per, nrows);
    int cur = -1; f32x4 cv[4], hv[4];
#pragma unroll
    for (int j = 0; j < 4; ++j) { cv[j] = (f32x4){0.f, 0.f, 0.f, 0.f}; hv[j] = cv[j]; }
    for (int r0 = start; r0 < end; r0 += 3) {
        f32x4 v[3][4];
#pragma unroll
        for (int u = 0; u < 3; ++u) { const int row = r0 + u;
            if (row < end) { const float* xr = row < ML ? xlat + (size_t)row * DM : xctx + (size_t)(row - ML) * DM;
#pragma unroll
                for (int j = 0; j < 4; ++j) { v[u][j] = *(const f32x4*)(xr + 4 * lane + 256 * j);
                    if (p1 && row >= ML) { const size_t po = (size_t)(row - ML) * DM + 4 * lane + 256 * j; v[u][j] = v[u][j] + (*(const f32x4*)(p1 + po) + *(const f32x4*)(p2 + po) + *(const f32x4*)(p3 + po)); } } }
            else {
#pragma unroll
                for (int j = 0; j < 4; ++j) v[u][j] = (f32x4){0.f, 0.f, 0.f, 0.f}; } }
#pragma unroll
        for (int u = 0; u < 3; ++u) { const int row = r0 + u;
            if (row < end) {
                float ss = 0.f;
#pragma unroll
                for (int j = 0; j < 4; ++j) ss += (v[u][j].x * v[u][j].x + v[u][j].y * v[u][j].y) + (v[u][j].z * v[u][j].z + v[u][j].w * v[u][j].w);
                const float rstd = rsqrtf(wave_sum(ss) * (1.f / DM) + EPSN);
                const int mr = row < ML ? (row >> 11) : 8;
                if (mr != cur) { cur = mr; const float* md = modl + (size_t)mr * 6144;
#pragma unroll
                    for (int j = 0; j < 4; ++j) { const int col = 4 * lane + 256 * j; cv[j] = *(const f32x4*)(w + col) * (1.f + *(const f32x4*)(md + s_off + col)); hv[j] = *(const f32x4*)(md + sh_off + col); } }
#pragma unroll
                for (int j = 0; j < 4; ++j) { const int col = 4 * lane + 256 * j; const f32x4 o = v[u][j] * rstd * cv[j] + hv[j];
                    u32x2 pk; pk.x = pk2(o.x, o.y); pk.y = pk2(o.z, o.w); *(u32x2*)(out + (size_t)row * DM + col) = pk; } } }
    }
}
__device__ __forceinline__ void ph_final_norm(const float* x, const float* w, float* out) {
    const int tid = otid(), lane = tid & 63, gw = blockIdx.x * 8 + (tid >> 6), NGW = gridDim.x * 8;
    const int per = (ML + NGW - 1) / NGW, start = gw * per, end = min(start + per, ML);
    f32x4 wv[4];
#pragma unroll
    for (int j = 0; j < 4; ++j) wv[j] = *(const f32x4*)(w + 4 * lane + 256 * j);
    for (int r0 = start; r0 < end; r0 += 4) {
        f32x4 v[4][4];
#pragma unroll
        for (int u = 0; u < 4; ++u) { const int row = min(r0 + u, end - 1);
#pragma unroll
            for (int j = 0; j < 4; ++j) v[u][j] = *(const f32x4*)(x + (size_t)row * DM + 4 * lane + 256 * j); }
#pragma unroll
        for (int u = 0; u < 4; ++u) { const int row = r0 + u;
            if (row < end) { float ss = 0.f;
#pragma unroll
                for (int j = 0; j < 4; ++j) ss += (v[u][j].x * v[u][j].x + v[u][j].y * v[u][j].y) + (v[u][j].z * v[u][j].z + v[u][j].w * v[u][j].w);
                const float rstd = rsqrtf(wave_sum(ss) * (1.f / DM) + EPSN);
#pragma unroll
                for (int j = 0; j < 4; ++j) *(f32x4*)(out + (size_t)row * DM + 4 * lane + 256 * j) = v[u][j] * rstd * wv[j]; } }
    }
}

__device__ __forceinline__ void pool_unit(LAS unsigned char* lds, const bf16* Z, bf16* Y, const bf16* PWT_l, const float* pool_scale_l, int T) {
    const int tid = otid(), lane = tid & 63, wave = __builtin_amdgcn_readfirstlane(tid >> 6), r = lane & 15, quad = lane >> 4;
    LAS float* Pf = (LAS float*)lds;
    LAS bf16* Dt = (LAS bf16*)lds;
    LAS bf16* Wt = (LAS bf16*)(lds + 81920);
    int t0, n, rowbase;
    if (T < 256) { rowbase = (T >> 5) * SEQ; t0 = (T & 31) * 64; n = SEQ; } else { const int Tc = T - 256; rowbase = ML + (Tc >> 2) * CTXL; t0 = (Tc & 3) * 64; n = CTXL; }
#pragma unroll
    for (int i = 0; i < 5; ++i) { const int idx = tid + NTHREADS * i, rr = idx >> 5, c8 = idx & 31, t = t0 - 8 + rr;
        u32x4 v = {0u, 0u, 0u, 0u};
        if (t >= 0 && t < n) v = *(const u32x4*)(Z + (size_t)(rowbase + t) * INW + ZP + c8 * 8);
        f32x4 lo4 = {bfe(v, 0), bfe(v, 1), bfe(v, 2), bfe(v, 3)}, hi4 = {bfe(v, 4), bfe(v, 5), bfe(v, 6), bfe(v, 7)};
        *(LAS f32x4*)(Pf + rr * 256 + c8 * 8) = lo4; *(LAS f32x4*)(Pf + rr * 256 + c8 * 8 + 4) = hi4; }
#pragma unroll
    for (int i = 0; i < 4; ++i) { const int idx = tid + NTHREADS * i, row = idx >> 3, ch8 = idx & 7;
        *(LAS u32x4*)(Wt + row * 72 + ch8 * 8) = *(const u32x4*)(PWT_l + row * 64 + ch8 * 8); }
    __syncthreads();
    const int c = tid & 255, hf = tid >> 8, half = 1 << (c >> 6);
    float dv[32];
    {
        const int rb = 32 * hf + 8;
        float sacc = 0.f;
        for (int j = -half; j < half; ++j) sacc += Pf[(rb + j) * 256 + c];
#pragma unroll
        for (int i = 0; i < 32; ++i) { const int t = t0 + 32 * hf + i; const int lo = max(t - half, 0), hi = min(t + half, n);
            dv[i] = sacc * rcpf_((float)(hi - lo)) - Pf[(rb + i) * 256 + c];
            if (i < 31) sacc += Pf[(rb + i + half) * 256 + c] - Pf[(rb + i - half) * 256 + c]; }
    }
    __syncthreads();
#pragma unroll
    for (int i = 0; i < 32; ++i) Dt[(32 * hf + i) * 264 + c] = (bf16)f2bf(dv[i]);
    __syncthreads();
#pragma unroll
    for (int e = 0; e < 8; ++e) { const int tt = wave * 8 + e, g = tt >> 4, d0 = ((tt >> 2) & 3) * 16, tau0 = (tt & 3) * 16;
        f32x4 acc = {0.f, 0.f, 0.f, 0.f};
        acc = mma16(Wt + (g * 64 + d0) * 72, 72, Dt + tau0 * 264 + g * 64, 264, 64, acc, lane);
        const f32x4 sc = *(const f32x4*)(pool_scale_l + 64 * g + d0 + quad * 4);
        u32x2 pk; pk.x = pk2(acc[0] * sc[0], acc[1] * sc[1]); pk.y = pk2(acc[2] * sc[2], acc[3] * sc[3]);
        *(u32x2*)(Y + (size_t)(rowbase + t0 + tau0 + r) * DM + 64 * g + d0 + quad * 4) = pk; }
    __syncthreads();
}

__device__ __forceinline__ bf16x8 rope8(const u32x4& own, const u32x4& par, const LAS f32x2* cs, bool first, float scale) {
    bf16x8 o;
    float t[8];
#pragma unroll
    for (int j = 0; j < 8; ++j) { const float a = bfe(own, j), b = bfe(par, j); const f32x2 c = cs[j];
        t[j] = (first ? a * c.x - b * c.y : a * c.x + b * c.y) * scale; }
    u32x4 w; w.x = pk2(t[0], t[1]); w.y = pk2(t[2], t[3]); w.z = pk2(t[4], t[5]); w.w = pk2(t[6], t[7]);
    return __builtin_bit_cast(bf16x8, w);
}
__device__ __forceinline__ bf16x8 scale8(const u32x4& own, float scale) {
    float t[8];
#pragma unroll
    for (int j = 0; j < 8; ++j) t[j] = bfe(own, j) * scale;
    u32x4 w; w.x = pk2(t[0], t[1]); w.y = pk2(t[2], t[3]); w.z = pk2(t[4], t[5]); w.w = pk2(t[6], t[7]);
    return __builtin_bit_cast(bf16x8, w);
}

__device__ __forceinline__ void attn_unit(LAS unsigned char* lds, const bf16* Z, bf16* Y, const float* sink_l, const float2* rope, int unit) {
    const int tid = otid(), lane = tid & 63, wave = __builtin_amdgcn_readfirstlane(tid >> 6), r = lane & 15, quad = lane >> 4;
    LAS bf16* Ks = (LAS bf16*)lds;
    LAS bf16* Vt = (LAS bf16*)(lds + 36864);
    const bool lat = unit < 512;
    int b, kh, qrow0, qpos0, ntiles, tlo;
    if (lat) { b = unit >> 6; const int n = (unit & 63) >> 1; kh = unit & 1; qpos0 = 64 * n; qrow0 = b * SEQ + qpos0; tlo = n == 0 ? 2 : (n == 1 ? 1 : 0); const int thi = n == 31 ? 3 : (n == 30 ? 4 : 5); ntiles = 4 + thi - tlo; }
    else { const int cu = unit - 512; b = cu >> 3; const int qb4 = (cu & 7) >> 1; kh = cu & 1; qpos0 = 0; qrow0 = ML + b * CTXL + 64 * qb4; tlo = 0; ntiles = 4; }
    const int hh = wave >> 1, qhead = kh * 4 + hh, qw0 = (wave & 1) * 32;
    LAS f32x2* ropeL = (LAS f32x2*)(lds + 73728);
    ropeL[tid] = ((const f32x2*)rope)[tid]; ropeL[tid + NTHREADS] = ((const f32x2*)rope)[tid + NTHREADS];
    __syncthreads();
    const float QSC = 0.125f * 1.4426950408889634f;
    bf16x8 qf[2][2];
#pragma unroll
    for (int qb = 0; qb < 2; ++qb)
#pragma unroll
        for (int ks = 0; ks < 2; ++ks) {
            const int qi = qw0 + qb * 16 + r;
            const bf16* ptr = Z + (size_t)(qrow0 + qi) * INW + ZQ + qhead * 64 + ks * 32;
            const u32x4 own = *(const u32x4*)(ptr + quad * 8);
            if (lat) { const u32x4 par = *(const u32x4*)(ptr + (quad ^ 2) * 8); const int pos = qpos0 + qi; const int p = ks == 0 ? (pos >> 6) : (pos & 63);
                qf[qb][ks] = rope8(own, par, ropeL + p * 16 + (quad & 1) * 8, quad < 2, QSC); }
            else qf[qb][ks] = scale8(own, QSC);
        }
    const float sk = sink_l[qhead] * 1.4426950408889634f;
    float mrun[2], lrun[2]; f32x4 o[2][4];
#pragma unroll
    for (int qb = 0; qb < 2; ++qb) { mrun[qb] = sk; lrun[qb] = quad == 0 ? 1.f : 0.f;
#pragma unroll
        for (int db = 0; db < 4; ++db) o[qb][db] = (f32x4){0.f, 0.f, 0.f, 0.f}; }
    const int skey = tid >> 3, c8 = tid & 7;
    u32x4 kown, kpar, vv;
    auto tile_rows = [&](int idx, int& rowbase, int& kpos0) { if (idx < 4) { rowbase = ML + b * CTXL + 64 * idx; kpos0 = -100000; } else { kpos0 = qpos0 - 128 + 64 * (tlo + idx - 4); rowbase = b * SEQ + kpos0; } };
    auto prefetch = [&](int idx) { int rowbase, kpos0; tile_rows(idx, rowbase, kpos0);
        const bf16* zr = Z + (size_t)(rowbase + skey) * INW;
        kown = *(const u32x4*)(zr + ZK + kh * 64 + c8 * 8); kpar = *(const u32x4*)(zr + ZK + kh * 64 + (c8 ^ 2) * 8); vv = *(const u32x4*)(zr + ZV + kh * 64 + c8 * 8); };
    auto stage_store = [&](int idx, int buf) {
        int rowbase, kpos0; tile_rows(idx, rowbase, kpos0);
        LAS bf16* Kb = Ks + buf * 9216; LAS bf16* Vb = Vt + buf * 9216;
        bf16x8 kk;
        if (kpos0 >= 0) { const int pos = kpos0 + skey; const int p = (c8 < 4) ? (pos >> 6) : (pos & 63);
            kk = rope8(kown, kpar, ropeL + p * 16 + (c8 & 1) * 8, (c8 & 3) < 2, 1.0f); }
        else kk = __builtin_bit_cast(bf16x8, kown);
        *(LAS bf16x8*)(Kb + skey * 72 + c8 * 8) = kk;
#pragma unroll
        for (int j = 0; j < 8; ++j) Vb[(c8 * 8 + j) * 72 + skey] = (bf16)((vv[j >> 1] >> ((j & 1) * 16)) & 0xffffu);
    };
    prefetch(0);
    __syncthreads();
    stage_store(0, 0);
    if (ntiles > 1) prefetch(1);
    __syncthreads();
    for (int it = 0; it < ntiles; ++it) {
        int rowbase, kpos0; tile_rows(it, rowbase, kpos0);
        const LAS bf16* Kc = Ks + (it & 1) * 9216; const LAS bf16* Vc = Vt + (it & 1) * 9216;
        bf16x8 kf[4][2], vf[4][2];
#pragma unroll
        for (int kb = 0; kb < 4; ++kb)
#pragma unroll
            for (int ks = 0; ks < 2; ++ks) kf[kb][ks] = *(const LAS bf16x8*)(Kc + (kb * 16 + r) * 72 + ks * 32 + quad * 8);
#pragma unroll
        for (int db = 0; db < 4; ++db)
#pragma unroll
            for (int k2 = 0; k2 < 2; ++k2) { const u32x2 a = *(const LAS u32x2*)(Vc + (db * 16 + r) * 72 + 32 * k2 + 4 * quad), c = *(const LAS u32x2*)(Vc + (db * 16 + r) * 72 + 32 * k2 + 16 + 4 * quad);
                u32x4 w; w.x = a.x; w.y = a.y; w.z = c.x; w.w = c.y; vf[db][k2] = __builtin_bit_cast(bf16x8, w); }
#pragma unroll
        for (int qb = 0; qb < 2; ++qb) {
            f32x4 st[4];
#pragma unroll
            for (int kb = 0; kb < 4; ++kb) { st[kb] = (f32x4){0.f, 0.f, 0.f, 0.f};
#pragma unroll
                for (int ks = 0; ks < 2; ++ks) st[kb] = __builtin_amdgcn_mfma_f32_16x16x32_bf16(kf[kb][ks], qf[qb][ks], st[kb], 0, 0, 0); }
            if (kpos0 >= 0) { const int qpos = qpos0 + qw0 + qb * 16 + r;
#pragma unroll
                for (int kb = 0; kb < 4; ++kb)
#pragma unroll
                    for (int j = 0; j < 4; ++j) { const int dd = qpos - (kpos0 + kb * 16 + quad * 4 + j); if (dd > 128 || dd < -128) st[kb][j] = -1e30f; } }
            float mx = -3e38f;
#pragma unroll
            for (int kb = 0; kb < 4; ++kb)
#pragma unroll
                for (int j = 0; j < 4; ++j) mx = fmaxf(mx, st[kb][j]);
            mx = xmax32(xmax16(mx));
            const float mnew = fmaxf(mrun[qb], mx), alpha = __builtin_amdgcn_exp2f(mrun[qb] - mnew); mrun[qb] = mnew;
            float ps = 0.f;
#pragma unroll
            for (int kb = 0; kb < 4; ++kb)
#pragma unroll
                for (int j = 0; j < 4; ++j) { const float pv = __builtin_amdgcn_exp2f(st[kb][j] - mnew); ps += pv; st[kb][j] = pv; }
            lrun[qb] = lrun[qb] * alpha + ps;
#pragma unroll
            for (int db = 0; db < 4; ++db) o[qb][db] = o[qb][db] * alpha;
#pragma unroll
            for (int k2 = 0; k2 < 2; ++k2) { u32x4 w; w.x = pk2(st[2 * k2][0], st[2 * k2][1]); w.y = pk2(st[2 * k2][2], st[2 * k2][3]); w.z = pk2(st[2 * k2 + 1][0], st[2 * k2 + 1][1]); w.w = pk2(st[2 * k2 + 1][2], st[2 * k2 + 1][3]);
                const bf16x8 pb = __builtin_bit_cast(bf16x8, w);
#pragma unroll
                for (int db = 0; db < 4; ++db) o[qb][db] = __builtin_amdgcn_mfma_f32_16x16x32_bf16(vf[db][k2], pb, o[qb][db], 0, 0, 0); }
        }
        if (it + 1 < ntiles) { stage_store(it + 1, (it + 1) & 1); if (it + 2 < ntiles) prefetch(it + 2); }
        __syncthreads();
    }
#pragma unroll
    for (int qb = 0; qb < 2; ++qb) { float lt = xsum32(xsum16(lrun[qb])); const float inv = rcpf_(lt);
        bf16* yr = Y + (size_t)(qrow0 + qw0 + qb * 16 + r) * DM + 256 + qhead * 64 + quad * 4;
#pragma unroll
        for (int db = 0; db < 4; ++db) { u32x2 pk; pk.x = pk2(o[qb][db][0] * inv, o[qb][db][1] * inv); pk.y = pk2(o[qb][db][2] * inv, o[qb][db][3] * inv); *(u32x2*)(yr + db * 16) = pk; } }
    __syncthreads();
}

__device__ __forceinline__ int hg_row(int b, int step, int dir, int tau) {
    if (dir == 0) return step < 4 ? ML + b * CTXL + 64 * step + tau : b * SEQ + 64 * (step - 4) + tau;
    return step < 4 ? ML + b * CTXL + 64 * (3 - step) + 63 - tau : b * SEQ + 64 * (35 - step) + 63 - tau;
}
__device__ __forceinline__ void hg_stage(LAS bf16* dst, const bf16* Z, int b, int step, int dir, int col0, int tid) {
    const int tau = tid >> 3, c8 = tid & 7;
    *(LAS u32x4*)(dst + tau * 72 + c8 * 8) = *(const u32x4*)(Z + (size_t)hg_row(b, step, dir, tau) * INW + col0 + c8 * 8);
}
__device__ __forceinline__ float hg_gates(const LAS bf16* RAWF, LAS float* TOT, float lb, float (&kk)[8], float (&bb)[8], int lane, int wave, float (&cend)[3], int rs = 72) {
    float run = 0.f;
#pragma unroll
    for (int i = 0; i < 8; ++i) { const float fp = bf2f(RAWF[(8 * wave + i) * rs + lane]);
        const float e = __expf(fp);
        const float om = (1.f - lb) * rcpf_(1.f + e);
        kk[i] = om; run += __logf(1.f - om); bb[i] = run; }
    TOT[wave * 64 + lane] = run;
    __syncthreads();
    float pre = 0.f, tot = 0.f;
#pragma unroll
    for (int s = 0; s < 8; ++s) { const float t = TOT[s * 64 + lane]; tot += t; if (s < wave) pre += t; if (s == 1) cend[0] = tot; if (s == 3) cend[1] = tot; if (s == 5) cend[2] = tot; }
#pragma unroll
    for (int i = 0; i < 8; ++i) bb[i] += pre;
    return tot;
}

struct HuPre { u32x4 f, v; bool valid; };
__device__ __forceinline__ HuPre hu_load(const bf16* Z, int u, int tid) {
    const int chain = u / 36, step = u % 36, b = chain >> 3, h = (chain >> 1) & 3, dir = chain & 1;
    const int tau = tid >> 3, c8 = tid & 7;
    const bf16* zr = Z + (size_t)hg_row(b, step, dir, tau) * INW + h * 64 + c8 * 8;
    HuPre p; p.f = *(const u32x4*)(zr + (dir ? ZFB : ZFF)); p.v = *(const u32x4*)(zr + ZHI); p.valid = true; return p;
}
__device__ __forceinline__ void hgU_unit(LAS unsigned char* lds, const bf16* Z, const float* LBl, float* Sbuf, float* DEC, int u, HuPre& pre, int u_next) {
    const int tid = otid(), lane = tid & 63, wave = __builtin_amdgcn_readfirstlane(tid >> 6), r = lane & 15, quad = lane >> 4;
    LAS bf16* KH = (LAS bf16*)lds;
    LAS bf16* VT = (LAS bf16*)(lds + 9216);
    LAS float* TOT = (LAS float*)(lds + 18432);
    LAS bf16* RAWF = (LAS bf16*)(lds + 20480);
    LAS bf16* RAWV = (LAS bf16*)(lds + 29696);
    const int chain = u / 36, step = u % 36, b = chain >> 3, h = (chain >> 1) & 3, dir = chain & 1;
    const float lb = LBl[dir * 256 + h * 64 + lane];
    if (!pre.valid) pre = hu_load(Z, u, tid);
    { const int tau = tid >> 3, c8 = tid & 7; *(LAS u32x4*)(RAWF + tau * 72 + c8 * 8) = pre.f; *(LAS u32x4*)(RAWV + tau * 72 + c8 * 8) = pre.v; }
    __syncthreads();
    if (u_next >= 0) pre = hu_load(Z, u_next, tid); else pre.valid = false;
    float kk[8], bb[8];
    float cend_[3];
    const float bend = hg_gates(RAWF, TOT, lb, kk, bb, lane, wave, cend_);
    float kh[8];
    u32x4 x;
#pragma unroll
    for (int i = 0; i < 8; ++i) kh[i] = kk[i] * __expf(bend - bb[i]);
#pragma unroll
    for (int i = 0; i < 4; ++i) x[i] = (unsigned)RAWV[(8 * wave + 2 * i) * 72 + lane] | ((unsigned)RAWV[(8 * wave + 2 * i + 1) * 72 + lane] << 16);
    { u32x4 w; w.x = pk2(kh[0], kh[1]); w.y = pk2(kh[2], kh[3]); w.z = pk2(kh[4], kh[5]); w.w = pk2(kh[6], kh[7]); *(LAS u32x4*)(KH + lane * 72 + 8 * wave) = w;
      *(LAS u32x4*)(VT + lane * 72 + 8 * wave) = x; }
    if (wave == 0) DEC[(size_t)u * 64 + lane] = __expf(bend);
    __syncthreads();
#pragma unroll
    for (int e = 0; e < 2; ++e) { const int tt = 2 * wave + e, v0 = (tt >> 2) * 16, k0 = (tt & 3) * 16;
        f32x4 acc = {0.f, 0.f, 0.f, 0.f};
        acc = mma16(VT + v0 * 72, 72, KH + k0 * 72, 72, 64, acc, lane);
#pragma unroll
        for (int j = 0; j < 4; ++j) Sbuf[(size_t)u * 4096 + (v0 + quad * 4 + j) * 64 + k0 + r] = acc[j]; }
    __syncthreads();
}

__device__ __forceinline__ void hg_chain(LAS unsigned char* lds, const bf16* Z, const float* LBl, float* Sbuf, int chain) {
    const int tid = otid(), lane = tid & 63, wave = __builtin_amdgcn_readfirstlane(tid >> 6), r = lane & 15, quad = lane >> 4;
    LAS bf16* KH = (LAS bf16*)lds;
    LAS bf16* VT = (LAS bf16*)(lds + 9216);
    LAS float* TOT = (LAS float*)(lds + 18432);
    LAS bf16* RAWF = (LAS bf16*)(lds + 20480);
    LAS bf16* RAWV = (LAS bf16*)(lds + 29696);
    LAS float* DECL = (LAS float*)(lds + 57344);
    const int h = (chain >> 1) & 3, dir = chain & 1;
    const float lb = LBl[dir * 256 + h * 64 + lane];
    f32x4 st[2];
    st[0] = (f32x4){0.f, 0.f, 0.f, 0.f}; st[1] = st[0];
    HuPre pre = hu_load(Z, chain * 36, tid);
    __syncthreads();
    { const int tau = tid >> 3, c8 = tid & 7; *(LAS u32x4*)(RAWF + tau * 72 + c8 * 8) = pre.f; *(LAS u32x4*)(RAWV + tau * 72 + c8 * 8) = pre.v; }
    pre = hu_load(Z, chain * 36 + 1, tid);
    __syncthreads();
#pragma unroll 1
    for (int step = 0; step < 36; ++step) {
        const int u = chain * 36 + step;
        LAS bf16* RF = RAWF + (step & 1) * 9216;
        LAS bf16* RV = RAWV + (step & 1) * 9216;
        float kk[8], bb[8], cend_[3];
        const float bend = hg_gates(RF, TOT, lb, kk, bb, lane, wave, cend_);
        float kh[8]; u32x4 x;
#pragma unroll
        for (int i = 0; i < 8; ++i) kh[i] = kk[i] * __expf(bend - bb[i]);
#pragma unroll
        for (int i = 0; i < 4; ++i) x[i] = (unsigned)RV[(8 * wave + 2 * i) * 72 + lane] | ((unsigned)RV[(8 * wave + 2 * i + 1) * 72 + lane] << 16);
        { u32x4 w; w.x = pk2(kh[0], kh[1]); w.y = pk2(kh[2], kh[3]); w.z = pk2(kh[4], kh[5]); w.w = pk2(kh[6], kh[7]); *(LAS u32x4*)(KH + lane * 72 + 8 * wave) = w;
          *(LAS u32x4*)(VT + lane * 72 + 8 * wave) = x; }
        if (wave == 0) DECL[lane] = __expf(bend);
        if (step + 1 < 36) { const int tau = tid >> 3, c8 = tid & 7; LAS bf16* NF = RAWF + ((step + 1) & 1) * 9216; LAS bf16* NV = RAWV + ((step + 1) & 1) * 9216;
            *(LAS u32x4*)(NF + tau * 72 + c8 * 8) = pre.f; *(LAS u32x4*)(NV + tau * 72 + c8 * 8) = pre.v;
            if (step + 2 < 36) pre = hu_load(Z, u + 2, tid); }
        __syncthreads();
#pragma unroll
        for (int e = 0; e < 2; ++e) { const int tt = 2 * wave + e, v0 = (tt >> 2) * 16, k0 = (tt & 3) * 16;
            f32x4 acc = {0.f, 0.f, 0.f, 0.f};
            acc = mma16(VT + v0 * 72, 72, KH + k0 * 72, 72, 64, acc, lane);
            const float dk = DECL[k0 + r];
#pragma unroll
            for (int j = 0; j < 4; ++j) { Sbuf[(size_t)u * 4096 + (v0 + quad * 4 + j) * 64 + k0 + r] = st[e][j]; st[e][j] = dk * st[e][j] + acc[j]; } }
    }
    __syncthreads();
}

__device__ __forceinline__ void ph_hg_scan(float* __restrict__ Sbuf, const float* __restrict__ DEC) {
    const int gt = blockIdx.x * NTHREADS + otid(), nt = gridDim.x * NTHREADS;
    for (int i = gt; i < 64 * 4096; i += nt) { const int chain = i >> 12, e = i & 4095, k = e & 63;
        float* __restrict__ sp = Sbuf + (size_t)chain * 36 * 4096 + e; const float* __restrict__ dp = DEC + (size_t)chain * 36 * 64 + k;
        float s = 0.f;
#pragma unroll 1
        for (int s0 = 0; s0 < 36; s0 += 12) {
            float uu[12], dd[12];
#pragma unroll
            for (int j = 0; j < 12; ++j) { uu[j] = sp[(size_t)(s0 + j) * 4096]; dd[j] = dp[(s0 + j) * 64]; }
#pragma unroll
            for (int j = 0; j < 12; ++j) { sp[(size_t)(s0 + j) * 4096] = s; s = dd[j] * s + uu[j]; }
        } }
}

constexpr int HO_RAWQ = 0, HO_RAWF = 9216, HO_RAWV = 18432, HO_QE = 27648, HO_KT = 36864, HO_KD = 46080, HO_VT = 55296, HO_ST = 64512, HO_AM = 73728, HO_QOFF = 82944, HO_OB = 96768, HO_TOT = 114176, HO_BEND = 116224, HO_ST1 = 117248;
struct HoPre { u32x4 q, f, v; f32x4 s0, s1; };
__device__ __forceinline__ void ho_decode(int it, int l, int& b, int& cstep, int& h) {
    if (l == 0) { b = it / 144; cstep = (it % 144) >> 2; h = it & 3; } else { b = it >> 7; cstep = 4 + ((it & 127) >> 2); h = it & 3; }
}
__device__ __forceinline__ HoPre ho_load(const bf16* Z, const float* Sbuf, int b, int cstep, int h, int dir, int tid) {
    const int step = dir == 0 ? cstep : (cstep < 4 ? 3 - cstep : 39 - cstep);
    const int uidx = ((b * 4 + h) * 2 + dir) * 36 + step;
    const int tau = tid >> 3, c8 = tid & 7;
    const bf16* zr = Z + (size_t)hg_row(b, step, dir, tau) * INW + h * 64 + c8 * 8;
    HoPre p; p.q = *(const u32x4*)(zr + ZHQ); p.f = *(const u32x4*)(zr + (dir ? ZFB : ZFF)); p.v = *(const u32x4*)(zr + ZHI);
    const float* sp = Sbuf + (size_t)uidx * 4096 + tau * 64 + c8 * 8; p.s0 = *(const f32x4*)sp; p.s1 = *(const f32x4*)(sp + 4);
    return p;
}
constexpr int H2_RAW = 0  , H2_QE = 49152, H2_KT = 58368, H2_KD = 67584, H2_VT = 76800, H2_ST = 86016  ,
              H2_AM = 104448, H2_QOFF = 113664, H2_OB = 127488, H2_TOT = 144896;
static_assert(H2_TOT + 2048 <= LDS_BYTES - 256, "hgO LDS map");
__device__ __forceinline__ HoPre ho_load_k(const bf16* Z, const float* Sbuf, int l, int it0, int G, int k, int tid) {
    int b, cstep, h; ho_decode(it0 + (k >> 1) * G, l, b, cstep, h);
    return ho_load(Z, Sbuf, b, cstep, h, k & 1, tid);
}
__device__ __forceinline__ void ho_stage(LAS unsigned char* lds, const HoPre& pre, int set, int dirbuf, int tid) {
    const int tau = tid >> 3, c8 = tid & 7;
    LAS bf16* R = (LAS bf16*)(lds + H2_RAW + set * 24576);
    *(LAS u32x4*)(R + tau * 64 + c8 * 8) = pre.q; *(LAS u32x4*)(R + 4096 + tau * 64 + c8 * 8) = pre.f; *(LAS u32x4*)(R + 8192 + tau * 64 + c8 * 8) = pre.v;
    u32x4 w; w.x = pk2(pre.s0.x, pre.s0.y); w.y = pk2(pre.s0.z, pre.s0.w); w.z = pk2(pre.s1.x, pre.s1.y); w.w = pk2(pre.s1.z, pre.s1.w);
    *(LAS u32x4*)((LAS bf16*)(lds + H2_ST + dirbuf * 9216) + tau * 72 + c8 * 8) = w;
}
__device__ __forceinline__ void ph_hgO(LAS unsigned char* lds, const bf16* Z, bf16* Y, const float* LBl, const float* Sbuf, const float* hg_norm_w_l, int l, int n_u) {
    const int it0 = blockIdx.x, G = (int)gridDim.x; if (it0 >= n_u) return;
    const int nk = 2 * ((n_u - it0 + G - 1) / G);
    const int tid = otid(), lane = tid & 63, wave = __builtin_amdgcn_readfirstlane(tid >> 6), r = lane & 15, quad = lane >> 4;
    LAS bf16* QE = (LAS bf16*)(lds + H2_QE); LAS bf16* KT = (LAS bf16*)(lds + H2_KT); LAS bf16* KD = (LAS bf16*)(lds + H2_KD); LAS bf16* VT = (LAS bf16*)(lds + H2_VT);
    LAS bf16* AM = (LAS bf16*)(lds + H2_AM); LAS bf16* QOFF = (LAS bf16*)(lds + H2_QOFF);
    LAS float* OB = (LAS float*)(lds + H2_OB);
    LAS float* TOT = (LAS float*)(lds + H2_TOT);
    HoPre pre = ho_load_k(Z, Sbuf, l, it0, G, 0, tid);
    ho_stage(lds, pre, 0, 0, tid);
    if (nk > 1) pre = ho_load_k(Z, Sbuf, l, it0, G, 1, tid);
    __syncthreads();
#pragma unroll 1
    for (int k = 0; k < nk; ++k) {
        const int dir = k & 1;
        int b, cstep, h; ho_decode(it0 + (k >> 1) * G, l, b, cstep, h);
        const float lb = LBl[dir * 256 + h * 64 + lane];
        const LAS bf16* RAWQ = (const LAS bf16*)(lds + H2_RAW + dir * 24576); const LAS bf16* RAWF = RAWQ + 4096; const LAS bf16* RAWV = RAWQ + 8192;
        const LAS bf16* ST = (const LAS bf16*)(lds + H2_ST + dir * 9216);
        float kk[8], bb[8], cend[3];
        const float btot = hg_gates(RAWF, TOT, lb, kk, bb, lane, wave, cend, 64);
        { u32x4 x;
#pragma unroll
          for (int i = 0; i < 4; ++i) x[i] = (unsigned)RAWV[(8 * wave + 2 * i) * 64 + lane] | ((unsigned)RAWV[(8 * wave + 2 * i + 1) * 64 + lane] << 16);
          *(LAS u32x4*)(VT + lane * 72 + 8 * wave) = x; }
        { const int jj = wave >> 1;
          const float b0 = cend[0], b1 = cend[1], b2 = cend[2];
          const float be = jj == 0 ? b0 : (jj == 1 ? b1 : (jj == 2 ? b2 : btot));
          const float bs = jj == 0 ? 0.f : (jj == 1 ? b0 : (jj == 2 ? b1 : b2));
          const float Es = __expf(bs);
          const float H0 = jj >= 2 ? __expf(bs - b0) : 1.f, H1 = jj >= 3 ? __expf(bs - b1) : 1.f;
#pragma unroll
          for (int i2 = 0; i2 < 4; ++i2) { const int tau = 8 * wave + 2 * i2;
              const float ba = bb[2 * i2], bb_ = bb[2 * i2 + 1], ka = kk[2 * i2], kb_ = kk[2 * i2 + 1];
              const float qa = siluf(bf2f(RAWQ[tau * 64 + lane])) * __expf(ba - bs), qb_ = siluf(bf2f(RAWQ[(tau + 1) * 64 + lane])) * __expf(bb_ - bs);
              unsigned w;
              w = pk2(qa * Es, qb_ * Es); QE[tau * 72 + lane] = (bf16)(w & 0xffffu); QE[(tau + 1) * 72 + lane] = (bf16)(w >> 16);
              w = pk2(ka * __expf(be - ba), kb_ * __expf(be - bb_)); KT[tau * 72 + lane] = (bf16)(w & 0xffffu); KT[(tau + 1) * 72 + lane] = (bf16)(w >> 16);
              w = pk2(ka * __expf(fminf(bs - ba, 80.f)), kb_ * __expf(fminf(bs - bb_, 80.f))); KD[tau * 72 + lane] = (bf16)(w & 0xffffu); KD[(tau + 1) * 72 + lane] = (bf16)(w >> 16);
              if (jj >= 1) { w = pk2(qa * H0, qb_ * H0); QOFF[(tau - 16) * 72 + lane] = (bf16)(w & 0xffffu); QOFF[(tau - 15) * 72 + lane] = (bf16)(w >> 16); }
              if (jj >= 2) { w = pk2(qa * H1, qb_ * H1); QOFF[(48 + tau - 32) * 72 + lane] = (bf16)(w & 0xffffu); QOFF[(48 + tau - 31) * 72 + lane] = (bf16)(w >> 16); }
              if (jj >= 3) { w = pk2(qa, qb_); QOFF[(80 + tau - 48) * 72 + lane] = (bf16)(w & 0xffffu); QOFF[(80 + tau - 47) * 72 + lane] = (bf16)(w >> 16); } } }
        if (k + 1 < nk) { ho_stage(lds, pre, 1 - dir, 1 - dir, tid); if (k + 2 < nk) pre = ho_load_k(Z, Sbuf, l, it0, G, k + 2, tid); }
        __syncthreads();
#pragma unroll
        for (int ee = 0; ee < 2; ++ee) { const int bi = 2 * wave + ee, i = bi >> 2, j = bi & 3;
            if (j <= i) {
                const LAS bf16* qa = (j < i) ? QOFF + ((j == 0 ? 0 : (j == 1 ? 48 : 80)) + 16 * (i - j - 1)) * 72
                                             : (i == 0 ? QE : QOFF + (i == 1 ? 0 : (i == 2 ? 48 : 80)) * 72);
                const LAS bf16* ka = (j < i) ? KT + 16 * j * 72 : KD + 16 * i * 72;
                f32x4 acc = {0.f, 0.f, 0.f, 0.f};
                acc = mma16(qa, 72, ka, 72, 64, acc, lane);
#pragma unroll
                for (int jj = 0; jj < 4; ++jj) { const float v = (j < i || r <= quad * 4 + jj) ? acc[jj] : 0.f; AM[(16 * i + quad * 4 + jj) * 72 + 16 * j + r] = (bf16)f2bf(v); } }
            else {
#pragma unroll
                for (int jj = 0; jj < 4; ++jj) AM[(16 * i + quad * 4 + jj) * 72 + 16 * j + r] = (bf16)0; } }
        __syncthreads();
#pragma unroll
        for (int e = 0; e < 2; ++e) { const int tt = 2 * wave + e, tau0 = (tt >> 2) * 16, v0 = (tt & 3) * 16;
            f32x4 acc = {0.f, 0.f, 0.f, 0.f};
            acc = mma16(AM + tau0 * 72, 72, VT + v0 * 72, 72, tau0 < 32 ? 32 : 64, acc, lane);
            acc = mma16(QE + tau0 * 72, 72, ST + v0 * 72, 72, 64, acc, lane);
#pragma unroll
            for (int j = 0; j < 4; ++j) { const int tau = tau0 + quad * 4 + j; const int t = dir == 0 ? tau : 63 - tau;
                if (dir == 0) OB[t * 68 + v0 + r] = acc[j]; else OB[t * 68 + v0 + r] += acc[j]; } }
        if (dir == 1) {
            __syncthreads();
            const float nw = hg_norm_w_l[lane];
            const int rowbase = cstep < 4 ? ML + b * CTXL + 64 * cstep : b * SEQ + 64 * (cstep - 4);
#pragma unroll
            for (int i = 0; i < 8; ++i) { const int t = 8 * wave + i; const float v = OB[t * 68 + lane];
                const float rstd = rsqrtf(wave_sum(v * v) * (1.f / 64.f) + EPSN);
                const float gt = bf2f(Z[(size_t)(rowbase + t) * INW + ZHG + h * 64 + lane]);
                Y[(size_t)(rowbase + t) * DM + 768 + h * 64 + lane] = (bf16)f2bf(v * rstd * nw * siluf(gt)); }
        }
    }
    __syncthreads();
}

__device__ __forceinline__ void flat_barrier(unsigned* ctr, unsigned target) {
    __builtin_amdgcn_fence(__ATOMIC_RELEASE, "agent");
    asm volatile("s_waitcnt vmcnt(0)" ::: "memory");
    __syncthreads();
    if (threadIdx.x == 0) {
        __hip_atomic_fetch_add(ctr, 1u, __ATOMIC_RELEASE, __HIP_MEMORY_SCOPE_AGENT);
        while (__hip_atomic_load(ctr, __ATOMIC_ACQUIRE, __HIP_MEMORY_SCOPE_AGENT) < target) __builtin_amdgcn_s_sleep(2);
    }
    __syncthreads();
    __builtin_amdgcn_fence(__ATOMIC_ACQUIRE, "agent");
    asm volatile("s_waitcnt vmcnt(0)" ::: "memory");
}
#define XB_TMO      128
#define XB_XCNT(j)  (256  + 64 * (j))
#define XB_XSUB(j)  (1280 + 64 * (j))
#define XB_XGEN(j)  (2304 + 64 * (j))
#define XB_TOP      3328
#define XB_TOPGEN   3392
#define XCD_BAR_WORDS 3456
#define XB_SPIN_CAP (1u << 18)

__device__ __forceinline__ unsigned xb_ld(unsigned* p)              { return __hip_atomic_load(p, __ATOMIC_RELAXED, __HIP_MEMORY_SCOPE_AGENT); }
__device__ __forceinline__ unsigned xb_add(unsigned* p, unsigned v) { return __hip_atomic_fetch_add(p, v, __ATOMIC_RELAXED, __HIP_MEMORY_SCOPE_AGENT); }
__device__ __forceinline__ unsigned xb_xcc_id() { return (unsigned)__builtin_amdgcn_s_getreg((3 << 11) | 20) & 0xFu; }
#define XB_SPIN(cond, bar) do { unsigned _sp = 0; while (cond) { __builtin_amdgcn_s_sleep(1); \
    if ((++_sp & 255u) == 0u) { if (xb_ld(&(bar)[XB_TMO])) break; if (_sp > XB_SPIN_CAP) { atomicAdd(&(bar)[XB_TMO], 1u); break; } } } } while (0)

struct XcdBarrier {
    unsigned* bar; unsigned x;
    volatile LAS unsigned* st;
};

__device__ __forceinline__ XcdBarrier xcd_barrier_post(unsigned* bar, volatile LAS unsigned* st) {
    XcdBarrier b; b.bar = bar; b.x = xb_xcc_id(); b.st = st;
    if (threadIdx.x == 0) (void)xb_add(&bar[XB_XCNT(b.x)], 1u);
    return b;
}
__device__ __forceinline__ void xcd_barrier_complete(unsigned* bar, unsigned x, unsigned& nloc, unsigned& nx) {
    const unsigned G = gridDim.x * gridDim.y * gridDim.z;
    unsigned sum, cnt, mine, sp = 0u;
    for (;;) {
        sum = 0u; cnt = 0u; mine = 0u;
#pragma unroll
        for (unsigned j = 0; j < 16; ++j) { const unsigned c = xb_ld(&bar[XB_XCNT(j)]); sum += c; cnt += (c > 0u) ? 1u : 0u; mine = (j == x) ? c : mine; }
        if (sum == G) break;
        __builtin_amdgcn_s_sleep(1);
        if ((++sp & 255u) == 0u) { if (xb_ld(&bar[XB_TMO])) break; if (sp > XB_SPIN_CAP) { atomicAdd(&bar[XB_TMO], 1u); break; } }
    }
    nloc = mine > 0u ? mine : 1u; nx = cnt > 0u ? cnt : 1u;
}

__device__ __forceinline__ void xcd_barrier(const XcdBarrier& b) {
    asm volatile("s_waitcnt vmcnt(0)" ::: "memory");
    __syncthreads();
    if (threadIdx.x == 0) {
        unsigned* bar = b.bar;
        __builtin_amdgcn_s_waitcnt(0);
        unsigned nloc = b.st[0], nx = b.st[1];
        if (nloc == 0u) { xcd_barrier_complete(bar, b.x, nloc, nx); b.st[0] = nloc; b.st[1] = nx; }
        const unsigned old = xb_add(&bar[XB_XSUB(b.x)], 1u);
        const unsigned gen = old / nloc;
        if (old + 1u == (gen + 1u) * nloc) {
            __builtin_amdgcn_fence(__ATOMIC_RELEASE, "agent");
            asm volatile("s_waitcnt vmcnt(0)" ::: "memory");
            const unsigned og = xb_add(&bar[XB_TOP], 1u);
            const unsigned tg = og / nx;
            if (og + 1u == (tg + 1u) * nx) xb_add(&bar[XB_TOPGEN], 1u);
            else XB_SPIN(xb_ld(&bar[XB_TOPGEN]) == tg, bar);
            __builtin_amdgcn_fence(__ATOMIC_ACQUIRE, "agent");
            xb_add(&bar[XB_XGEN(b.x)], 1u);
            asm volatile("s_waitcnt vmcnt(0)" ::: "memory");
        } else {
            XB_SPIN(xb_ld(&bar[XB_XGEN(b.x)]) == gen, bar);
            __builtin_amdgcn_fence(__ATOMIC_ACQUIRE, "agent");
            asm volatile("s_waitcnt vmcnt(0)" ::: "memory");
        }
    }
    __syncthreads();
}

constexpr int NPHASE = 20;
#ifndef EN_MASK
#define EN_MASK 0x3ff
#endif
#define EN(k) (((EN_MASK) >> (k)) & 1)
#ifndef REP_OP0
#define REP_OP0 1
#endif
#ifndef REP_SYNC
#define REP_SYNC 0
#endif
#ifndef REP_PRO
#define REP_PRO 1
#endif
#ifndef REP_NORM
#define REP_NORM 1
#endif
#ifndef REP_MIX1
#define REP_MIX1 1
#endif
#ifndef REP_HGO
#define REP_HGO 1
#endif
#ifndef REP_GZ
#define REP_GZ 1
#endif
#ifndef REP_ATT
#define REP_ATT 1
#endif
#ifndef REP_HU
#define REP_HU 1
#endif
#ifndef REP_POOL
#define REP_POOL 1
#endif
typedef __attribute__((address_space(4))) const Params CParams;
__device__ __forceinline__ CParams* kparams() { CParams* p = (CParams*)__builtin_amdgcn_kernarg_segment_ptr(); asm volatile("" : "+s"(p)); return p; }
__device__ __forceinline__ Params ldparams(CParams* k) { Params P;
    P.x = k->x; P.c = k->c; P.ctx = k->ctx; P.c_ctx = k->c_ctx; P.w_ada = k->w_ada; P.b_ada = k->b_ada; P.norm1_w = k->norm1_w; P.w_in = k->w_in; P.pool_w = k->pool_w; P.pool_scale = k->pool_scale;
    P.attn_sink = k->attn_sink; P.hg_lower = k->hg_lower; P.hg_norm_w = k->hg_norm_w; P.w_out = k->w_out; P.norm2_w = k->norm2_w; P.w_mlp1 = k->w_mlp1; P.w_mlp2 = k->w_mlp2; P.final_norm_w = k->final_norm_w;
    P.out = k->out; P.ws = k->ws; P.ph_lo = k->ph_lo; P.ph_hi = k->ph_hi; return P; }
#define WSP(T, off) ((T*)(P.ws + (off)))
__global__ void __launch_bounds__(NTHREADS, 2) fwd_kernel(Params Parg) {
    extern __shared__ __attribute__((aligned(16))) unsigned char lds_raw[];
    LAS unsigned char* lds = (LAS unsigned char*)lds_raw;
    cg::grid_group grid = cg::this_grid();
    const int lo = Parg.ph_lo, hi = Parg.ph_hi;
    volatile LAS unsigned* bst = (volatile LAS unsigned*)(lds + LDS_BYTES - 256);
    if (threadIdx.x == 0) { bst[0] = 0u; bst[1] = 0u; }
    __syncthreads();
    const XcdBarrier xbar = xcd_barrier_post((unsigned*)(Parg.ws + WS_CTL), bst);
#define IN(k) (lo <= (k) && (k) < hi)
#define SEAM(k) do { if (IN(k) && IN((k) + 1)) { if (lo < 0) grid.sync(); else xcd_barrier(xbar); } } while (0)
    if (EN(0) && IN(0)) for (int rep = 0; rep < REP_PRO; ++rep) { const Params P = ldparams(kparams()); ph_prologue(P, lds); }
    SEAM(0);
#pragma unroll 1
    for (int l = 0; l < 2; ++l) {
        const int pb = 1 + 9 * l;
        const int mrows = l == 0 ? MT : ML;
        if (EN(1) && IN(pb + 0)) for (int rep = 0; rep < REP_NORM; ++rep) { const Params P = ldparams(kparams());
            ph_norm_mod(l == 0 ? P.x : P.out, l == 0 ? P.ctx : WSP(const float, WS_XC), MT, P.norm1_w + l * DM, WSP(const float, WS_MOD) + (size_t)l * 9 * 6144, 0, 1024, WSP(bf16, WS_ACT),
                        l == 0 ? (const float*)nullptr : WSP(const float, WS_P1), WSP(const float, WS_P2), WSP(const float, WS_P3), (l == 1 && gridDim.x == 256) ? ML : 0); }
        SEAM(pb + 0);
        if (EN(2) && IN(pb + 1)) for (int rep = 0; rep < REP_GZ; ++rep) { const Params P = ldparams(kparams());
            pg8::Gemm g{WSP(const bf16, WS_ACT), WSP(const bf16, WS_WT + (size_t)l * WT_LAYER + WT_IN), MT, INW, DM, DM}; pg8::StaticOrder S; S.init(MT, INW, gridDim.x, blockIdx.x);
            pg8::EpiBf E{WSP(bf16, WS_Z), INW, 0}; pg8::gemm_phase<pg8::EpiBf, pg8::StaticOrder, true, true>(lds, g, S, E);
            if (l == 0) {
                const int G = (int)gridDim.x, nun = (MT / 256) * (INW / 256), rem = nun % G, first = rem == 0 ? 0 : rem, nb = G - first;
                if ((int)blockIdx.x >= first) { const int t_ = otid(); const int w_ = __builtin_amdgcn_readfirstlane(t_ >> 6);
                    convert_weights(P, lds, 0, ((int)blockIdx.x - first) * 8 + w_, nb * 8, w_, t_ & 63, 1152, 5760); } } }
        SEAM(pb + 1);
        if (IN(pb + 2)) for (int rep = 0; rep < REP_MIX1; ++rep) { const Params P = ldparams(kparams());
            const bf16* Z = WSP(const bf16, WS_Z); bf16* ACT = WSP(bf16, WS_ACT);
            const int n_attn = l == 0 ? 576 : 512, n_pool = l == 0 ? 288 : 256, G = (int)gridDim.x, bx = (int)blockIdx.x;
            const int NCH = 64;
            if (G >= 2 * NCH) {
                if (bx < NCH) { if (EN(4)) hg_chain(lds, Z, WSP(const float, WS_LB) + l * 512, WSP(float, WS_S), bx); }
                else for (int it = bx - NCH; it < n_attn; it += G - NCH) { if (EN(3)) attn_unit(lds, Z, ACT, P.attn_sink + l * 8, WSP(const float2, WS_ROPE), it); }
            } else {
                for (int c = bx; c < NCH; c += G) hg_chain(lds, Z, WSP(const float, WS_LB) + l * 512, WSP(float, WS_S), c);
                for (int it = bx; it < n_attn; it += G) attn_unit(lds, Z, ACT, P.attn_sink + l * 8, WSP(const float2, WS_ROPE), it);
            }
            __syncthreads();
            {
                int j0 = bx, jstep = G;
                if (G == 256) {
                    if (l == 1) { j0 = bx >= 192 ? bx - 192 : n_pool; jstep = 64; }
                    else { if (bx >= 192) { j0 = bx - 192; jstep = 64; if (0) {} }
                           else if (bx < 160) { j0 = 128 + bx; jstep = 1024; }
                           else { j0 = n_pool; } }
                }
                const int jlim = (G == 256 && l == 0 && bx >= 192) ? 128 : n_pool;
                if (EN(5)) for (int j = j0; j < jlim; j += jstep) pool_unit(lds, Z, ACT, WSP(const bf16, WS_PWT) + (size_t)l * 4 * 64 * 64, P.pool_scale + l * 256, j);
            }
        }
        SEAM(pb + 2);
        if (EN(7) && IN(pb + 4)) for (int rep = 0; rep < REP_HGO; ++rep) { const Params P = ldparams(kparams());
            const int n_u = l == 0 ? 8 * 36 * 4 : 8 * 32 * 4;
            ph_hgO(lds, WSP(const bf16, WS_Z), WSP(bf16, WS_ACT), WSP(const float, WS_LB) + l * 512, WSP(const float, WS_S), P.hg_norm_w + l * 64, l, n_u);
        }
        SEAM(pb + 4);
        const bool fuse_n2 = (gridDim.x == 256);
        if (EN(8) && IN(pb + 5) && fuse_n2) { const Params P = ldparams(kparams());
            { pg8::Gemm g{WSP(const bf16, WS_ACT), WSP(const bf16, WS_WT + (size_t)l * WT_LAYER + WT_OUT), ML, DM, DM, DM}; pg8::StaticOrder S; S.init(ML, DM, gridDim.x, blockIdx.x);
              const float* modl = WSP(const float, WS_MOD) + (size_t)l * 9 * 6144;
              pg8::EpiNorm2 E{l == 0 ? P.x : P.out, P.out, modl + 2048, P.norm2_w + l * DM, modl + 4096, modl + 3072, WSP(bf16, WS_ACT), WSP(unsigned long long, WS_FSLOT + (l == 0 ? 1536 : 512) * 1024), WSP(unsigned, WS_CTL) + (l == 0 ? 16384 : 8192), EPSN, 0, -1};
              pg8::gemm_phase<pg8::EpiNorm2, pg8::StaticOrder, false, true>(lds, g, S, E); }
            if (l == 0) {
                pg8::Gemm g{WSP(const bf16, WS_ACT), WSP(const bf16, WS_WT + WT_OUT), MT, DM, DM, DM}; pg8::SplitOrder S{64, 8, 4, 1, (int)gridDim.x, (int)blockIdx.x};
                const float* mod0 = WSP(const float, WS_MOD);
                pg8::EpiNorm2 E{P.ctx, WSP(float, WS_XC), mod0 + 2048, P.norm2_w, mod0 + 4096, mod0 + 3072, WSP(bf16, WS_ACT), WSP(unsigned long long, WS_FSLOT + 2048 * 1024), WSP(unsigned, WS_CTL) + 20480, EPSN, 64, 8};
                pg8::gemm_phase<pg8::EpiNorm2, pg8::SplitOrder, false, true>(lds, g, S, E);
                if ((int)blockIdx.x >= 32) { const int t_ = otid(); const int w_ = __builtin_amdgcn_readfirstlane(t_ >> 6);
                    convert_weights(P, lds, 1, ((int)blockIdx.x - 32) * 8 + w_, ((int)gridDim.x - 32) * 8, w_, t_ & 63, 0, 5760); } } }
        if (EN(8) && IN(pb + 5) && !fuse_n2) for (int rep = 0; rep < (l == 0 ? REP_OP0 : 1); ++rep) { const Params P = ldparams(kparams());
            pg8::Gemm g{WSP(const bf16, WS_ACT), WSP(const bf16, WS_WT + (size_t)l * WT_LAYER + WT_OUT), mrows, DM, DM, DM}; pg8::StaticOrder S; S.init(mrows, DM, gridDim.x, blockIdx.x);
            pg8::EpiRes E{l == 0 ? P.x : P.out, l == 0 ? P.ctx : WSP(const float, WS_XC), P.out, WSP(float, WS_XC), WSP(const float, WS_MOD) + (size_t)l * 9 * 6144 + 2048};
            pg8::gemm_phase<pg8::EpiRes, pg8::StaticOrder, true, true>(lds, g, S, E);
            if (l == 0) {
                const int G = (int)gridDim.x, nun = (MT / 256) * (DM / 256), rem = nun % G, first = rem == 0 ? 0 : rem, nb = G - first;
                if ((int)blockIdx.x >= first) { const int t_ = otid(); const int w_ = __builtin_amdgcn_readfirstlane(t_ >> 6);
                    convert_weights(P, lds, 1, ((int)blockIdx.x - first) * 8 + w_, nb * 8, w_, t_ & 63, 0, 5760); } } }
        if (!fuse_n2) SEAM(pb + 5);
        if (EN(1) && IN(pb + 6) && !fuse_n2) for (int rep = 0; rep < REP_NORM; ++rep) { const Params P = ldparams(kparams());
            ph_norm_mod(P.out, WSP(const float, WS_XC), mrows, P.norm2_w + l * DM, WSP(const float, WS_MOD) + (size_t)l * 9 * 6144, 3072, 4096, WSP(bf16, WS_ACT), nullptr, nullptr, nullptr, fuse_n2 ? ML : 0); }
        SEAM(pb + 6);
        if (EN(2) && IN(pb + 7)) for (int rep = 0; rep < REP_GZ; ++rep) { const Params P = ldparams(kparams());
            pg8::Gemm g{WSP(const bf16, WS_ACT), WSP(const bf16, WS_WT + (size_t)l * WT_LAYER + WT_W1), mrows, DFF, DM, DM}; pg8::StaticOrder S; S.init(mrows, DFF, gridDim.x, blockIdx.x);
            pg8::EpiBf E{WSP(bf16, WS_HH), DFF, 1}; pg8::gemm_phase<pg8::EpiBf, pg8::StaticOrder, true, true>(lds, g, S, E); }
        SEAM(pb + 7);
        if (EN(8) && IN(pb + 8)) { const Params P = ldparams(kparams());
            if (l == 1 && gridDim.x == 256) {
              pg8::Gemm g{WSP(const bf16, WS_HH), WSP(const bf16, WS_WT + (size_t)l * WT_LAYER + WT_W2), ML, DM, DFF, DFF}; pg8::StaticOrder S; S.init(ML, DM, gridDim.x, blockIdx.x);
              pg8::EpiFinal E{P.out, P.out, WSP(const float, WS_MOD) + (size_t)l * 9 * 6144 + 5120, P.final_norm_w, WSP(unsigned long long, WS_FSLOT), WSP(unsigned, WS_CTL) + 4096, EPSN};
              pg8::gemm_phase<pg8::EpiFinal, pg8::StaticOrder, false, true>(lds, g, S, E); }
            else
            if (l == 0 && gridDim.x == 256) {
              pg8::Gemm g{WSP(const bf16, WS_HH), WSP(const bf16, WS_WT + WT_W2), ML, DM, DFF, DFF}; pg8::StaticOrder S; S.init(ML, DM, gridDim.x, blockIdx.x);
              const float* mod0 = WSP(const float, WS_MOD); const float* mod1 = mod0 + 9 * 6144;
              pg8::EpiNorm2 E{P.out, P.out, mod0 + 5120, P.norm1_w + DM, mod1 + 1024, mod1 + 0, WSP(bf16, WS_ACT), WSP(unsigned long long, WS_FSLOT + 1024 * 1024), WSP(unsigned, WS_CTL) + 12288, EPSN, 0, -1};
              pg8::gemm_phase<pg8::EpiNorm2, pg8::StaticOrder, false, true>(lds, g, S, E); }
            else
            { pg8::Gemm g{WSP(const bf16, WS_HH), WSP(const bf16, WS_WT + (size_t)l * WT_LAYER + WT_W2), ML, DM, DFF, DFF}; pg8::StaticOrder S; S.init(ML, DM, gridDim.x, blockIdx.x);
              pg8::EpiRes E{P.out, WSP(const float, WS_XC), P.out, WSP(float, WS_XC), WSP(const float, WS_MOD) + (size_t)l * 9 * 6144 + 5120};
              pg8::gemm_phase<pg8::EpiRes, pg8::StaticOrder, true, true>(lds, g, S, E); }
            if (l == 0) {
              pg8::Gemm g{WSP(const bf16, WS_HH), WSP(const bf16, WS_WT + WT_W2), MT, DM, 1024, DFF}; pg8::SplitOrder S{64, 8, 4, 4, (int)gridDim.x, (int)blockIdx.x};
              pg8::EpiPart E{WSP(float, WS_XC), WSP(float, WS_P1), WSP(float, WS_P2), WSP(float, WS_P3), WSP(const float, WS_MOD) + 8 * 6144 + 5120};
              pg8::gemm_phase<pg8::EpiPart, pg8::SplitOrder, true, true>(lds, g, S, E); } }
        if (!(l == 1 && gridDim.x == 256)) SEAM(pb + 8);
    }
    for (int rep = 0; rep < REP_SYNC; ++rep) xcd_barrier(xbar);
    if (EN(9) && IN(19) && gridDim.x != 256) { const Params P = ldparams(kparams()); ph_final_norm(P.out, P.final_norm_w, P.out); }
#undef IN
#undef SEAM
}

#ifndef N_LAUNCH_MODE
#define N_LAUNCH_MODE 1
#endif
extern "C" void kernel_launch(void* const* d_in, const int* in_sizes, int n_in, void* d_out, int out_size, void* d_ws, size_t ws_size, hipStream_t stream) {
    static int grid = 0;
    if (grid == 0) {
        if (n_in != 18 || out_size != ML * DM || ws_size < WS_END) { fprintf(stderr, "kernel_launch: unexpected shapes (n_in %d out %d ws %zu)\n", n_in, out_size, ws_size); grid = -1; return; }
        int dev = 0, cus = 0, per_cu = 0;
        hipGetDevice(&dev); hipDeviceGetAttribute(&cus, hipDeviceAttributeMultiprocessorCount, dev);
        hipFuncSetAttribute((const void*)fwd_kernel, hipFuncAttributeMaxDynamicSharedMemorySize, LDS_BYTES);
        hipOccupancyMaxActiveBlocksPerMultiprocessor(&per_cu, (const void*)fwd_kernel, NTHREADS, LDS_BYTES);
        if (per_cu < 1) { fprintf(stderr, "kernel_launch: occupancy query returned %d\n", per_cu); per_cu = 1; }
        grid = cus * per_cu;
        fprintf(stderr, "kernel_launch: cus %d per_cu %d grid %d\n", cus, per_cu, grid);
    }
    if (grid < 0) return;
    hipMemsetAsync((unsigned char*)d_ws + WS_CTL, 0, CTL_BYTES, stream);
    Params p{};
    const float** pp = (const float**)&p;
    for (int i = 0; i < 18; ++i) pp[i] = (const float*)d_in[i];
    p.out = (float*)d_out; p.ws = (unsigned char*)d_ws;
#if N_LAUNCH_MODE == 1
    p.ph_lo = 0; p.ph_hi = NPHASE;
    void* args[] = {&p};
    hipError_t e = hipLaunchCooperativeKernel((const void*)fwd_kernel, dim3(grid), dim3(NTHREADS), args, LDS_BYTES, stream);
    if (e != hipSuccess) fprintf(stderr, "cooperative launch failed: %s (grid %d)\n", hipGetErrorString(e), grid);
#else
    for (int k = 0; k < NPHASE; ++k) { p.ph_lo = k; p.ph_hi = k + 1;
        hipLaunchKernelGGL(fwd_kernel, dim3(grid), dim3(NTHREADS), LDS_BYTES, stream, p); }
#endif
}
```

```cpp
#include <hip/hip_runtime.h>
#include <hip/hip_cooperative_groups.h>
#include <cstdio>
#include <cstdint>
namespace cg = cooperative_groups;
namespace pg8 {
#define PG8_LAS __attribute__((address_space(3)))
typedef unsigned short bf16_t;
typedef short bf16x8 __attribute__((ext_vector_type(8)));
typedef float f32x4 __attribute__((ext_vector_type(4)));
typedef unsigned u32x4 __attribute__((ext_vector_type(4)));
constexpr int BM = 256, BK = 64, HALF = 128, HTB = HALF * BK * 2  , STAGE_BYTES = 8 * HTB, NXCD = 8, WGM = 4;

__host__ __device__ __forceinline__ int lds_byte(int r, int c) { const int st = (r >> 4) * 2 + (c >> 5), rr = r & 15, cc = c & 31, ob = rr * 64 + cc * 2; return st * 1024 + (ob ^ (((ob >> 9) & 1) << 5)); }
__host__ __device__ __forceinline__ void stage_rc(int b, int& R, int& C) { const int st = b / 1024, sb = b % 1024, swz = sb ^ (((sb >> 9) & 1) << 5); R = (st >> 1) * 16 + swz / 64; C = (st & 1) * 32 + (swz % 64) / 2; }
__host__ __device__ __forceinline__ int perm32(int rho) { const int n = rho >> 4, i = rho & 15; return 8 * (i >> 2) + 4 * n + (i & 3); }

struct Unit { int pm, pn, ks; };
struct Gemm { const bf16_t* A; const bf16_t* Bt; int M, N, K, ld; };

struct StaticOrder {
    int nM, nN, nwg, G, c;
    __host__ __device__ void init(int M, int N, int G_, int c_) { nM = M / BM; nN = N / BM; nwg = nM * nN; G = G_; c = c_; }
    __host__ __device__ bool next(int i, Unit& u) const {
        const long L = (long)i * G + c; if (L >= nwg) return false;
        int wgid = (int)L; { const int q = nwg / NXCD, r = nwg % NXCD, xcd = wgid % NXCD, off = wgid / NXCD; wgid = (xcd < r ? xcd * (q + 1) : r * (q + 1) + (xcd - r) * q) + off; }
        const int nig = WGM * nN, gid = wgid / nig, fm = gid * WGM, gsz = (nM - fm) < WGM ? (nM - fm) : WGM;
        u.pm = fm + ((wgid % nig) % gsz); u.pn = (wgid % nig) / gsz; u.ks = 0; return true;
    }
    __device__ __forceinline__ void a_ready(const Unit&) const {}
    __device__ __forceinline__ void done(const Unit&) const {}
};
__device__ __forceinline__ unsigned cvt_pk_bf16(float lo, float hi) { unsigned r; asm volatile("v_cvt_pk_bf16_f32 %0, %1, %2" : "=v"(r) : "v"(lo), "v"(hi)); return r; }
typedef float f32x2 __attribute__((ext_vector_type(2)));
struct EpiBf {
    static constexpr bool PERM = true, AFTER_DRAIN = false;
    bf16_t* O; int ldc; int act;
    __device__ __forceinline__ void operator()(const f32x4 (&acc)[2][2][4][2], const Unit& u, int wr, int wc, int fr, int fq) const {
        const int row0 = u.pm * BM + wr * 64 + fr; const int col0 = u.pn * BM + wc * 32 + 8 * fq;
#pragma unroll
        for (int ai = 0; ai < 2; ++ai)
#pragma unroll
            for (int m = 0; m < 4; ++m) { bf16_t* rowp = O + (size_t)(row0 + ai * HALF + m * 16) * ldc + col0;
#pragma unroll
                for (int bj = 0; bj < 2; ++bj) { f32x4 v0 = acc[ai][bj][m][0], v1 = acc[ai][bj][m][1];
                    if (act) {
#pragma unroll
                        for (int e = 0; e < 4; ++e) { float a = fmaxf(v0[e], 0.f), b = fmaxf(v1[e], 0.f); v0[e] = a * a; v1[e] = b * b; } }
                    u32x4 w; w.x = cvt_pk_bf16(v0[0], v0[1]); w.y = cvt_pk_bf16(v0[2], v0[3]); w.z = cvt_pk_bf16(v1[0], v1[1]); w.w = cvt_pk_bf16(v1[2], v1[3]);
                    *(u32x4*)(rowp + bj * HALF) = w; } }
    }
};
struct EpiRes {
    static constexpr bool PERM = false, AFTER_DRAIN = false;
    const float* res_lat; const float* res_ctx; float* out_lat; float* out_ctx; const float* gate;
    __device__ __forceinline__ void operator()(const f32x4 (&acc)[2][2][4][2], const Unit& u, int wr, int wc, int fr, int fq) const {
        const bool lat = u.pm < 64;
        const float* res = lat ? res_lat + (size_t)u.pm * BM * 1024 : res_ctx + (size_t)(u.pm - 64) * BM * 1024;
        float* out = lat ? out_lat + (size_t)u.pm * BM * 1024 : out_ctx + (size_t)(u.pm - 64) * BM * 1024;
        const float* g = gate + (size_t)(lat ? (u.pm >> 3) : 8) * 6144;
        const int col0 = u.pn * BM + wc * 32 + 4 * fq;
        f32x4 gv[2][2];
#pragma unroll
        for (int bj = 0; bj < 2; ++bj)
#pragma unroll
            for (int n = 0; n < 2; ++n) gv[bj][n] = *(const f32x4*)(g + col0 + bj * HALF + n * 16);
#pragma unroll
        for (int ai = 0; ai < 2; ++ai)
#pragma unroll
            for (int m = 0; m < 4; ++m) { const size_t off = (size_t)(ai * HALF + wr * 64 + m * 16 + fr) * 1024 + col0;
#pragma unroll
                for (int bj = 0; bj < 2; ++bj)
#pragma unroll
                    for (int n = 0; n < 2; ++n) { const f32x4 r = *(const f32x4*)(res + off + bj * HALF + n * 16);
                        *(f32x4*)(out + off + bj * HALF + n * 16) = r + gv[bj][n] * acc[ai][bj][m][n]; } }
    }
};

struct SplitOrder {
    int pm0, npm, nN, nks, G, c;
    __device__ __forceinline__ bool next(int i, Unit& u) const { const int L = i * G + c; if (L >= npm * nN * nks) return false;
        u.ks = L % nks; const int t = L / nks; u.pn = t % nN; u.pm = pm0 + t / nN; return true; }
    __device__ __forceinline__ void a_ready(const Unit&) const {}
    __device__ __forceinline__ void done(const Unit&) const {}
};
struct EpiPart {
    static constexpr bool PERM = false, AFTER_DRAIN = false;
    float* xc; float* p1; float* p2; float* p3; const float* gate;
    __device__ __forceinline__ void operator()(const f32x4 (&acc)[2][2][4][2], const Unit& u, int wr, int wc, int fr, int fq) const {
        float* base = u.ks == 0 ? xc : (u.ks == 1 ? p1 : (u.ks == 2 ? p2 : p3));
        float* out = base + (size_t)(u.pm - 64) * BM * 1024;
        const bool inplace = u.ks == 0;
        const int col0 = u.pn * BM + wc * 32 + 4 * fq;
        f32x4 gv[2][2];
#pragma unroll
        for (int bj = 0; bj < 2; ++bj)
#pragma unroll
            for (int n = 0; n < 2; ++n) gv[bj][n] = *(const f32x4*)(gate + col0 + bj * HALF + n * 16);
#pragma unroll
        for (int ai = 0; ai < 2; ++ai)
#pragma unroll
            for (int m = 0; m < 4; ++m) { const size_t off = (size_t)(ai * HALF + wr * 64 + m * 16 + fr) * 1024 + col0;
#pragma unroll
                for (int bj = 0; bj < 2; ++bj)
#pragma unroll
                    for (int n = 0; n < 2; ++n) { f32x4 v = gv[bj][n] * acc[ai][bj][m][n]; float* p = out + off + bj * HALF + n * 16;
                        if (inplace) v = v + *(const f32x4*)p;
                        *(f32x4*)p = v; } }
    }
};

typedef unsigned epi_u32x2 __attribute__((ext_vector_type(2)));
struct EpiFinal {
    static constexpr bool PERM = false, AFTER_DRAIN = true;
    const float* res; float* out; const float* gate; const float* w; unsigned long long* slots; unsigned* cnt; float eps;
    __device__ __forceinline__ void operator()(const f32x4 (&)[2][2][4][2], const Unit&, int, int, int, int) const {}
    __device__ __forceinline__ void fused(f32x4 (&acc)[2][2][4][2], const Unit& u, int wr, int wc, int fr, int fq, PG8_LAS unsigned char* lds, int wid, int lane) const {
        const float* rs = res + (size_t)u.pm * BM * 1024; float* o = out + (size_t)u.pm * BM * 1024;
        const float* g = gate + (size_t)(u.pm >> 3) * 6144;
        const int col0 = u.pn * BM + wc * 32 + 4 * fq;
        PG8_LAS float* Pp = (PG8_LAS float*)lds;
        PG8_LAS float* Sr = (PG8_LAS float*)(lds + 4096);
        f32x4 gv[2][2];
#pragma unroll
        for (int bj = 0; bj < 2; ++bj)
#pragma unroll
            for (int n = 0; n < 2; ++n) gv[bj][n] = *(const f32x4*)(g + col0 + bj * HALF + n * 16);
#pragma unroll
        for (int ai = 0; ai < 2; ++ai)
#pragma unroll
            for (int m = 0; m < 4; ++m) { const int row = ai * HALF + wr * 64 + m * 16 + fr; const size_t off = (size_t)row * 1024 + col0; float s = 0.f;
#pragma unroll
                for (int bj = 0; bj < 2; ++bj)
#pragma unroll
                    for (int n = 0; n < 2; ++n) { const f32x4 r = __builtin_nontemporal_load((const f32x4*)(rs + off + bj * HALF + n * 16)); const f32x4 x = r + gv[bj][n] * acc[ai][bj][m][n]; acc[ai][bj][m][n] = x;
                        s += (x[0] * x[0] + x[1] * x[1]) + (x[2] * x[2] + x[3] * x[3]); }
                { const epi_u32x2 t = __builtin_amdgcn_permlane16_swap(__float_as_uint(s), __float_as_uint(s), false, false); s = __uint_as_float(t.x) + __uint_as_float(t.y); }
                { const epi_u32x2 t = __builtin_amdgcn_permlane32_swap(__float_as_uint(s), __float_as_uint(s), false, false); s = __uint_as_float(t.x) + __uint_as_float(t.y); }
                if (fq == 0) Pp[row * 4 + wc] = s; }
        asm volatile("s_waitcnt lgkmcnt(0)" ::: "memory"); __builtin_amdgcn_s_barrier(); asm volatile("" ::: "memory");
        const int tid = wid * 64 + lane;
        if (tid < 256) { const f32x4 p = *(const PG8_LAS f32x4*)(Pp + tid * 4); const float tot = (p[0] + p[1]) + (p[2] + p[3]);
            __hip_atomic_store(slots + ((size_t)(u.pm * 4 + u.pn) * 256 + tid), (unsigned long long)__float_as_uint(tot) | (1ull << 32), __ATOMIC_RELAXED, __HIP_MEMORY_SCOPE_AGENT); }
        asm volatile("s_waitcnt vmcnt(0)" ::: "memory"); __builtin_amdgcn_s_barrier(); asm volatile("" ::: "memory");
        if (tid == 0) { __hip_atomic_fetch_add(cnt + 64 * u.pm, 1u, __ATOMIC_RELAXED, __HIP_MEMORY_SCOPE_AGENT);
            unsigned sp = 0; while (__hip_atomic_load(cnt + 64 * u.pm, __ATOMIC_RELAXED, __HIP_MEMORY_SCOPE_AGENT) < 4u) { __builtin_amdgcn_s_sleep(1); if (++sp > (1u << 20)) break; } }
        asm volatile("s_waitcnt vmcnt(0) lgkmcnt(0)" ::: "memory"); __builtin_amdgcn_s_barrier(); asm volatile("" ::: "memory");
        if (tid < 256) { float tot = 0.f;
#pragma unroll
            for (int t = 0; t < 4; ++t) tot += __uint_as_float((unsigned)__hip_atomic_load(slots + ((size_t)(u.pm * 4 + t) * 256 + tid), __ATOMIC_RELAXED, __HIP_MEMORY_SCOPE_AGENT));
            Sr[tid] = 1.0f / sqrtf(tot * (1.0f / 1024.0f) + eps); }
        asm volatile("s_waitcnt vmcnt(0) lgkmcnt(0)" ::: "memory"); __builtin_amdgcn_s_barrier(); asm volatile("" ::: "memory");
        f32x4 wv[2][2];
#pragma unroll
        for (int bj = 0; bj < 2; ++bj)
#pragma unroll
            for (int n = 0; n < 2; ++n) wv[bj][n] = *(const f32x4*)(w + col0 + bj * HALF + n * 16);
#pragma unroll
        for (int ai = 0; ai < 2; ++ai)
#pragma unroll
            for (int m = 0; m < 4; ++m) { const int row = ai * HALF + wr * 64 + m * 16 + fr; const size_t off = (size_t)row * 1024 + col0; const float rstd = Sr[row];
#pragma unroll
                for (int bj = 0; bj < 2; ++bj)
#pragma unroll
                    for (int n = 0; n < 2; ++n) __builtin_nontemporal_store(acc[ai][bj][m][n] * rstd * wv[bj][n], (f32x4*)(o + off + bj * HALF + n * 16)); }
        asm volatile("s_waitcnt lgkmcnt(0)" ::: "memory"); __builtin_amdgcn_s_barrier(); asm volatile("" ::: "memory");
    }
};

struct EpiNorm2 {
    static constexpr bool PERM = false, AFTER_DRAIN = true;
    const float* res; float* out; const float* gate; const float* nw; const float* ms; const float* msh; bf16_t* hb; unsigned long long* slots; unsigned* cnt; float eps; int pm_sub; int mrow_c;
    __device__ __forceinline__ void operator()(const f32x4 (&)[2][2][4][2], const Unit&, int, int, int, int) const {}
    __device__ __forceinline__ void fused(f32x4 (&acc)[2][2][4][2], const Unit& u, int wr, int wc, int fr, int fq, PG8_LAS unsigned char* lds, int wid, int lane) const {
        const int pl = u.pm - pm_sub;
        const float* rs = res + (size_t)pl * BM * 1024; float* o = out + (size_t)pl * BM * 1024; bf16_t* hp = hb + (size_t)u.pm * BM * 1024;
        const size_t mrow = (size_t)(mrow_c >= 0 ? mrow_c : (u.pm >> 3)) * 6144;
        const int col0 = u.pn * BM + wc * 32 + 4 * fq;
        PG8_LAS float* Pp = (PG8_LAS float*)lds;
        PG8_LAS float* Sr = (PG8_LAS float*)(lds + 4096);
        f32x4 gv[2][2];
#pragma unroll
        for (int bj = 0; bj < 2; ++bj)
#pragma unroll
            for (int n = 0; n < 2; ++n) gv[bj][n] = *(const f32x4*)(gate + mrow + col0 + bj * HALF + n * 16);
#pragma unroll
        for (int ai = 0; ai < 2; ++ai)
#pragma unroll
            for (int m = 0; m < 4; ++m) { const int row = ai * HALF + wr * 64 + m * 16 + fr; const size_t off = (size_t)row * 1024 + col0; float s = 0.f;
#pragma unroll
                for (int bj = 0; bj < 2; ++bj)
#pragma unroll
                    for (int n = 0; n < 2; ++n) { const f32x4 r = __builtin_nontemporal_load((const f32x4*)(rs + off + bj * HALF + n * 16)); const f32x4 x = r + gv[bj][n] * acc[ai][bj][m][n]; acc[ai][bj][m][n] = x;
                        *(f32x4*)(o + off + bj * HALF + n * 16) = x;
                        s += (x[0] * x[0] + x[1] * x[1]) + (x[2] * x[2] + x[3] * x[3]); }
                { const epi_u32x2 t = __builtin_amdgcn_permlane16_swap(__float_as_uint(s), __float_as_uint(s), false, false); s = __uint_as_float(t.x) + __uint_as_float(t.y); }
                { const epi_u32x2 t = __builtin_amdgcn_permlane32_swap(__float_as_uint(s), __float_as_uint(s), false, false); s = __uint_as_float(t.x) + __uint_as_float(t.y); }
                if (fq == 0) Pp[row * 4 + wc] = s; }
        asm volatile("s_waitcnt lgkmcnt(0)" ::: "memory"); __builtin_amdgcn_s_barrier(); asm volatile("" ::: "memory");
        const int tid = wid * 64 + lane;
        if (tid < 256) { const f32x4 p = *(const PG8_LAS f32x4*)(Pp + tid * 4); const float tot = (p[0] + p[1]) + (p[2] + p[3]);
            __hip_atomic_store(slots + ((size_t)(pl * 4 + u.pn) * 256 + tid), (unsigned long long)__float_as_uint(tot) | (1ull << 32), __ATOMIC_RELAXED, __HIP_MEMORY_SCOPE_AGENT); }
        asm volatile("s_waitcnt vmcnt(0)" ::: "memory"); __builtin_amdgcn_s_barrier(); asm volatile("" ::: "memory");
        if (tid == 0) { __hip_atomic_fetch_add(cnt + 64 * pl, 1u, __ATOMIC_RELAXED, __HIP_MEMORY_SCOPE_AGENT);
            unsigned sp = 0; while (__hip_atomic_load(cnt + 64 * pl, __ATOMIC_RELAXED, __HIP_MEMORY_SCOPE_AGENT) < 4u) { __builtin_amdgcn_s_sleep(1); if (++sp > (1u << 20)) break; } }
        asm volatile("s_waitcnt vmcnt(0) lgkmcnt(0)" ::: "memory"); __builtin_amdgcn_s_barrier(); asm volatile("" ::: "memory");
        if (tid < 256) { float tot = 0.f;
#pragma unroll
            for (int t = 0; t < 4; ++t) tot += __uint_as_float((unsigned)__hip_atomic_load(slots + ((size_t)(pl * 4 + t) * 256 + tid), __ATOMIC_RELAXED, __HIP_MEMORY_SCOPE_AGENT));
            Sr[tid] = 1.0f / sqrtf(tot * (1.0f / 1024.0f) + eps); }
        asm volatile("s_waitcnt vmcnt(0) lgkmcnt(0)" ::: "memory"); __builtin_amdgcn_s_barrier(); asm volatile("" ::: "memory");
        f32x4 cv[2][2], hv[2][2];
#pragma unroll
        for (int bj = 0; bj < 2; ++bj)
#pragma unroll
            for (int n = 0; n < 2; ++n) { const int c = col0 + bj * HALF + n * 16; cv[bj][n] = *(const f32x4*)(nw + c) * (1.0f + *(const f32x4*)(ms + mrow + c)); hv[bj][n] = *(const f32x4*)(msh + mrow + c); }
#pragma unroll
        for (int ai = 0; ai < 2; ++ai)
#pragma unroll
            for (int m = 0; m < 4; ++m) { const int row = ai * HALF + wr * 64 + m * 16 + fr; const size_t off = (size_t)row * 1024 + col0; const float rstd = Sr[row];
#pragma unroll
                for (int bj = 0; bj < 2; ++bj)
#pragma unroll
                    for (int n = 0; n < 2; ++n) { const f32x4 h = acc[ai][bj][m][n] * rstd * cv[bj][n] + hv[bj][n];
                        epi_u32x2 pk; pk.x = cvt_pk_bf16(h[0], h[1]); pk.y = cvt_pk_bf16(h[2], h[3]); *(epi_u32x2*)(hp + off + bj * HALF + n * 16) = pk; } }
        asm volatile("s_waitcnt lgkmcnt(0)" ::: "memory"); __builtin_amdgcn_s_barrier(); asm volatile("" ::: "memory");
    }
};
template <class Epi, class Sched, bool ALIGN_EPI = false, bool SP2 = false>
__device__ __forceinline__ void gemm_phase(PG8_LAS unsigned char* lds, const Gemm g, const Sched& S, const Epi& E) {
    int tid_o = threadIdx.x; asm volatile("" : "+v"(tid_o));
    const int tid = tid_o, wid = __builtin_amdgcn_readfirstlane(tid >> 6), lane = tid & 63, wr = wid >> 2, wc = wid & 3, fr = lane & 15, fq = lane >> 4;
    const int K = g.K, nt = K / BK;
    unsigned voffA[2], voffB[2];
#pragma unroll
    for (int i = 0; i < 2; ++i) { int R, C; stage_rc(tid * 16 + i * 8192, R, C); const int Rb = Epi::PERM ? ((R & ~31) + perm32(R & 31)) : R;
        voffA[i] = (unsigned)(R * g.ld + C) * 2u; voffB[i] = (unsigned)(Rb * g.ld + C) * 2u; }
    const size_t kstep = (size_t)(BK * 2);
    const size_t hstep = (size_t)HALF * g.ld * 2;
    const size_t tstep = 2 * hstep;
    const unsigned ldsw = (unsigned)wid * 1024u;
    const int aoff = lds_byte(wr * 64 + fr, fq * 8), boff = lds_byte(wc * 32 + fr, fq * 8);
#define PG8_SA(b, h) (((b) * 2 + (h)) * HTB)
#define PG8_SB(b, h) ((4 + (b) * 2 + (h)) * HTB)
#define PG8_STAGE(bufoff, gbase, voff) do { _Pragma("unroll") for (int _i = 0; _i < 2; ++_i) \
        __builtin_amdgcn_global_load_lds((const unsigned*)((const char*)(gbase) + (voff)[_i]), (PG8_LAS unsigned*)(lds + (bufoff) + ldsw + _i * 8192), 16, 0, 0); } while (0)
#define PG8_LDA(dst, b, h) do { _Pragma("unroll") for (int m = 0; m < 4; ++m) _Pragma("unroll") for (int k = 0; k < 2; ++k) dst[m][k] = *(const PG8_LAS bf16x8*)(lds + PG8_SA(b, h) + aoff + m * 2048 + k * 1024); } while (0)
#define PG8_LDB(dst, b, h) do { _Pragma("unroll") for (int n = 0; n < 2; ++n) _Pragma("unroll") for (int k = 0; k < 2; ++k) dst[n][k] = *(const PG8_LAS bf16x8*)(lds + PG8_SB(b, h) + boff + n * 2048 + k * 1024); } while (0)
#define PG8_MMA(ai, bj, At, Bt) do { __builtin_amdgcn_s_setprio(1); _Pragma("unroll") for (int m = 0; m < 4; ++m) _Pragma("unroll") for (int n = 0; n < 2; ++n) _Pragma("unroll") for (int k = 0; k < 2; ++k) \
        acc[ai][bj][m][n] = __builtin_amdgcn_mfma_f32_16x16x32_bf16(Bt[n][k], At[m][k], acc[ai][bj][m][n], 0, 0, 0); __builtin_amdgcn_s_setprio(0); } while (0)
#define PG8_WAIT_V(n) asm volatile("s_waitcnt vmcnt(" #n ")" ::: "memory")
#define PG8_WAIT_L(n) asm volatile("s_waitcnt lgkmcnt(" #n ")" ::: "memory")
#define PG8_BAR __builtin_amdgcn_s_barrier()
#define PG8_SCHED __builtin_amdgcn_sched_barrier(0)
    Unit cur, nxt; int ui = 0;
    if (!S.next(0, cur)) return;
    f32x4 acc[2][2][4][2];
#pragma unroll
    for (int a = 0; a < 2; ++a)
#pragma unroll
        for (int b = 0; b < 2; ++b)
#pragma unroll
            for (int m = 0; m < 4; ++m)
#pragma unroll
                for (int n = 0; n < 2; ++n) acc[a][b][m][n] = (f32x4){0.f, 0.f, 0.f, 0.f};
    bf16x8 At[4][2], B0[2][2], B1[2][2];
    const char* cA = (const char*)g.A + (size_t)cur.pm * tstep + (size_t)cur.ks * K * 2; const char* cB = (const char*)g.Bt + (size_t)cur.pn * tstep + (size_t)cur.ks * K * 2;
    S.a_ready(cur);
    if constexpr (SP2) {
        PG8_STAGE(PG8_SB(0, 0), cB, voffB); PG8_STAGE(PG8_SB(0, 1), cB + hstep, voffB); PG8_STAGE(PG8_SA(0, 0), cA, voffA); PG8_STAGE(PG8_SA(0, 1), cA + hstep, voffA);
        if (wr == 1) PG8_BAR;
        PG8_WAIT_V(2); PG8_BAR;
        PG8_STAGE(PG8_SB(1, 0), cB + kstep, voffB); PG8_STAGE(PG8_SA(1, 0), cA + kstep, voffA); PG8_STAGE(PG8_SB(1, 1), cB + hstep + kstep, voffB);
        PG8_WAIT_V(6); PG8_BAR;
    } else {
        PG8_STAGE(PG8_SB(0, 0), cB, voffB); PG8_STAGE(PG8_SA(0, 0), cA, voffA); PG8_STAGE(PG8_SB(0, 1), cB + hstep, voffB); PG8_STAGE(PG8_SA(0, 1), cA + hstep, voffA);
        if (wr == 1) PG8_BAR;
        PG8_WAIT_V(4); PG8_BAR;
        PG8_STAGE(PG8_SB(1, 0), cB + kstep, voffB); PG8_STAGE(PG8_SA(1, 0), cA + kstep, voffA); PG8_STAGE(PG8_SB(1, 1), cB + hstep + kstep, voffB);
        PG8_WAIT_V(6); PG8_BAR;
    }
    for (;;) {
        const bool has_next = S.next(ui + 1, nxt);
        const char* nA = has_next ? (const char*)g.A + (size_t)nxt.pm * tstep + (size_t)nxt.ks * K * 2 : cA; const char* nB = has_next ? (const char*)g.Bt + (size_t)nxt.pn * tstep + (size_t)nxt.ks * K * 2 : cB;
        for (int t = 0; t < nt; t += 2) {
            const bool last = (t == nt - 2);
            const char* a1 = cA + (size_t)(t + 1) * kstep;
            const char* a2 = last ? nA : cA + (size_t)(t + 2) * kstep; const char* b2 = last ? nB : cB + (size_t)(t + 2) * kstep;
            const char* a3 = a2 + kstep; const char* b3 = b2 + kstep;
            if (last && has_next) S.a_ready(nxt);
            if constexpr (SP2) {
            PG8_LDB(B0, 0, 0); PG8_LDB(B1, 0, 1); PG8_SCHED; PG8_LDA(At, 0, 0); PG8_STAGE(PG8_SA(1, 1), a1 + hstep, voffA);
            PG8_WAIT_V(8); PG8_WAIT_L(0); PG8_BAR; PG8_MMA(0, 0, At, B0); PG8_MMA(0, 1, At, B1); PG8_BAR; PG8_SCHED;
            PG8_LDA(At, 0, 1); PG8_STAGE(PG8_SB(0, 0), b2, voffB); PG8_STAGE(PG8_SB(0, 1), b2 + hstep, voffB); PG8_STAGE(PG8_SA(0, 0), a2, voffA);
            PG8_WAIT_V(8); PG8_WAIT_L(0); PG8_BAR; PG8_MMA(1, 0, At, B0); PG8_MMA(1, 1, At, B1); PG8_BAR; PG8_SCHED;
            PG8_LDB(B0, 1, 0); PG8_LDB(B1, 1, 1); PG8_SCHED; PG8_LDA(At, 1, 0); PG8_STAGE(PG8_SA(0, 1), a2 + hstep, voffA);
            PG8_WAIT_V(8); PG8_WAIT_L(0); PG8_BAR; PG8_MMA(0, 0, At, B0); PG8_MMA(0, 1, At, B1); PG8_BAR; PG8_SCHED;
            PG8_LDA(At, 1, 1); PG8_STAGE(PG8_SB(1, 0), b3, voffB); PG8_STAGE(PG8_SB(1, 1), b3 + hstep, voffB); PG8_STAGE(PG8_SA(1, 0), a3, voffA);
            PG8_WAIT_V(8); PG8_WAIT_L(0); PG8_BAR; PG8_MMA(1, 0, At, B0); PG8_MMA(1, 1, At, B1); PG8_BAR; PG8_SCHED;
            } else {
            PG8_LDB(B0, 0, 0); PG8_SCHED; PG8_LDA(At, 0, 0); PG8_STAGE(PG8_SA(1, 1), a1 + hstep, voffA);
            PG8_WAIT_L(8); PG8_BAR; PG8_WAIT_L(0); PG8_MMA(0, 0, At, B0); PG8_BAR; PG8_SCHED;
            PG8_LDB(B1, 0, 1); PG8_STAGE(PG8_SB(0, 0), b2, voffB);
            PG8_BAR; PG8_WAIT_L(0); PG8_MMA(0, 1, At, B1); PG8_BAR;
            PG8_LDA(At, 0, 1); PG8_STAGE(PG8_SA(0, 0), a2, voffA);
            PG8_BAR; PG8_WAIT_L(0); PG8_MMA(1, 0, At, B0); PG8_BAR; PG8_SCHED;
            PG8_STAGE(PG8_SB(0, 1), b2 + hstep, voffB);
            PG8_WAIT_V(6); PG8_BAR; PG8_MMA(1, 1, At, B1); PG8_BAR;
            PG8_LDB(B0, 1, 0); PG8_SCHED; PG8_LDA(At, 1, 0); PG8_STAGE(PG8_SA(0, 1), a2 + hstep, voffA);
            PG8_WAIT_L(8); PG8_BAR; PG8_WAIT_L(0); PG8_MMA(0, 0, At, B0); PG8_BAR; PG8_SCHED;
            PG8_LDB(B1, 1, 1); PG8_STAGE(PG8_SB(1, 0), b3, voffB);
            PG8_BAR; PG8_WAIT_L(0); PG8_MMA(0, 1, At, B1); PG8_BAR;
            PG8_LDA(At, 1, 1); PG8_STAGE(PG8_SA(1, 0), a3, voffA);
            PG8_BAR; PG8_WAIT_L(0); PG8_MMA(1, 0, At, B0); PG8_BAR; PG8_SCHED;
            PG8_STAGE(PG8_SB(1, 1), b3 + hstep, voffB);
            PG8_WAIT_V(6); PG8_BAR; PG8_MMA(1, 1, At, B1); PG8_BAR;
            }
        }
        if constexpr (ALIGN_EPI) { if (wr == 0) PG8_BAR; }
        if constexpr (!Epi::AFTER_DRAIN) { E(acc, cur, wr, wc, fr, fq); S.done(cur); }
        if (!has_next) break;
#pragma unroll
        for (int a = 0; a < 2; ++a)
#pragma unroll
            for (int b = 0; b < 2; ++b)
#pragma unroll
                for (int m = 0; m < 4; ++m)
#pragma unroll
                    for (int n = 0; n < 2; ++n) acc[a][b][m][n] = (f32x4){0.f, 0.f, 0.f, 0.f};
        cur = nxt; cA = nA; cB = nB; ++ui;
        if constexpr (ALIGN_EPI) { if (wr == 1) PG8_BAR; }
    }
    PG8_WAIT_V(0);
    if constexpr (!ALIGN_EPI) { if (wr == 0) PG8_BAR; }
    PG8_BAR;
    if constexpr (Epi::AFTER_DRAIN) { E.fused(acc, cur, wr, wc, fr, fq, lds, wid, lane); S.done(cur); }
#undef PG8_SA
#undef PG8_SB
#undef PG8_STAGE
#undef PG8_LDA
#undef PG8_LDB
#undef PG8_MMA
#undef PG8_WAIT_V
#undef PG8_WAIT_L
#undef PG8_BAR
#undef PG8_SCHED
}
}

#define LAS __attribute__((address_space(3)))
typedef unsigned short bf16;
typedef float f32x4 __attribute__((ext_vector_type(4)));
typedef short bf16x8 __attribute__((ext_vector_type(8)));
typedef unsigned u32x4 __attribute__((ext_vector_type(4)));
typedef unsigned u32x2 __attribute__((ext_vector_type(2)));
typedef float f32x2 __attribute__((ext_vector_type(2)));

constexpr int DM = 1024, NB = 8, SEQ = 2048, CTXL = 256;
constexpr int ML = NB * SEQ, MC = NB * CTXL, MT = ML + MC;
constexpr int INW = 2304, DFF = 4096;
constexpr int ZP = 0, ZQ = 256, ZK = 768, ZV = 896, ZHQ = 1024, ZFF = 1280, ZFB = 1536, ZHI = 1792, ZHG = 2048;
constexpr int NTHREADS = 512;
constexpr int LDS_BYTES = 147456;
constexpr float EPSN = 1e-6f;

constexpr size_t MiB = 1u << 20;
constexpr size_t WS_WT = 0;
constexpr size_t WT_LAYER = 22 * MiB + MiB / 2, WT_IN = 0, WT_OUT = 4 * MiB + MiB / 2, WT_W1 = 6 * MiB + MiB / 2, WT_W2 = 14 * MiB + MiB / 2;
constexpr size_t WS_XC = 45 * MiB;
constexpr size_t WS_ACT = 53 * MiB;
constexpr size_t WS_Z = 89 * MiB;
constexpr size_t WS_S = 170 * MiB;
constexpr size_t WS_HH = 89 * MiB;
constexpr size_t WS_MOD = 233 * MiB;
constexpr size_t WS_ROPE = WS_MOD + 512 * 1024;
constexpr size_t WS_LB = WS_ROPE + 16 * 1024;
constexpr size_t WS_DEC = WS_LB + 16 * 1024;
constexpr size_t WS_CTL = 234 * MiB + 512 * 1024;
constexpr size_t CTL_BYTES = 90112;
constexpr size_t WS_PWT = 234 * MiB + 768 * 1024;
constexpr size_t WS_P1 = 0, WS_P2 = 235 * MiB, WS_P3 = 243 * MiB;
constexpr size_t WS_FSLOT = 251 * MiB;
constexpr size_t WS_END = 254 * MiB;
static_assert(WS_DEC + 2304 * 64 * 4 <= WS_CTL && WS_CTL + CTL_BYTES <= WS_PWT && WS_PWT + 65536 <= WS_P2, "ws map");

struct Params {
    const float *x, *c, *ctx, *c_ctx, *w_ada, *b_ada, *norm1_w, *w_in, *pool_w, *pool_scale, *attn_sink, *hg_lower, *hg_norm_w, *w_out, *norm2_w, *w_mlp1, *w_mlp2, *final_norm_w;
    float* out; unsigned char* ws; int ph_lo, ph_hi;
};

__device__ __forceinline__ int otid() { int t = threadIdx.x; asm volatile("" : "+v"(t)); return t; }
__device__ __forceinline__ float bf2f(unsigned u) { return __uint_as_float(u << 16); }
__device__ __forceinline__ unsigned f2bf(float f) { unsigned u = __float_as_uint(f); return (u + 0x7fffu + ((u >> 16) & 1u)) >> 16; }
__device__ __forceinline__ unsigned pk2(float lo, float hi) { return pg8::cvt_pk_bf16(lo, hi); }
__device__ __forceinline__ float xmax16(float v) { const u32x2 r = __builtin_amdgcn_permlane16_swap(__float_as_uint(v), __float_as_uint(v), false, false); return fmaxf(__uint_as_float(r.x), __uint_as_float(r.y)); }
__device__ __forceinline__ float xmax32(float v) { const u32x2 r = __builtin_amdgcn_permlane32_swap(__float_as_uint(v), __float_as_uint(v), false, false); return fmaxf(__uint_as_float(r.x), __uint_as_float(r.y)); }
__device__ __forceinline__ float xsum16(float v) { const u32x2 r = __builtin_amdgcn_permlane16_swap(__float_as_uint(v), __float_as_uint(v), false, false); return __uint_as_float(r.x) + __uint_as_float(r.y); }
__device__ __forceinline__ float xsum32(float v) { const u32x2 r = __builtin_amdgcn_permlane32_swap(__float_as_uint(v), __float_as_uint(v), false, false); return __uint_as_float(r.x) + __uint_as_float(r.y); }
#define DPP_F(v, ctrl) __uint_as_float((unsigned)__builtin_amdgcn_update_dpp(0, (int)__float_as_uint(v), (ctrl), 0xF, 0xF, false))
__device__ __forceinline__ float wave_sum(float v) {
    v += DPP_F(v, 0xB1);
    v += DPP_F(v, 0x4E);
    v += DPP_F(v, 0x141);
    v += DPP_F(v, 0x140);
    return xsum32(xsum16(v));
}
__device__ __forceinline__ float rcpf_(float x) { return __builtin_amdgcn_rcpf(x); }
__device__ __forceinline__ float siluf(float x) { return x * rcpf_(1.f + __expf(-x)); }
__device__ __forceinline__ float bfe(const u32x4& v, int j) { const unsigned w = v[j >> 1]; return (j & 1) ? __uint_as_float(w & 0xffff0000u) : __uint_as_float(w << 16); }

__device__ __forceinline__ f32x4 mma16(const LAS bf16* A, int lda, const LAS bf16* Bt, int ldb, int K, f32x4 acc, int lane) {
    const int r = lane & 15, q = lane >> 4;
    for (int k0 = 0; k0 < K; k0 += 32) {
        const bf16x8 a = *(const LAS bf16x8*)(A + r * lda + k0 + q * 8);
        const bf16x8 b = *(const LAS bf16x8*)(Bt + r * ldb + k0 + q * 8);
        acc = __builtin_amdgcn_mfma_f32_16x16x32_bf16(a, b, acc, 0, 0, 0);
    }
    return acc;
}

__device__ __forceinline__ void transpose_item(const float* W, int K, int N, bf16* WT, LAS float* scr, int item, int lane) {
    const int nblk = N / 32, kb = item / nblk, nb = item % nblk, k0 = 64 * kb, n0 = 32 * nb;
    float tv[32];
#pragma unroll
    for (int i = 0; i < 32; ++i) tv[i] = __builtin_nontemporal_load(W + (size_t)(k0 + 2 * i + (lane >> 5)) * N + n0 + (lane & 31));
#pragma unroll
    for (int i = 0; i < 32; ++i) scr[(2 * i + (lane >> 5)) * 33 + (lane & 31)] = tv[i];
    asm volatile("s_waitcnt lgkmcnt(0)" ::: "memory");
    const int c = lane & 7;
#pragma unroll
    for (int j = 0; j < 4; ++j) { const int n = (lane >> 3) + 8 * j; const LAS float* s = scr + (8 * c) * 33 + n;
        u32x4 o; o.x = pk2(s[0 * 33], s[1 * 33]); o.y = pk2(s[2 * 33], s[3 * 33]); o.z = pk2(s[4 * 33], s[5 * 33]); o.w = pk2(s[6 * 33], s[7 * 33]);
        *(u32x4*)(WT + (size_t)(n0 + n) * K + k0 + 8 * c) = o; }
    asm volatile("s_waitcnt lgkmcnt(0)" ::: "memory");
}

__device__ __forceinline__ void convert_weights(const Params& P, LAS unsigned char* lds, int l, int gw, int NGW, int wave, int lane, int item_lo, int item_hi) {
    LAS float* scr = (LAS float*)(lds + wave * 8448);
    constexpr int I_IN = 16 * 72, I_OUT = 16 * 32, I_1 = 16 * 128, I_2 = 64 * 32, I_L = I_IN + I_OUT + I_1 + I_2;
    unsigned char* wt = P.ws + WS_WT + (size_t)l * WT_LAYER;
    for (int it = item_lo + gw; it < item_hi; it += NGW) {
        int r = it;
        if (r < I_IN) { transpose_item(P.w_in + (size_t)l * DM * INW, DM, INW, (bf16*)(wt + WT_IN), scr, r, lane); continue; } r -= I_IN;
        if (r < I_OUT) { transpose_item(P.w_out + (size_t)l * DM * DM, DM, DM, (bf16*)(wt + WT_OUT), scr, r, lane); continue; } r -= I_OUT;
        if (r < I_1) { transpose_item(P.w_mlp1 + (size_t)l * DM * DFF, DM, DFF, (bf16*)(wt + WT_W1), scr, r, lane); continue; } r -= I_1;
        transpose_item(P.w_mlp2 + (size_t)l * DFF * DM, DFF, DM, (bf16*)(wt + WT_W2), scr, r, lane);
    }
}

__device__ __forceinline__ void ph_prologue(const Params& P, LAS unsigned char* lds) {
    const int tid = otid(), lane = tid & 63, wave = __builtin_amdgcn_readfirstlane(tid >> 6);
    unsigned char* ws = P.ws;
    {
        const int gt = blockIdx.x * NTHREADS + tid, nt = gridDim.x * NTHREADS;
        float2* rope = (float2*)(ws + WS_ROPE);
        for (int i = gt; i < 64 * 16; i += nt) { const int p = i >> 4, f = i & 15;
            const float inv = exp2f(-(float)f * (13.287712379549449f / 16.0f));
            const float a = (float)p * inv; rope[i] = make_float2(__cosf(a), __sinf(a)); }
        bf16* PWT = (bf16*)(ws + WS_PWT);
        for (int i = gt; i < 2 * 4 * 64 * 64; i += nt) { const int lg = i >> 12, d = (i >> 6) & 63, c = i & 63; PWT[i] = (bf16)f2bf(P.pool_w[(size_t)(lg * 64 + c) * 64 + d]); }
        float* LB = (float*)(ws + WS_LB);
        for (int i = gt; i < 512; i += nt) { const float h0 = P.hg_lower[i], h1 = P.hg_lower[512 + i];
            LB[i] = 0.f; LB[512 + i] = 1.f / (1.f + __expf(h0 - h1)); }
    }
    if (blockIdx.x < 192) {
        LAS float* sc = (LAS float*)lds;
        LAS float* red = (LAS float*)(lds + 36864);
        for (int i = tid; i < 9 * 1024; i += NTHREADS) { const int r = i >> 10, k = i & 1023; const float v = r < 8 ? P.c[r * 1024 + k] : P.c_ctx[k]; sc[i] = siluf(v); }
        __syncthreads();
        float* MOD = (float*)(ws + WS_MOD);
        for (int u = blockIdx.x; u < 192; u += gridDim.x) {
            const int l = u / 96, n0 = (u % 96) * 64;
            const float* W = P.w_ada + (size_t)l * 1024 * 6144 + n0 + lane;
            float acc[9];
#pragma unroll
            for (int r = 0; r < 9; ++r) acc[r] = 0.f;
#pragma unroll 1
            for (int kb = 128 * wave; kb < 128 * wave + 128; kb += 32) { float wv[32];
#pragma unroll
                for (int i = 0; i < 32; ++i) wv[i] = __builtin_nontemporal_load(W + (size_t)(kb + i) * 6144);
#pragma unroll
                for (int i = 0; i < 32; ++i) {
#pragma unroll
                    for (int r = 0; r < 9; ++r) acc[r] += sc[r * 1024 + kb + i] * wv[i]; } }
#pragma unroll
            for (int r = 0; r < 9; ++r) red[(wave * 9 + r) * 64 + lane] = acc[r];
            __syncthreads();
            for (int i = tid; i < 576; i += NTHREADS) { const int r = i >> 6, cc = i & 63; float s = P.b_ada[l * 6144 + n0 + cc];
#pragma unroll
                for (int w = 0; w < 8; ++w) s += red[(w * 9 + r) * 64 + cc];
                MOD[(size_t)(l * 9 + r) * 6144 + n0 + cc] = s; }
            __syncthreads();
        }
    }
    __syncthreads();
    convert_weights(P, lds, 0, blockIdx.x * 8 + wave, gridDim.x * 8, wave, lane, 0, 1152);
}

__device__ __forceinline__ void ph_norm_mod(const float* xlat, const float* xctx, int nrows, const float* w, const float* modl, int sh_off, int s_off, bf16* out, const float* p1 = nullptr, const float* p2 = nullptr, const float* p3 = nullptr, int row0 = 0) {
    const int tid = otid(), lane = tid & 63, gw = blockIdx.x * 8 + (tid >> 6), NGW = gridDim.x * 8;
    const int per = (nrows - row0 + NGW - 1) / NGW, start = row0 + gw * per, end = min(start + per, nrows);
    int cur = -1; f32x4 cv[4], hv[4];
#pragma unroll
    for (int j = 0; j < 4; ++j) { cv[j] = (f32x4){0.f, 0.f, 0.f, 0.f}; hv[j] = cv[j]; }
    for (int r0 = start; r0 < end; r0 += 3) {
        f32x4 v[3][4];
#pragma unroll
        for (int u = 0; u < 3; ++u) { const int row = r0 + u;
            if (row < end) { const float* xr = row < ML ? xlat + (size_t)row * DM : xctx + (size_t)(row - ML) * DM;
#pragma unroll
                for (int j = 0; j < 4; ++j) { v[u][j] = __builtin_nontemporal_load((const f32x4*)(xr + 4 * lane + 256 * j));
                    if (p1 && row >= ML) { const size_t po = (size_t)(row - ML) * DM + 4 * lane + 256 * j; v[u][j] = v[u][j] + (*(const f32x4*)(p1 + po) + *(const f32x4*)(p2 + po) + *(const f32x4*)(p3 + po)); } } }
            else {
#pragma unroll
                for (int j = 0; j < 4; ++j) v[u][j] = (f32x4){0.f, 0.f, 0.f, 0.f}; } }
#pragma unroll
        for (int u = 0; u < 3; ++u) { const int row = r0 + u;
            if (row < end) {
                float ss = 0.f;
#pragma unroll
                for (int j = 0; j < 4; ++j) ss += (v[u][j].x * v[u][j].x + v[u][j].y * v[u][j].y) + (v[u][j].z * v[u][j].z + v[u][j].w * v[u][j].w);
                const float rstd = rsqrtf(wave_sum(ss) * (1.f / DM) + EPSN);
                const int mr = row < ML ? (row >> 11) : 8;
                if (mr != cur) { cur = mr; const float* md = modl + (size_t)mr * 6144;
#pragma unroll
                    for (int j = 0; j < 4; ++j) { const int col = 4 * lane + 256 * j; cv[j] = *(const f32x4*)(w + col) * (1.f + *(const f32x4*)(md + s_off + col)); hv[j] = *(const f32x4*)(md + sh_off + col); } }
#pragma unroll
                for (int j = 0; j < 4; ++j) { const int col = 4 * lane + 256 * j; const f32x4 o = v[u][j] * rstd * cv[j] + hv[j];
                    u32x2 pk; pk.x = pk2(o.x, o.y); pk.y = pk2(o.z, o.w); *(u32x2*)(out + (size_t)row * DM + col) = pk; } } }
    }
}
__device__ __forceinline__ void ph_final_norm(const float* x, const float* w, float* out) {
    const int tid = otid(), lane = tid & 63, gw = blockIdx.x * 8 + (tid >> 6), NGW = gridDim.x * 8;
    const int per = (ML + NGW - 1) / NGW, start = gw * per, end = min(start + per, ML);
    f32x4 wv[4];
#pragma unroll
    for (int j = 0; j < 4; ++j) wv[j] = *(const f32x4*)(w + 4 * lane + 256 * j);
    for (int r0 = start; r0 < end; r0 += 4) {
        f32x4 v[4][4];
#pragma unroll
        for (int u = 0; u < 4; ++u) { const int row = min(r0 + u, end - 1);
#pragma unroll
            for (int j = 0; j < 4; ++j) v[u][j] = *(const f32x4*)(x + (size_t)row * DM + 4 * lane + 256 * j); }
#pragma unroll
        for (int u = 0; u < 4; ++u) { const int row = r0 + u;
            if (row < end) { float ss = 0.f;
#pragma unroll
                for (int j = 0; j < 4; ++j) ss += (v[u][j].x * v[u][j].x + v[u][j].y * v[u][j].y) + (v[u][j].z * v[u][j].z + v[u][j].w * v[u][j].w);
                const float rstd = rsqrtf(wave_sum(ss) * (1.f / DM) + EPSN);
#pragma unroll
                for (int j = 0; j < 4; ++j) *(f32x4*)(out + (size_t)row * DM + 4 * lane + 256 * j) = v[u][j] * rstd * wv[j]; } }
    }
}

__device__ __forceinline__ void pool_unit(LAS unsigned char* lds, const bf16* Z, bf16* Y, const bf16* PWT_l, const float* pool_scale_l, int T) {
    const int tid = otid(), lane = tid & 63, wave = __builtin_amdgcn_readfirstlane(tid >> 6), r = lane & 15, quad = lane >> 4;
    LAS float* Pf = (LAS float*)lds;
    LAS bf16* Dt = (LAS bf16*)lds;
    LAS bf16* Wt = (LAS bf16*)(lds + 81920);
    int t0, n, rowbase;
    if (T < 256) { rowbase = (T >> 5) * SEQ; t0 = (T & 31) * 64; n = SEQ; } else { const int Tc = T - 256; rowbase = ML + (Tc >> 2) * CTXL; t0 = (Tc & 3) * 64; n = CTXL; }
#pragma unroll
    for (int i = 0; i < 5; ++i) { const int idx = tid + NTHREADS * i, rr = idx >> 5, c8 = idx & 31, t = t0 - 8 + rr;
        u32x4 v = {0u, 0u, 0u, 0u};
        if (t >= 0 && t < n) v = *(const u32x4*)(Z + (size_t)(rowbase + t) * INW + ZP + c8 * 8);
        f32x4 lo4 = {bfe(v, 0), bfe(v, 1), bfe(v, 2), bfe(v, 3)}, hi4 = {bfe(v, 4), bfe(v, 5), bfe(v, 6), bfe(v, 7)};
        *(LAS f32x4*)(Pf + rr * 256 + c8 * 8) = lo4; *(LAS f32x4*)(Pf + rr * 256 + c8 * 8 + 4) = hi4; }
#pragma unroll
    for (int i = 0; i < 4; ++i) { const int idx = tid + NTHREADS * i, row = idx >> 3, ch8 = idx & 7;
        *(LAS u32x4*)(Wt + row * 72 + ch8 * 8) = *(const u32x4*)(PWT_l + row * 64 + ch8 * 8); }
    __syncthreads();
    const int c = tid & 255, hf = tid >> 8, half = 1 << (c >> 6);
    float dv[32];
    {
        const int rb = 32 * hf + 8;
        float sacc = 0.f;
        for (int j = -half; j < half; ++j) sacc += Pf[(rb + j) * 256 + c];
#pragma unroll
        for (int i = 0; i < 32; ++i) { const int t = t0 + 32 * hf + i; const int lo = max(t - half, 0), hi = min(t + half, n);
            dv[i] = sacc * rcpf_((float)(hi - lo)) - Pf[(rb + i) * 256 + c];
            if (i < 31) sacc += Pf[(rb + i + half) * 256 + c] - Pf[(rb + i - half) * 256 + c]; }
    }
    __syncthreads();
#pragma unroll
    for (int i = 0; i < 32; ++i) Dt[(32 * hf + i) * 264 + c] = (bf16)f2bf(dv[i]);
    __syncthreads();
#pragma unroll
    for (int e = 0; e < 8; ++e) { const int tt = wave * 8 + e, g = tt >> 4, d0 = ((tt >> 2) & 3) * 16, tau0 = (tt & 3) * 16;
        f32x4 acc = {0.f, 0.f, 0.f, 0.f};
        acc = mma16(Wt + (g * 64 + d0) * 72, 72, Dt + tau0 * 264 + g * 64, 264, 64, acc, lane);
        const f32x4 sc = *(const f32x4*)(pool_scale_l + 64 * g + d0 + quad * 4);
        u32x2 pk; pk.x = pk2(acc[0] * sc[0], acc[1] * sc[1]); pk.y = pk2(acc[2] * sc[2], acc[3] * sc[3]);
        *(u32x2*)(Y + (size_t)(rowbase + t0 + tau0 + r) * DM + 64 * g + d0 + quad * 4) = pk; }
    __syncthreads();
}

__device__ __forceinline__ bf16x8 rope8(const u32x4& own, const u32x4& par, const LAS f32x2* cs, bool first, float scale) {
    bf16x8 o;
    float t[8];
#pragma unroll
    for (int j = 0; j < 8; ++j) { const float a = bfe(own, j), b = bfe(par, j); const f32x2 c = cs[j];
        t[j] = (first ? a * c.x - b * c.y : a * c.x + b * c.y) * scale; }
    u32x4 w; w.x = pk2(t[0], t[1]); w.y = pk2(t[2], t[3]); w.z = pk2(t[4], t[5]); w.w = pk2(t[6], t[7]);
    return __builtin_bit_cast(bf16x8, w);
}
__device__ __forceinline__ bf16x8 scale8(const u32x4& own, float scale) {
    float t[8];
#pragma unroll
    for (int j = 0; j < 8; ++j) t[j] = bfe(own, j) * scale;
    u32x4 w; w.x = pk2(t[0], t[1]); w.y = pk2(t[2], t[3]); w.z = pk2(t[4], t[5]); w.w = pk2(t[6], t[7]);
    return __builtin_bit_cast(bf16x8, w);
}

__device__ __forceinline__ void attn_unit(LAS unsigned char* lds, const bf16* Z, bf16* Y, const float* sink_l, const float2* rope, int unit) {
    const int tid = otid(), lane = tid & 63, wave = __builtin_amdgcn_readfirstlane(tid >> 6), r = lane & 15, quad = lane >> 4;
    LAS bf16* Ks = (LAS bf16*)lds;
    LAS bf16* Vt = (LAS bf16*)(lds + 36864);
    const bool lat = unit < 512;
    int b, kh, qrow0, qpos0, ntiles, tlo;
    if (lat) { b = unit >> 6; const int n = (unit & 63) >> 1; kh = unit & 1; qpos0 = 64 * n; qrow0 = b * SEQ + qpos0; tlo = n == 0 ? 2 : (n == 1 ? 1 : 0); const int thi = n == 31 ? 3 : (n == 30 ? 4 : 5); ntiles = 4 + thi - tlo; }
    else { const int cu = unit - 512; b = cu >> 3; const int qb4 = (cu & 7) >> 1; kh = cu & 1; qpos0 = 0; qrow0 = ML + b * CTXL + 64 * qb4; tlo = 0; ntiles = 4; }
    const int hh = wave >> 1, qhead = kh * 4 + hh, qw0 = (wave & 1) * 32;
    LAS f32x2* ropeL = (LAS f32x2*)(lds + 73728);
    ropeL[tid] = ((const f32x2*)rope)[tid]; ropeL[tid + NTHREADS] = ((const f32x2*)rope)[tid + NTHREADS];
    __syncthreads();
    const float QSC = 0.125f * 1.4426950408889634f;
    bf16x8 qf[2][2];
#pragma unroll
    for (int qb = 0; qb < 2; ++qb)
#pragma unroll
        for (int ks = 0; ks < 2; ++ks) {
            const int qi = qw0 + qb * 16 + r;
            const bf16* ptr = Z + (size_t)(qrow0 + qi) * INW + ZQ + qhead * 64 + ks * 32;
            const u32x4 own = *(const u32x4*)(ptr + quad * 8);
            if (lat) { const u32x4 par = *(const u32x4*)(ptr + (quad ^ 2) * 8); const int pos = qpos0 + qi; const int p = ks == 0 ? (pos >> 6) : (pos & 63);
                qf[qb][ks] = rope8(own, par, ropeL + p * 16 + (quad & 1) * 8, quad < 2, QSC); }
            else qf[qb][ks] = scale8(own, QSC);
        }
    const float sk = sink_l[qhead] * 1.4426950408889634f;
    float mrun[2], lrun[2]; f32x4 o[2][4];
#pragma unroll
    for (int qb = 0; qb < 2; ++qb) { mrun[qb] = sk; lrun[qb] = quad == 0 ? 1.f : 0.f;
#pragma unroll
        for (int db = 0; db < 4; ++db) o[qb][db] = (f32x4){0.f, 0.f, 0.f, 0.f}; }
    const int skey = tid >> 3, c8 = tid & 7;
    u32x4 kown, kpar, vv;
    auto tile_rows = [&](int idx, int& rowbase, int& kpos0) { if (idx < 4) { rowbase = ML + b * CTXL + 64 * idx; kpos0 = -100000; } else { kpos0 = qpos0 - 128 + 64 * (tlo + idx - 4); rowbase = b * SEQ + kpos0; } };
    auto prefetch = [&](int idx) { int rowbase, kpos0; tile_rows(idx, rowbase, kpos0);
        const bf16* zr = Z + (size_t)(rowbase + skey) * INW;
        kown = *(const u32x4*)(zr + ZK + kh * 64 + c8 * 8); kpar = *(const u32x4*)(zr + ZK + kh * 64 + (c8 ^ 2) * 8); vv = *(const u32x4*)(zr + ZV + kh * 64 + c8 * 8); };
    auto stage_store = [&](int idx, int buf) {
        int rowbase, kpos0; tile_rows(idx, rowbase, kpos0);
        LAS bf16* Kb = Ks + buf * 9216; LAS bf16* Vb = Vt + buf * 9216;
        bf16x8 kk;
        if (kpos0 >= 0) { const int pos = kpos0 + skey; const int p = (c8 < 4) ? (pos >> 6) : (pos & 63);
            kk = rope8(kown, kpar, ropeL + p * 16 + (c8 & 1) * 8, (c8 & 3) < 2, 1.0f); }
        else kk = __builtin_bit_cast(bf16x8, kown);
        *(LAS bf16x8*)(Kb + skey * 72 + c8 * 8) = kk;
#pragma unroll
        for (int j = 0; j < 8; ++j) Vb[(c8 * 8 + j) * 72 + skey] = (bf16)((vv[j >> 1] >> ((j & 1) * 16)) & 0xffffu);
    };
    prefetch(0);
    __syncthreads();
    stage_store(0, 0);
    if (ntiles > 1) prefetch(1);
    __syncthreads();
    for (int it = 0; it < ntiles; ++it) {
        int rowbase, kpos0; tile_rows(it, rowbase, kpos0);
        const LAS bf16* Kc = Ks + (it & 1) * 9216; const LAS bf16* Vc = Vt + (it & 1) * 9216;
        bf16x8 kf[4][2], vf[4][2];
#pragma unroll
        for (int kb = 0; kb < 4; ++kb)
#pragma unroll
            for (int ks = 0; ks < 2; ++ks) kf[kb][ks] = *(const LAS bf16x8*)(Kc + (kb * 16 + r) * 72 + ks * 32 + quad * 8);
#pragma unroll
        for (int db = 0; db < 4; ++db)
#pragma unroll
            for (int k2 = 0; k2 < 2; ++k2) { const u32x2 a = *(const LAS u32x2*)(Vc + (db * 16 + r) * 72 + 32 * k2 + 4 * quad), c = *(const LAS u32x2*)(Vc + (db * 16 + r) * 72 + 32 * k2 + 16 + 4 * quad);
                u32x4 w; w.x = a.x; w.y = a.y; w.z = c.x; w.w = c.y; vf[db][k2] = __builtin_bit_cast(bf16x8, w); }
#pragma unroll
        for (int qb = 0; qb < 2; ++qb) {
            f32x4 st[4];
#pragma unroll
            for (int kb = 0; kb < 4; ++kb) { st[kb] = (f32x4){0.f, 0.f, 0.f, 0.f};
#pragma unroll
                for (int ks = 0; ks < 2; ++ks) st[kb] = __builtin_amdgcn_mfma_f32_16x16x32_bf16(kf[kb][ks], qf[qb][ks], st[kb], 0, 0, 0); }
            if (kpos0 >= 0) { const int qpos = qpos0 + qw0 + qb * 16 + r;
#pragma unroll
                for (int kb = 0; kb < 4; ++kb)
#pragma unroll
                    for (int j = 0; j < 4; ++j) { const int dd = qpos - (kpos0 + kb * 16 + quad * 4 + j); if (dd > 128 || dd < -128) st[kb][j] = -1e30f; } }
            float mx = -3e38f;
#pragma unroll
            for (int kb = 0; kb < 4; ++kb)
#pragma unroll
                for (int j = 0; j < 4; ++j) mx = fmaxf(mx, st[kb][j]);
            mx = xmax32(xmax16(mx));
            const float mnew = fmaxf(mrun[qb], mx), alpha = __builtin_amdgcn_exp2f(mrun[qb] - mnew); mrun[qb] = mnew;
            float ps = 0.f;
#pragma unroll
            for (int kb = 0; kb < 4; ++kb)
#pragma unroll
                for (int j = 0; j < 4; ++j) { const float pv = __builtin_amdgcn_exp2f(st[kb][j] - mnew); ps += pv; st[kb][j] = pv; }
            lrun[qb] = lrun[qb] * alpha + ps;
#pragma unroll
            for (int db = 0; db < 4; ++db) o[qb][db] = o[qb][db] * alpha;
#pragma unroll
            for (int k2 = 0; k2 < 2; ++k2) { u32x4 w; w.x = pk2(st[2 * k2][0], st[2 * k2][1]); w.y = pk2(st[2 * k2][2], st[2 * k2][3]); w.z = pk2(st[2 * k2 + 1][0], st[2 * k2 + 1][1]); w.w = pk2(st[2 * k2 + 1][2], st[2 * k2 + 1][3]);
                const bf16x8 pb = __builtin_bit_cast(bf16x8, w);
#pragma unroll
                for (int db = 0; db < 4; ++db) o[qb][db] = __builtin_amdgcn_mfma_f32_16x16x32_bf16(vf[db][k2], pb, o[qb][db], 0, 0, 0); }
        }
        if (it + 1 < ntiles) { stage_store(it + 1, (it + 1) & 1); if (it + 2 < ntiles) prefetch(it + 2); }
        __syncthreads();
    }
#pragma unroll
    for (int qb = 0; qb < 2; ++qb) { float lt = xsum32(xsum16(lrun[qb])); const float inv = rcpf_(lt);
        bf16* yr = Y + (size_t)(qrow0 + qw0 + qb * 16 + r) * DM + 256 + qhead * 64 + quad * 4;
#pragma unroll
        for (int db = 0; db < 4; ++db) { u32x2 pk; pk.x = pk2(o[qb][db][0] * inv, o[qb][db][1] * inv); pk.y = pk2(o[qb][db][2] * inv, o[qb][db][3] * inv); *(u32x2*)(yr + db * 16) = pk; } }
    __syncthreads();
}

__device__ __forceinline__ int hg_row(int b, int step, int dir, int tau) {
    if (dir == 0) return step < 4 ? ML + b * CTXL + 64 * step + tau : b * SEQ + 64 * (step - 4) + tau;
    return step < 4 ? ML + b * CTXL + 64 * (3 - step) + 63 - tau : b * SEQ + 64 * (35 - step) + 63 - tau;
}
__device__ __forceinline__ void hg_stage(LAS bf16* dst, const bf16* Z, int b, int step, int dir, int col0, int tid) {
    const int tau = tid >> 3, c8 = tid & 7;
    *(LAS u32x4*)(dst + tau * 72 + c8 * 8) = *(const u32x4*)(Z + (size_t)hg_row(b, step, dir, tau) * INW + col0 + c8 * 8);
}
__device__ __forceinline__ float hg_gates(const LAS bf16* RAWF, LAS float* TOT, float lb, float (&kk)[8], float (&bb)[8], int lane, int wave, float (&cend)[3], int rs = 72) {
    float run = 0.f;
#pragma unroll
    for (int i = 0; i < 8; ++i) { const float fp = bf2f(RAWF[(8 * wave + i) * rs + lane]);
        const float e = __expf(fp);
        const float om = (1.f - lb) * rcpf_(1.f + e);
        kk[i] = om; run += __logf(1.f - om); bb[i] = run; }
    TOT[wave * 64 + lane] = run;
    __syncthreads();
    float pre = 0.f, tot = 0.f;
#pragma unroll
    for (int s = 0; s < 8; ++s) { const float t = TOT[s * 64 + lane]; tot += t; if (s < wave) pre += t; if (s == 1) cend[0] = tot; if (s == 3) cend[1] = tot; if (s == 5) cend[2] = tot; }
#pragma unroll
    for (int i = 0; i < 8; ++i) bb[i] += pre;
    return tot;
}

struct HuPre { u32x4 f, v; bool valid; };
__device__ __forceinline__ HuPre hu_load(const bf16* Z, int u, int tid) {
    const int chain = u / 36, step = u % 36, b = chain >> 3, h = (chain >> 1) & 3, dir = chain & 1;
    const int tau = tid >> 3, c8 = tid & 7;
    const bf16* zr = Z + (size_t)hg_row(b, step, dir, tau) * INW + h * 64 + c8 * 8;
    HuPre p; p.f = *(const u32x4*)(zr + (dir ? ZFB : ZFF)); p.v = *(const u32x4*)(zr + ZHI); p.valid = true; return p;
}
__device__ __forceinline__ void hgU_unit(LAS unsigned char* lds, const bf16* Z, const float* LBl, float* Sbuf, float* DEC, int u, HuPre& pre, int u_next) {
    const int tid = otid(), lane = tid & 63, wave = __builtin_amdgcn_readfirstlane(tid >> 6), r = lane & 15, quad = lane >> 4;
    LAS bf16* KH = (LAS bf16*)lds;
    LAS bf16* VT = (LAS bf16*)(lds + 9216);
    LAS float* TOT = (LAS float*)(lds + 18432);
    LAS bf16* RAWF = (LAS bf16*)(lds + 20480);
    LAS bf16* RAWV = (LAS bf16*)(lds + 29696);
    const int chain = u / 36, step = u % 36, b = chain >> 3, h = (chain >> 1) & 3, dir = chain & 1;
    const float lb = LBl[dir * 256 + h * 64 + lane];
    if (!pre.valid) pre = hu_load(Z, u, tid);
    { const int tau = tid >> 3, c8 = tid & 7; *(LAS u32x4*)(RAWF + tau * 72 + c8 * 8) = pre.f; *(LAS u32x4*)(RAWV + tau * 72 + c8 * 8) = pre.v; }
    __syncthreads();
    if (u_next >= 0) pre = hu_load(Z, u_next, tid); else pre.valid = false;
    float kk[8], bb[8];
    float cend_[3];
    const float bend = hg_gates(RAWF, TOT, lb, kk, bb, lane, wave, cend_);
    float kh[8];
    u32x4 x;
#pragma unroll
    for (int i = 0; i < 8; ++i) kh[i] = kk[i] * __expf(bend - bb[i]);
#pragma unroll
    for (int i = 0; i < 4; ++i) x[i] = (unsigned)RAWV[(8 * wave + 2 * i) * 72 + lane] | ((unsigned)RAWV[(8 * wave + 2 * i + 1) * 72 + lane] << 16);
    { u32x4 w; w.x = pk2(kh[0], kh[1]); w.y = pk2(kh[2], kh[3]); w.z = pk2(kh[4], kh[5]); w.w = pk2(kh[6], kh[7]); *(LAS u32x4*)(KH + lane * 72 + 8 * wave) = w;
      *(LAS u32x4*)(VT + lane * 72 + 8 * wave) = x; }
    if (wave == 0) DEC[(size_t)u * 64 + lane] = __expf(bend);
    __syncthreads();
#pragma unroll
    for (int e = 0; e < 2; ++e) { const int tt = 2 * wave + e, v0 = (tt >> 2) * 16, k0 = (tt & 3) * 16;
        f32x4 acc = {0.f, 0.f, 0.f, 0.f};
        acc = mma16(VT + v0 * 72, 72, KH + k0 * 72, 72, 64, acc, lane);
#pragma unroll
        for (int j = 0; j < 4; ++j) Sbuf[(size_t)u * 4096 + (v0 + quad * 4 + j) * 64 + k0 + r] = acc[j]; }
    __syncthreads();
}

__device__ __forceinline__ void hg_chain(LAS unsigned char* lds, const bf16* Z, const float* LBl, float* Sbuf, int chain) {
    const int tid = otid(), lane = tid & 63, wave = __builtin_amdgcn_readfirstlane(tid >> 6), r = lane & 15, quad = lane >> 4;
    LAS bf16* KH = (LAS bf16*)lds;
    LAS bf16* VT = (LAS bf16*)(lds + 9216);
    LAS float* TOT = (LAS float*)(lds + 18432);
    LAS bf16* RAWF = (LAS bf16*)(lds + 20480);
    LAS bf16* RAWV = (LAS bf16*)(lds + 29696);
    LAS float* DECL = (LAS float*)(lds + 57344);
    const int h = (chain >> 1) & 3, dir = chain & 1;
    const float lb = LBl[dir * 256 + h * 64 + lane];
    f32x4 st[2];
    st[0] = (f32x4){0.f, 0.f, 0.f, 0.f}; st[1] = st[0];
    HuPre pre = hu_load(Z, chain * 36, tid);
    __syncthreads();
    { const int tau = tid >> 3, c8 = tid & 7; *(LAS u32x4*)(RAWF + tau * 72 + c8 * 8) = pre.f; *(LAS u32x4*)(RAWV + tau * 72 + c8 * 8) = pre.v; }
    pre = hu_load(Z, chain * 36 + 1, tid);
    __syncthreads();
#pragma unroll 1
    for (int step = 0; step < 36; ++step) {
        const int u = chain * 36 + step;
        LAS bf16* RF = RAWF + (step & 1) * 9216;
        LAS bf16* RV = RAWV + (step & 1) * 9216;
        float kk[8], bb[8], cend_[3];
        const float bend = hg_gates(RF, TOT, lb, kk, bb, lane, wave, cend_);
        float kh[8]; u32x4 x;
#pragma unroll
        for (int i = 0; i < 8; ++i) kh[i] = kk[i] * __expf(bend - bb[i]);
#pragma unroll
        for (int i = 0; i < 4; ++i) x[i] = (unsigned)RV[(8 * wave + 2 * i) * 72 + lane] | ((unsigned)RV[(8 * wave + 2 * i + 1) * 72 + lane] << 16);
        { u32x4 w; w.x = pk2(kh[0], kh[1]); w.y = pk2(kh[2], kh[3]); w.z = pk2(kh[4], kh[5]); w.w = pk2(kh[6], kh[7]); *(LAS u32x4*)(KH + lane * 72 + 8 * wave) = w;
          *(LAS u32x4*)(VT + lane * 72 + 8 * wave) = x; }
        if (wave == 0) DECL[lane] = __expf(bend);
        if (step + 1 < 36) { const int tau = tid >> 3, c8 = tid & 7; LAS bf16* NF = RAWF + ((step + 1) & 1) * 9216; LAS bf16* NV = RAWV + ((step + 1) & 1) * 9216;
            *(LAS u32x4*)(NF + tau * 72 + c8 * 8) = pre.f; *(LAS u32x4*)(NV + tau * 72 + c8 * 8) = pre.v;
            if (step + 2 < 36) pre = hu_load(Z, u + 2, tid); }
        __syncthreads();
#pragma unroll
        for (int e = 0; e < 2; ++e) { const int tt = 2 * wave + e, v0 = (tt >> 2) * 16, k0 = (tt & 3) * 16;
            f32x4 acc = {0.f, 0.f, 0.f, 0.f};
            acc = mma16(VT + v0 * 72, 72, KH + k0 * 72, 72, 64, acc, lane);
            const float dk = DECL[k0 + r];
#pragma unroll
            for (int j = 0; j < 4; ++j) { Sbuf[(size_t)u * 4096 + (v0 + quad * 4 + j) * 64 + k0 + r] = st[e][j]; st[e][j] = dk * st[e][j] + acc[j]; } }
    }
    __syncthreads();
}

__device__ __forceinline__ void ph_hg_scan(float* __restrict__ Sbuf, const float* __restrict__ DEC) {
    const int gt = blockIdx.x * NTHREADS + otid(), nt = gridDim.x * NTHREADS;
    for (int i = gt; i < 64 * 4096; i += nt) { const int chain = i >> 12, e = i & 4095, k = e & 63;
        float* __restrict__ sp = Sbuf + (size_t)chain * 36 * 4096 + e; const float* __restrict__ dp = DEC + (size_t)chain * 36 * 64 + k;
        float s = 0.f;
#pragma unroll 1
        for (int s0 = 0; s0 < 36; s0 += 12) {
            float uu[12], dd[12];
#pragma unroll
            for (int j = 0; j < 12; ++j) { uu[j] = sp[(size_t)(s0 + j) * 4096]; dd[j] = dp[(s0 + j) * 64]; }
#pragma unroll
            for (int j = 0; j < 12; ++j) { sp[(size_t)(s0 + j) * 4096] = s; s = dd[j] * s + uu[j]; }
        } }
}

constexpr int HO_RAWQ = 0, HO_RAWF = 9216, HO_RAWV = 18432, HO_QE = 27648, HO_KT = 36864, HO_KD = 46080, HO_VT = 55296, HO_ST = 64512, HO_AM = 73728, HO_QOFF = 82944, HO_OB = 96768, HO_TOT = 114176, HO_BEND = 116224, HO_ST1 = 117248;
struct HoPre { u32x4 q, f, v; f32x4 s0, s1; };
__device__ __forceinline__ void ho_decode(int it, int l, int& b, int& cstep, int& h) {
    if (l == 0) { b = it / 144; cstep = (it % 144) >> 2; h = it & 3; } else { b = it >> 7; cstep = 4 + ((it & 127) >> 2); h = it & 3; }
}
__device__ __forceinline__ HoPre ho_load(const bf16* Z, const float* Sbuf, int b, int cstep, int h, int dir, int tid) {
    const int step = dir == 0 ? cstep : (cstep < 4 ? 3 - cstep : 39 - cstep);
    const int uidx = ((b * 4 + h) * 2 + dir) * 36 + step;
    const int tau = tid >> 3, c8 = tid & 7;
    const bf16* zr = Z + (size_t)hg_row(b, step, dir, tau) * INW + h * 64 + c8 * 8;
    HoPre p; p.q = *(const u32x4*)(zr + ZHQ); p.f = *(const u32x4*)(zr + (dir ? ZFB : ZFF)); p.v = *(const u32x4*)(zr + ZHI);
    const float* sp = Sbuf + (size_t)uidx * 4096 + tau * 64 + c8 * 8; p.s0 = *(const f32x4*)sp; p.s1 = *(const f32x4*)(sp + 4);
    return p;
}
constexpr int H2_RAW = 0  , H2_QE = 49152, H2_KT = 58368, H2_KD = 67584, H2_VT = 76800, H2_ST = 86016  ,
              H2_AM = 104448, H2_QOFF = 113664, H2_OB = 127488, H2_TOT = 144896;
static_assert(H2_TOT + 2048 <= LDS_BYTES - 256, "hgO LDS map");
__device__ __forceinline__ HoPre ho_load_k(const bf16* Z, const float* Sbuf, int l, int it0, int G, int k, int tid) {
    int b, cstep, h; ho_decode(it0 + (k >> 1) * G, l, b, cstep, h);
    return ho_load(Z, Sbuf, b, cstep, h, k & 1, tid);
}
__device__ __forceinline__ void ho_stage(LAS unsigned char* lds, const HoPre& pre, int set, int dirbuf, int tid) {
    const int tau = tid >> 3, c8 = tid & 7;
    LAS bf16* R = (LAS bf16*)(lds + H2_RAW + set * 24576);
    *(LAS u32x4*)(R + tau * 64 + c8 * 8) = pre.q; *(LAS u32x4*)(R + 4096 + tau * 64 + c8 * 8) = pre.f; *(LAS u32x4*)(R + 8192 + tau * 64 + c8 * 8) = pre.v;
    u32x4 w; w.x = pk2(pre.s0.x, pre.s0.y); w.y = pk2(pre.s0.z, pre.s0.w); w.z = pk2(pre.s1.x, pre.s1.y); w.w = pk2(pre.s1.z, pre.s1.w);
    *(LAS u32x4*)((LAS bf16*)(lds + H2_ST + dirbuf * 9216) + tau * 72 + c8 * 8) = w;
}
__device__ __forceinline__ void ph_hgO(LAS unsigned char* lds, const bf16* Z, bf16* Y, const float* LBl, const float* Sbuf, const float* hg_norm_w_l, int l, int n_u) {
    const int it0 = blockIdx.x, G = (int)gridDim.x; if (it0 >= n_u) return;
    const int nk = 2 * ((n_u - it0 + G - 1) / G);
    const int tid = otid(), lane = tid & 63, wave = __builtin_amdgcn_readfirstlane(tid >> 6), r = lane & 15, quad = lane >> 4;
    LAS bf16* QE = (LAS bf16*)(lds + H2_QE); LAS bf16* KT = (LAS bf16*)(lds + H2_KT); LAS bf16* KD = (LAS bf16*)(lds + H2_KD); LAS bf16* VT = (LAS bf16*)(lds + H2_VT);
    LAS bf16* AM = (LAS bf16*)(lds + H2_AM); LAS bf16* QOFF = (LAS bf16*)(lds + H2_QOFF);
    LAS float* OB = (LAS float*)(lds + H2_OB);
    LAS float* TOT = (LAS float*)(lds + H2_TOT);
    HoPre pre = ho_load_k(Z, Sbuf, l, it0, G, 0, tid);
    ho_stage(lds, pre, 0, 0, tid);
    if (nk > 1) pre = ho_load_k(Z, Sbuf, l, it0, G, 1, tid);
    __syncthreads();
#pragma unroll 1
    for (int k = 0; k < nk; ++k) {
        const int dir = k & 1;
        int b, cstep, h; ho_decode(it0 + (k >> 1) * G, l, b, cstep, h);
        const float lb = LBl[dir * 256 + h * 64 + lane];
        const LAS bf16* RAWQ = (const LAS bf16*)(lds + H2_RAW + dir * 24576); const LAS bf16* RAWF = RAWQ + 4096; const LAS bf16* RAWV = RAWQ + 8192;
        const LAS bf16* ST = (const LAS bf16*)(lds + H2_ST + dir * 9216);
        float kk[8], bb[8], cend[3];
        const float btot = hg_gates(RAWF, TOT, lb, kk, bb, lane, wave, cend, 64);
        { u32x4 x;
#pragma unroll
          for (int i = 0; i < 4; ++i) x[i] = (unsigned)RAWV[(8 * wave + 2 * i) * 64 + lane] | ((unsigned)RAWV[(8 * wave + 2 * i + 1) * 64 + lane] << 16);
          *(LAS u32x4*)(VT + lane * 72 + 8 * wave) = x; }
        { const int jj = wave >> 1;
          const float b0 = cend[0], b1 = cend[1], b2 = cend[2];
          const float be = jj == 0 ? b0 : (jj == 1 ? b1 : (jj == 2 ? b2 : btot));
          const float bs = jj == 0 ? 0.f : (jj == 1 ? b0 : (jj == 2 ? b1 : b2));
          const float Es = __expf(bs);
          const float H0 = jj >= 2 ? __expf(bs - b0) : 1.f, H1 = jj >= 3 ? __expf(bs - b1) : 1.f;
#pragma unroll
          for (int i2 = 0; i2 < 4; ++i2) { const int tau = 8 * wave + 2 * i2;
              const float ba = bb[2 * i2], bb_ = bb[2 * i2 + 1], ka = kk[2 * i2], kb_ = kk[2 * i2 + 1];
              const float qa = siluf(bf2f(RAWQ[tau * 64 + lane])) * __expf(ba - bs), qb_ = siluf(bf2f(RAWQ[(tau + 1) * 64 + lane])) * __expf(bb_ - bs);
              unsigned w;
              w = pk2(qa * Es, qb_ * Es); QE[tau * 72 + lane] = (bf16)(w & 0xffffu); QE[(tau + 1) * 72 + lane] = (bf16)(w >> 16);
              w = pk2(ka * __expf(be - ba), kb_ * __expf(be - bb_)); KT[tau * 72 + lane] = (bf16)(w & 0xffffu); KT[(tau + 1) * 72 + lane] = (bf16)(w >> 16);
              w = pk2(ka * __expf(fminf(bs - ba, 80.f)), kb_ * __expf(fminf(bs - bb_, 80.f))); KD[tau * 72 + lane] = (bf16)(w & 0xffffu); KD[(tau + 1) * 72 + lane] = (bf16)(w >> 16);
              if (jj >= 1) { w = pk2(qa * H0, qb_ * H0); QOFF[(tau - 16) * 72 + lane] = (bf16)(w & 0xffffu); QOFF[(tau - 15) * 72 + lane] = (bf16)(w >> 16); }
              if (jj >= 2) { w = pk2(qa * H1, qb_ * H1); QOFF[(48 + tau - 32) * 72 + lane] = (bf16)(w & 0xffffu); QOFF[(48 + tau - 31) * 72 + lane] = (bf16)(w >> 16); }
              if (jj >= 3) { w = pk2(qa, qb_); QOFF[(80 + tau - 48) * 72 + lane] = (bf16)(w & 0xffffu); QOFF[(80 + tau - 47) * 72 + lane] = (bf16)(w >> 16); } } }
        if (k + 1 < nk) { ho_stage(lds, pre, 1 - dir, 1 - dir, tid); if (k + 2 < nk) pre = ho_load_k(Z, Sbuf, l, it0, G, k + 2, tid); }
        __syncthreads();
#pragma unroll
        for (int ee = 0; ee < 2; ++ee) { const int bi = 2 * wave + ee, i = bi >> 2, j = bi & 3;
            if (j <= i) {
                const LAS bf16* qa = (j < i) ? QOFF + ((j == 0 ? 0 : (j == 1 ? 48 : 80)) + 16 * (i - j - 1)) * 72
                                             : (i == 0 ? QE : QOFF + (i == 1 ? 0 : (i == 2 ? 48 : 80)) * 72);
                const LAS bf16* ka = (j < i) ? KT + 16 * j * 72 : KD + 16 * i * 72;
                f32x4 acc = {0.f, 0.f, 0.f, 0.f};
                acc = mma16(qa, 72, ka, 72, 64, acc, lane);
#pragma unroll
                for (int jj = 0; jj < 4; ++jj) { const float v = (j < i || r <= quad * 4 + jj) ? acc[jj] : 0.f; AM[(16 * i + quad * 4 + jj) * 72 + 16 * j + r] = (bf16)f2bf(v); } }
            else {
#pragma unroll
                for (int jj = 0; jj < 4; ++jj) AM[(16 * i + quad * 4 + jj) * 72 + 16 * j + r] = (bf16)0; } }
        __syncthreads();
#pragma unroll
        for (int e = 0; e < 2; ++e) { const int tt = 2 * wave + e, tau0 = (tt >> 2) * 16, v0 = (tt & 3) * 16;
            f32x4 acc = {0.f, 0.f, 0.f, 0.f};
            acc = mma16(AM + tau0 * 72, 72, VT + v0 * 72, 72, tau0 < 32 ? 32 : 64, acc, lane);
            acc = mma16(QE + tau0 * 72, 72, ST + v0 * 72, 72, 64, acc, lane);
#pragma unroll
            for (int j = 0; j < 4; ++j) { const int tau = tau0 + quad * 4 + j; const int t = dir == 0 ? tau : 63 - tau;
                if (dir == 0) OB[t * 68 + v0 + r] = acc[j]; else OB[t * 68 + v0 + r] += acc[j]; } }
        if (dir == 1) {
            __syncthreads();
            const float nw = hg_norm_w_l[lane];
            const int rowbase = cstep < 4 ? ML + b * CTXL + 64 * cstep : b * SEQ + 64 * (cstep - 4);
#pragma unroll
            for (int i = 0; i < 8; ++i) { const int t = 8 * wave + i; const float v = OB[t * 68 + lane];
                const float rstd = rsqrtf(wave_sum(v * v) * (1.f / 64.f) + EPSN);
                const float gt = bf2f(Z[(size_t)(rowbase + t) * INW + ZHG + h * 64 + lane]);
                Y[(size_t)(rowbase + t) * DM + 768 + h * 64 + lane] = (bf16)f2bf(v * rstd * nw * siluf(gt)); }
        }
    }
    __syncthreads();
}

__device__ __forceinline__ void flat_barrier(unsigned* ctr, unsigned target) {
    __builtin_amdgcn_fence(__ATOMIC_RELEASE, "agent");
    asm volatile("s_waitcnt vmcnt(0)" ::: "memory");
    __syncthreads();
    if (threadIdx.x == 0) {
        __hip_atomic_fetch_add(ctr, 1u, __ATOMIC_RELEASE, __HIP_MEMORY_SCOPE_AGENT);
        while (__hip_atomic_load(ctr, __ATOMIC_ACQUIRE, __HIP_MEMORY_SCOPE_AGENT) < target) __builtin_amdgcn_s_sleep(2);
    }
    __syncthreads();
    __builtin_amdgcn_fence(__ATOMIC_ACQUIRE, "agent");
    asm volatile("s_waitcnt vmcnt(0)" ::: "memory");
}
#define XB_TMO      128
#define XB_XCNT(j)  (256  + 64 * (j))
#define XB_XSUB(j)  (1280 + 64 * (j))
#define XB_XGEN(j)  (2304 + 64 * (j))
#define XB_TOP      3328
#define XB_TOPGEN   3392
#define XCD_BAR_WORDS 3456
#define XB_SPIN_CAP (1u << 18)

__device__ __forceinline__ unsigned xb_ld(unsigned* p)              { return __hip_atomic_load(p, __ATOMIC_RELAXED, __HIP_MEMORY_SCOPE_AGENT); }
__device__ __forceinline__ unsigned xb_add(unsigned* p, unsigned v) { return __hip_atomic_fetch_add(p, v, __ATOMIC_RELAXED, __HIP_MEMORY_SCOPE_AGENT); }
__device__ __forceinline__ unsigned xb_xcc_id() { return (unsigned)__builtin_amdgcn_s_getreg((3 << 11) | 20) & 0xFu; }
#define XB_SPIN(cond, bar) do { unsigned _sp = 0; while (cond) { __builtin_amdgcn_s_sleep(1); \
    if ((++_sp & 255u) == 0u) { if (xb_ld(&(bar)[XB_TMO])) break; if (_sp > XB_SPIN_CAP) { atomicAdd(&(bar)[XB_TMO], 1u); break; } } } } while (0)

struct XcdBarrier {
    unsigned* bar; unsigned x;
    volatile LAS unsigned* st;
};

__device__ __forceinline__ XcdBarrier xcd_barrier_post(unsigned* bar, volatile LAS unsigned* st) {
    XcdBarrier b; b.bar = bar; b.x = xb_xcc_id(); b.st = st;
    if (threadIdx.x == 0) (void)xb_add(&bar[XB_XCNT(b.x)], 1u);
    return b;
}
__device__ __forceinline__ void xcd_barrier_complete(unsigned* bar, unsigned x, unsigned& nloc, unsigned& nx) {
    const unsigned G = gridDim.x * gridDim.y * gridDim.z;
    unsigned sum, cnt, mine, sp = 0u;
    for (;;) {
        sum = 0u; cnt = 0u; mine = 0u;
#pragma unroll
        for (unsigned j = 0; j < 16; ++j) { const unsigned c = xb_ld(&bar[XB_XCNT(j)]); sum += c; cnt += (c > 0u) ? 1u : 0u; mine = (j == x) ? c : mine; }
        if (sum == G) break;
        __builtin_amdgcn_s_sleep(1);
        if ((++sp & 255u) == 0u) { if (xb_ld(&bar[XB_TMO])) break; if (sp > XB_SPIN_CAP) { atomicAdd(&bar[XB_TMO], 1u); break; } }
    }
    nloc = mine > 0u ? mine : 1u; nx = cnt > 0u ? cnt : 1u;
}

__device__ __forceinline__ void xcd_barrier(const XcdBarrier& b) {
    asm volatile("s_waitcnt vmcnt(0)" ::: "memory");
    __syncthreads();
    if (threadIdx.x == 0) {
        unsigned* bar = b.bar;
        __builtin_amdgcn_s_waitcnt(0);
        unsigned nloc = b.st[0], nx = b.st[1];
        if (nloc == 0u) { xcd_barrier_complete(bar, b.x, nloc, nx); b.st[0] = nloc; b.st[1] = nx; }
        const unsigned old = xb_add(&bar[XB_XSUB(b.x)], 1u);
        const unsigned gen = old / nloc;
        if (old + 1u == (gen + 1u) * nloc) {
            __builtin_amdgcn_fence(__ATOMIC_RELEASE, "agent");
            asm volatile("s_waitcnt vmcnt(0)" ::: "memory");
            const unsigned og = xb_add(&bar[XB_TOP], 1u);
            const unsigned tg = og / nx;
            if (og + 1u == (tg + 1u) * nx) xb_add(&bar[XB_TOPGEN], 1u);
            else XB_SPIN(xb_ld(&bar[XB_TOPGEN]) == tg, bar);
            __builtin_amdgcn_fence(__ATOMIC_ACQUIRE, "agent");
            xb_add(&bar[XB_XGEN(b.x)], 1u);
            asm volatile("s_waitcnt vmcnt(0)" ::: "memory");
        } else {
            XB_SPIN(xb_ld(&bar[XB_XGEN(b.x)]) == gen, bar);
            __builtin_amdgcn_fence(__ATOMIC_ACQUIRE, "agent");
            asm volatile("s_waitcnt vmcnt(0)" ::: "memory");
        }
    }
    __syncthreads();
}

constexpr int NPHASE = 20;
#ifndef EN_MASK
#define EN_MASK 0x3ff
#endif
#define EN(k) (((EN_MASK) >> (k)) & 1)
#ifndef REP_OP0
#define REP_OP0 1
#endif
#ifndef REP_SYNC
#define REP_SYNC 0
#endif
#ifndef REP_PRO
#define REP_PRO 1
#endif
#ifndef REP_NORM
#define REP_NORM 1
#endif
#ifndef REP_MIX1
#define REP_MIX1 1
#endif
#ifndef REP_HGO
#define REP_HGO 1
#endif
#ifndef REP_GZ
#define REP_GZ 1
#endif
#ifndef REP_ATT
#define REP_ATT 1
#endif
#ifndef REP_HU
#define REP_HU 1
#endif
#ifndef REP_POOL
#define REP_POOL 1
#endif
typedef __attribute__((address_space(4))) const Params CParams;
__device__ __forceinline__ CParams* kparams() { CParams* p = (CParams*)__builtin_amdgcn_kernarg_segment_ptr(); asm volatile("" : "+s"(p)); return p; }
__device__ __forceinline__ Params ldparams(CParams* k) { Params P;
    P.x = k->x; P.c = k->c; P.ctx = k->ctx; P.c_ctx = k->c_ctx; P.w_ada = k->w_ada; P.b_ada = k->b_ada; P.norm1_w = k->norm1_w; P.w_in = k->w_in; P.pool_w = k->pool_w; P.pool_scale = k->pool_scale;
    P.attn_sink = k->attn_sink; P.hg_lower = k->hg_lower; P.hg_norm_w = k->hg_norm_w; P.w_out = k->w_out; P.norm2_w = k->norm2_w; P.w_mlp1 = k->w_mlp1; P.w_mlp2 = k->w_mlp2; P.final_norm_w = k->final_norm_w;
    P.out = k->out; P.ws = k->ws; P.ph_lo = k->ph_lo; P.ph_hi = k->ph_hi; return P; }
#define WSP(T, off) ((T*)(P.ws + (off)))
__global__ void __launch_bounds__(NTHREADS, 2) fwd_kernel(Params Parg) {
    extern __shared__ __attribute__((aligned(16))) unsigned char lds_raw[];
    LAS unsigned char* lds = (LAS unsigned char*)lds_raw;
    cg::grid_group grid = cg::this_grid();
    const int lo = Parg.ph_lo, hi = Parg.ph_hi;
    volatile LAS unsigned* bst = (volatile LAS unsigned*)(lds + LDS_BYTES - 256);
    if (threadIdx.x == 0) { bst[0] = 0u; bst[1] = 0u; }
    __syncthreads();
    const XcdBarrier xbar = xcd_barrier_post((unsigned*)(Parg.ws + WS_CTL), bst);
#define IN(k) (lo <= (k) && (k) < hi)
#define SEAM(k) do { if (IN(k) && IN((k) + 1)) { if (lo < 0) grid.sync(); else xcd_barrier(xbar); } } while (0)
    if (EN(0) && IN(0)) for (int rep = 0; rep < REP_PRO; ++rep) { const Params P = ldparams(kparams()); ph_prologue(P, lds); }
    SEAM(0);
#pragma unroll 1
    for (int l = 0; l < 2; ++l) {
        const int pb = 1 + 9 * l;
        const int mrows = l == 0 ? MT : ML;
        if (EN(1) && IN(pb + 0)) for (int rep = 0; rep < REP_NORM; ++rep) { const Params P = ldparams(kparams());
            ph_norm_mod(l == 0 ? P.x : P.out, l == 0 ? P.ctx : WSP(const float, WS_XC), MT, P.norm1_w + l * DM, WSP(const float, WS_MOD) + (size_t)l * 9 * 6144, 0, 1024, WSP(bf16, WS_ACT),
                        l == 0 ? (const float*)nullptr : WSP(const float, WS_P1), WSP(const float, WS_P2), WSP(const float, WS_P3), (l == 1 && gridDim.x == 256) ? ML : 0); }
        SEAM(pb + 0);
        if (EN(2) && IN(pb + 1)) for (int rep = 0; rep < REP_GZ; ++rep) { const Params P = ldparams(kparams());
            pg8::Gemm g{WSP(const bf16, WS_ACT), WSP(const bf16, WS_WT + (size_t)l * WT_LAYER + WT_IN), MT, INW, DM, DM}; pg8::StaticOrder S; S.init(MT, INW, gridDim.x, blockIdx.x);
            pg8::EpiBf E{WSP(bf16, WS_Z), INW, 0}; pg8::gemm_phase<pg8::EpiBf, pg8::StaticOrder, true, true>(lds, g, S, E);
            if (l == 0) {
                const int G = (int)gridDim.x, nun = (MT / 256) * (INW / 256), rem = nun % G, first = rem == 0 ? 0 : rem, nb = G - first;
                if ((int)blockIdx.x >= first) { const int t_ = otid(); const int w_ = __builtin_amdgcn_readfirstlane(t_ >> 6);
                    convert_weights(P, lds, 0, ((int)blockIdx.x - first) * 8 + w_, nb * 8, w_, t_ & 63, 1152, 5760); } } }
        SEAM(pb + 1);
        if (IN(pb + 2)) for (int rep = 0; rep < REP_MIX1; ++rep) { const Params P = ldparams(kparams());
            const bf16* Z = WSP(const bf16, WS_Z); bf16* ACT = WSP(bf16, WS_ACT);
            const int n_attn = l == 0 ? 576 : 512, n_pool = l == 0 ? 288 : 256, G = (int)gridDim.x, bx = (int)blockIdx.x;
            const int NCH = 64;
            if (G >= 2 * NCH) {
                if (bx < NCH) { if (EN(4)) hg_chain(lds, Z, WSP(const float, WS_LB) + l * 512, WSP(float, WS_S), bx); }
                else for (int it = bx - NCH; it < n_attn; it += G - NCH) { if (EN(3)) attn_unit(lds, Z, ACT, P.attn_sink + l * 8, WSP(const float2, WS_ROPE), it); }
            } else {
                for (int c = bx; c < NCH; c += G) hg_chain(lds, Z, WSP(const float, WS_LB) + l * 512, WSP(float, WS_S), c);
                for (int it = bx; it < n_attn; it += G) attn_unit(lds, Z, ACT, P.attn_sink + l * 8, WSP(const float2, WS_ROPE), it);
            }
            __syncthreads();
            {
                int j0 = bx, jstep = G;
                if (G == 256) {
                    if (l == 1) { j0 = bx >= 192 ? bx - 192 : n_pool; jstep = 64; }
                    else { if (bx >= 192) { j0 = bx - 192; jstep = 64; if (0) {} }
                           else if (bx < 160) { j0 = 128 + bx; jstep = 1024; }
                           else { j0 = n_pool; } }
                }
                const int jlim = (G == 256 && l == 0 && bx >= 192) ? 128 : n_pool;
                if (EN(5)) for (int j = j0; j < jlim; j += jstep) pool_unit(lds, Z, ACT, WSP(const bf16, WS_PWT) + (size_t)l * 4 * 64 * 64, P.pool_scale + l * 256, j);
            }
        }
        SEAM(pb + 2);
        if (EN(7) && IN(pb + 4)) for (int rep = 0; rep < REP_HGO; ++rep) { const Params P = ldparams(kparams());
            const int n_u = l == 0 ? 8 * 36 * 4 : 8 * 32 * 4;
            ph_hgO(lds, WSP(const bf16, WS_Z), WSP(bf16, WS_ACT), WSP(const float, WS_LB) + l * 512, WSP(const float, WS_S), P.hg_norm_w + l * 64, l, n_u);
        }
        SEAM(pb + 4);
        const bool fuse_n2 = (gridDim.x == 256);
        if (EN(8) && IN(pb + 5) && fuse_n2) { const Params P = ldparams(kparams());
            { pg8::Gemm g{WSP(const bf16, WS_ACT), WSP(const bf16, WS_WT + (size_t)l * WT_LAYER + WT_OUT), ML, DM, DM, DM}; pg8::StaticOrder S; S.init(ML, DM, gridDim.x, blockIdx.x);
              const float* modl = WSP(const float, WS_MOD) + (size_t)l * 9 * 6144;
              pg8::EpiNorm2 E{l == 0 ? P.x : P.out, P.out, modl + 2048, P.norm2_w + l * DM, modl + 4096, modl + 3072, WSP(bf16, WS_ACT), WSP(unsigned long long, WS_FSLOT + (l == 0 ? 1536 : 512) * 1024), WSP(unsigned, WS_CTL) + (l == 0 ? 16384 : 8192), EPSN, 0, -1};
              pg8::gemm_phase<pg8::EpiNorm2, pg8::StaticOrder, false, true>(lds, g, S, E); }
            if (l == 0) {
                pg8::Gemm g{WSP(const bf16, WS_ACT), WSP(const bf16, WS_WT + WT_OUT), MT, DM, DM, DM}; pg8::SplitOrder S{64, 8, 4, 1, (int)gridDim.x, (int)blockIdx.x};
                const float* mod0 = WSP(const float, WS_MOD);
                pg8::EpiNorm2 E{P.ctx, WSP(float, WS_XC), mod0 + 2048, P.norm2_w, mod0 + 4096, mod0 + 3072, WSP(bf16, WS_ACT), WSP(unsigned long long, WS_FSLOT + 2048 * 1024), WSP(unsigned, WS_CTL) + 20480, EPSN, 64, 8};
                pg8::gemm_phase<pg8::EpiNorm2, pg8::SplitOrder, false, true>(lds, g, S, E);
                if ((int)blockIdx.x >= 32) { const int t_ = otid(); const int w_ = __builtin_amdgcn_readfirstlane(t_ >> 6);
                    convert_weights(P, lds, 1, ((int)blockIdx.x - 32) * 8 + w_, ((int)gridDim.x - 32) * 8, w_, t_ & 63, 0, 5760); } } }
        if (EN(8) && IN(pb + 5) && !fuse_n2) for (int rep = 0; rep < (l == 0 ? REP_OP0 : 1); ++rep) { const Params P = ldparams(kparams());
            pg8::Gemm g{WSP(const bf16, WS_ACT), WSP(const bf16, WS_WT + (size_t)l * WT_LAYER + WT_OUT), mrows, DM, DM, DM}; pg8::StaticOrder S; S.init(mrows, DM, gridDim.x, blockIdx.x);
            pg8::EpiRes E{l == 0 ? P.x : P.out, l == 0 ? P.ctx : WSP(const float, WS_XC), P.out, WSP(float, WS_XC), WSP(const float, WS_MOD) + (size_t)l * 9 * 6144 + 2048};
            pg8::gemm_phase<pg8::EpiRes, pg8::StaticOrder, true, true>(lds, g, S, E);
            if (l == 0) {
                const int G = (int)gridDim.x, nun = (MT / 256) * (DM / 256), rem = nun % G, first = rem == 0 ? 0 : rem, nb = G - first;
                if ((int)blockIdx.x >= first) { const int t_ = otid(); const int w_ = __builtin_amdgcn_readfirstlane(t_ >> 6);
                    convert_weights(P, lds, 1, ((int)blockIdx.x - first) * 8 + w_, nb * 8, w_, t_ & 63, 0, 5760); } } }
        if (!fuse_n2) SEAM(pb + 5);
        if (EN(1) && IN(pb + 6) && !fuse_n2) for (int rep = 0; rep < REP_NORM; ++rep) { const Params P = ldparams(kparams());
            ph_norm_mod(P.out, WSP(const float, WS_XC), mrows, P.norm2_w + l * DM, WSP(const float, WS_MOD) + (size_t)l * 9 * 6144, 3072, 4096, WSP(bf16, WS_ACT), nullptr, nullptr, nullptr, fuse_n2 ? ML : 0); }
        SEAM(pb + 6);
        if (EN(2) && IN(pb + 7)) for (int rep = 0; rep < REP_GZ; ++rep) { const Params P = ldparams(kparams());
            pg8::Gemm g{WSP(const bf16, WS_ACT), WSP(const bf16, WS_WT + (size_t)l * WT_LAYER + WT_W1), mrows, DFF, DM, DM}; pg8::StaticOrder S; S.init(mrows, DFF, gridDim.x, blockIdx.x);
            pg8::EpiBf E{WSP(bf16, WS_HH), DFF, 1}; pg8::gemm_phase<pg8::EpiBf, pg8::StaticOrder, true, true>(lds, g, S, E); }
        SEAM(pb + 7);
        if (EN(8) && IN(pb + 8)) { const Params P = ldparams(kparams());
            if (l == 1 && gridDim.x == 256) {
              pg8::Gemm g{WSP(const bf16, WS_HH), WSP(const bf16, WS_WT + (size_t)l * WT_LAYER + WT_W2), ML, DM, DFF, DFF}; pg8::StaticOrder S; S.init(ML, DM, gridDim.x, blockIdx.x);
              pg8::EpiFinal E{P.out, P.out, WSP(const float, WS_MOD) + (size_t)l * 9 * 6144 + 5120, P.final_norm_w, WSP(unsigned long long, WS_FSLOT), WSP(unsigned, WS_CTL) + 4096, EPSN};
              pg8::gemm_phase<pg8::EpiFinal, pg8::StaticOrder, false, true>(lds, g, S, E); }
            else
            if (l == 0 && gridDim.x == 256) {
              pg8::Gemm g{WSP(const bf16, WS_HH), WSP(const bf16, WS_WT + WT_W2), ML, DM, DFF, DFF}; pg8::StaticOrder S; S.init(ML, DM, gridDim.x, blockIdx.x);
              const float* mod0 = WSP(const float, WS_MOD); const float* mod1 = mod0 + 9 * 6144;
              pg8::EpiNorm2 E{P.out, P.out, mod0 + 5120, P.norm1_w + DM, mod1 + 1024, mod1 + 0, WSP(bf16, WS_ACT), WSP(unsigned long long, WS_FSLOT + 1024 * 1024), WSP(unsigned, WS_CTL) + 12288, EPSN, 0, -1};
              pg8::gemm_phase<pg8::EpiNorm2, pg8::StaticOrder, false, true>(lds, g, S, E); }
            else
            { pg8::Gemm g{WSP(const bf16, WS_HH), WSP(const bf16, WS_WT + (size_t)l * WT_LAYER + WT_W2), ML, DM, DFF, DFF}; pg8::StaticOrder S; S.init(ML, DM, gridDim.x, blockIdx.x);
              pg8::EpiRes E{P.out, WSP(const float, WS_XC), P.out, WSP(float, WS_XC), WSP(const float, WS_MOD) + (size_t)l * 9 * 6144 + 5120};
              pg8::gemm_phase<pg8::EpiRes, pg8::StaticOrder, true, true>(lds, g, S, E); }
            if (l == 0) {
              pg8::Gemm g{WSP(const bf16, WS_HH), WSP(const bf16, WS_WT + WT_W2), MT, DM, 1024, DFF}; pg8::SplitOrder S{64, 8, 4, 4, (int)gridDim.x, (int)blockIdx.x};
              pg8::EpiPart E{WSP(float, WS_XC), WSP(float, WS_P1), WSP(float, WS_P2), WSP(float, WS_P3), WSP(const float, WS_MOD) + 8 * 6144 + 5120};
              pg8::gemm_phase<pg8::EpiPart, pg8::SplitOrder, true, true>(lds, g, S, E); } }
        if (!(l == 1 && gridDim.x == 256)) SEAM(pb + 8);
    }
    for (int rep = 0; rep < REP_SYNC; ++rep) xcd_barrier(xbar);
    if (EN(9) && IN(19) && gridDim.x != 256) { const Params P = ldparams(kparams()); ph_final_norm(P.out, P.final_norm_w, P.out); }
#undef IN
#undef SEAM
}

#ifndef N_LAUNCH_MODE
#define N_LAUNCH_MODE 1
#endif
extern "C" void kernel_launch(void* const* d_in, const int* in_sizes, int n_in, void* d_out, int out_size, void* d_ws, size_t ws_size, hipStream_t stream) {
    static int grid = 0;
    if (grid == 0) {
        if (n_in != 18 || out_size != ML * DM || ws_size < WS_END) { fprintf(stderr, "kernel_launch: unexpected shapes (n_in %d out %d ws %zu)\n", n_in, out_size, ws_size); grid = -1; return; }
        int dev = 0, cus = 0, per_cu = 0;
        hipGetDevice(&dev); hipDeviceGetAttribute(&cus, hipDeviceAttributeMultiprocessorCount, dev);
        hipFuncSetAttribute((const void*)fwd_kernel, hipFuncAttributeMaxDynamicSharedMemorySize, LDS_BYTES);
        hipOccupancyMaxActiveBlocksPerMultiprocessor(&per_cu, (const void*)fwd_kernel, NTHREADS, LDS_BYTES);
        if (per_cu < 1) { fprintf(stderr, "kernel_launch: occupancy query returned %d\n", per_cu); per_cu = 1; }
        grid = cus * per_cu;
        fprintf(stderr, "kernel_launch: cus %d per_cu %d grid %d\n", cus, per_cu, grid);
    }
    if (grid < 0) return;
    hipMemsetAsync((unsigned char*)d_ws + WS_CTL, 0, CTL_BYTES, stream);
    Params p{};
    const float** pp = (const float**)&p;
    for (int i = 0; i < 18; ++i) pp[i] = (const float*)d_in[i];
    p.out = (float*)d_out; p.ws = (unsigned char*)d_ws;
#if N_LAUNCH_MODE == 1
    p.ph_lo = 0; p.ph_hi = NPHASE;
    void* args[] = {&p};
    hipError_t e = hipLaunchCooperativeKernel((const void*)fwd_kernel, dim3(grid), dim3(NTHREADS), args, LDS_BYTES, stream);
    if (e != hipSuccess) fprintf(stderr, "cooperative launch failed: %s (grid %d)\n", hipGetErrorString(e), grid);
#else
    for (int k = 0; k < NPHASE; ++k) { p.ph_lo = k; p.ph_hi = k + 1;
        hipLaunchKernelGGL(fwd_kernel, dim3(grid), dim3(NTHREADS), LDS_BYTES, stream, p); }
#endif
}
```

```cpp
#include <hip/hip_runtime.h>
#include <hip/hip_cooperative_groups.h>
#include <cstdio>
#include <cstdint>
namespace cg = cooperative_groups;
namespace pg8 {
#define PG8_LAS __attribute__((address_space(3)))
typedef unsigned short bf16_t;
typedef short bf16x8 __attribute__((ext_vector_type(8)));
typedef float f32x4 __attribute__((ext_vector_type(4)));
typedef unsigned u32x4 __attribute__((ext_vector_type(4)));
constexpr int BM = 256, BK = 64, HALF = 128, HTB = HALF * BK * 2  , STAGE_BYTES = 8 * HTB, NXCD = 8, WGM = 4;

__host__ __device__ __forceinline__ int lds_byte(int r, int c) { const int st = (r >> 4) * 2 + (c >> 5), rr = r & 15, cc = c & 31, ob = rr * 64 + cc * 2; return st * 1024 + (ob ^ (((ob >> 9) & 1) << 5)); }
__host__ __device__ __forceinline__ void stage_rc(int b, int& R, int& C) { const int st = b / 1024, sb = b % 1024, swz = sb ^ (((sb >> 9) & 1) << 5); R = (st >> 1) * 16 + swz / 64; C = (st & 1) * 32 + (swz % 64) / 2; }
__host__ __device__ __forceinline__ int perm32(int rho) { const int n = rho >> 4, i = rho & 15; return 8 * (i >> 2) + 4 * n + (i & 3); }

struct Unit { int pm, pn, ks; };
struct Gemm { const bf16_t* A; const bf16_t* Bt; int M, N, K, ld; };

struct StaticOrder {
    int nM, nN, nwg, G, c;
    __host__ __device__ void init(int M, int N, int G_, int c_) { nM = M / BM; nN = N / BM; nwg = nM * nN; G = G_; c = c_; }
    __host__ __device__ bool next(int i, Unit& u) const {
        const long L = (long)i * G + c; if (L >= nwg) return false;
        int wgid = (int)L; { const int q = nwg / NXCD, r = nwg % NXCD, xcd = wgid % NXCD, off = wgid / NXCD; wgid = (xcd < r ? xcd * (q + 1) : r * (q + 1) + (xcd - r) * q) + off; }
        const int nig = WGM * nN, gid = wgid / nig, fm = gid * WGM, gsz = (nM - fm) < WGM ? (nM - fm) : WGM;
        u.pm = fm + ((wgid % nig) % gsz); u.pn = (wgid % nig) / gsz; u.ks = 0; return true;
    }
    __device__ __forceinline__ void a_ready(const Unit&) const {}
    __device__ __forceinline__ void done(const Unit&) const {}
};
__device__ __forceinline__ unsigned cvt_pk_bf16(float lo, float hi) { unsigned r; asm volatile("v_cvt_pk_bf16_f32 %0, %1, %2" : "=v"(r) : "v"(lo), "v"(hi)); return r; }
typedef float f32x2 __attribute__((ext_vector_type(2)));
struct EpiBf {
    static constexpr bool PERM = true, AFTER_DRAIN = false;
    bf16_t* O; int ldc; int act;
    __device__ __forceinline__ void operator()(const f32x4 (&acc)[2][2][4][2], const Unit& u, int wr, int wc, int fr, int fq) const {
        const int row0 = u.pm * BM + wr * 64 + fr; const int col0 = u.pn * BM + wc * 32 + 8 * fq;
#pragma unroll
        for (int ai = 0; ai < 2; ++ai)
#pragma unroll
            for (int m = 0; m < 4; ++m) { bf16_t* rowp = O + (size_t)(row0 + ai * HALF + m * 16) * ldc + col0;
#pragma unroll
                for (int bj = 0; bj < 2; ++bj) { f32x4 v0 = acc[ai][bj][m][0], v1 = acc[ai][bj][m][1];
                    if (act) {
#pragma unroll
                        for (int e = 0; e < 4; ++e) { float a = fmaxf(v0[e], 0.f), b = fmaxf(v1[e], 0.f); v0[e] = a * a; v1[e] = b * b; } }
                    u32x4 w; w.x = cvt_pk_bf16(v0[0], v0[1]); w.y = cvt_pk_bf16(v0[2], v0[3]); w.z = cvt_pk_bf16(v1[0], v1[1]); w.w = cvt_pk_bf16(v1[2], v1[3]);
                    *(u32x4*)(rowp + bj * HALF) = w; } }
    }
};
struct EpiRes {
    static constexpr bool PERM = false, AFTER_DRAIN = false;
    const float* res_lat; const float* res_ctx; float* out_lat; float* out_ctx; const float* gate;
    __device__ __forceinline__ void operator()(const f32x4 (&acc)[2][2][4][2], const Unit& u, int wr, int wc, int fr, int fq) const {
        const bool lat = u.pm < 64;
        const float* res = lat ? res_lat + (size_t)u.pm * BM * 1024 : res_ctx + (size_t)(u.pm - 64) * BM * 1024;
        float* out = lat ? out_lat + (size_t)u.pm * BM * 1024 : out_ctx + (size_t)(u.pm - 64) * BM * 1024;
        const float* g = gate + (size_t)(lat ? (u.pm >> 3) : 8) * 6144;
        const int col0 = u.pn * BM + wc * 32 + 4 * fq;
        f32x4 gv[2][2];
#pragma unroll
        for (int bj = 0; bj < 2; ++bj)
#pragma unroll
            for (int n = 0; n < 2; ++n) gv[bj][n] = *(const f32x4*)(g + col0 + bj * HALF + n * 16);
#pragma unroll
        for (int ai = 0; ai < 2; ++ai)
#pragma unroll
            for (int m = 0; m < 4; ++m) { const size_t off = (size_t)(ai * HALF + wr * 64 + m * 16 + fr) * 1024 + col0;
#pragma unroll
                for (int bj = 0; bj < 2; ++bj)
#pragma unroll
                    for (int n = 0; n < 2; ++n) { const f32x4 r = *(const f32x4*)(res + off + bj * HALF + n * 16);
                        *(f32x4*)(out + off + bj * HALF + n * 16) = r + gv[bj][n] * acc[ai][bj][m][n]; } }
    }
};

struct SplitOrder {
    int pm0, npm, nN, nks, G, c;
    __device__ __forceinline__ bool next(int i, Unit& u) const { const int L = i * G + c; if (L >= npm * nN * nks) return false;
        u.ks = L % nks; const int t = L / nks; u.pn = t % nN; u.pm = pm0 + t / nN; return true; }
    __device__ __forceinline__ void a_ready(const Unit&) const {}
    __device__ __forceinline__ void done(const Unit&) const {}
};
struct EpiPart {
    static constexpr bool PERM = false, AFTER_DRAIN = false;
    float* xc; float* p1; float* p2; float* p3; const float* gate;
    __device__ __forceinline__ void operator()(const f32x4 (&acc)[2][2][4][2], const Unit& u, int wr, int wc, int fr, int fq) const {
        float* base = u.ks == 0 ? xc : (u.ks == 1 ? p1 : (u.ks == 2 ? p2 : p3));
        float* out = base + (size_t)(u.pm - 64) * BM * 1024;
        const bool inplace = u.ks == 0;
        const int col0 = u.pn * BM + wc * 32 + 4 * fq;
        f32x4 gv[2][2];
#pragma unroll
        for (int bj = 0; bj < 2; ++bj)
#pragma unroll
            for (int n = 0; n < 2; ++n) gv[bj][n] = *(const f32x4*)(gate + col0 + bj * HALF + n * 16);
#pragma unroll
        for (int ai = 0; ai < 2; ++ai)
#pragma unroll
            for (int m = 0; m < 4; ++m) { const size_t off = (size_t)(ai * HALF + wr * 64 + m * 16 + fr) * 1024 + col0;
#pragma unroll
                for (int bj = 0; bj < 2; ++bj)
#pragma unroll
                    for (int n = 0; n < 2; ++n) { f32x4 v = gv[bj][n] * acc[ai][bj][m][n]; float* p = out + off + bj * HALF + n * 16;
                        if (inplace) v = v + *(const f32x4*)p;
                        *(f32x4*)p = v; } }
    }
};

typedef unsigned epi_u32x2 __attribute__((ext_vector_type(2)));
struct EpiFinal {
    static constexpr bool PERM = false, AFTER_DRAIN = true;
    const float* res; float* out; const float* gate; const float* w; unsigned long long* slots; unsigned* cnt; float eps;
    __device__ __forceinline__ void operator()(const f32x4 (&)[2][2][4][2], const Unit&, int, int, int, int) const {}
    __device__ __forceinline__ void fused(f32x4 (&acc)[2][2][4][2], const Unit& u, int wr, int wc, int fr, int fq, PG8_LAS unsigned char* lds, int wid, int lane) const {
        const float* rs = res + (size_t)u.pm * BM * 1024; float* o = out + (size_t)u.pm * BM * 1024;
        const float* g = gate + (size_t)(u.pm >> 3) * 6144;
        const int col0 = u.pn * BM + wc * 32 + 4 * fq;
        PG8_LAS float* Pp = (PG8_LAS float*)lds;
        PG8_LAS float* Sr = (PG8_LAS float*)(lds + 4096);
        f32x4 gv[2][2];
#pragma unroll
        for (int bj = 0; bj < 2; ++bj)
#pragma unroll
            for (int n = 0; n < 2; ++n) gv[bj][n] = *(const f32x4*)(g + col0 + bj * HALF + n * 16);
#pragma unroll
        for (int ai = 0; ai < 2; ++ai)
#pragma unroll
            for (int m = 0; m < 4; ++m) { const int row = ai * HALF + wr * 64 + m * 16 + fr; const size_t off = (size_t)row * 1024 + col0; float s = 0.f;
#pragma unroll
                for (int bj = 0; bj < 2; ++bj)
#pragma unroll
                    for (int n = 0; n < 2; ++n) { const f32x4 r = __builtin_nontemporal_load((const f32x4*)(rs + off + bj * HALF + n * 16)); const f32x4 x = r + gv[bj][n] * acc[ai][bj][m][n]; acc[ai][bj][m][n] = x;
                        s += (x[0] * x[0] + x[1] * x[1]) + (x[2] * x[2] + x[3] * x[3]); }
                { const epi_u32x2 t = __builtin_amdgcn_permlane16_swap(__float_as_uint(s), __float_as_uint(s), false, false); s = __uint_as_float(t.x) + __uint_as_float(t.y); }
                { const epi_u32x2 t = __builtin_amdgcn_permlane32_swap(__float_as_uint(s), __float_as_uint(s), false, false); s = __uint_as_float(t.x) + __uint_as_float(t.y); }
                if (fq == 0) Pp[row * 4 + wc] = s; }
        asm volatile("s_waitcnt lgkmcnt(0)" ::: "memory"); __builtin_amdgcn_s_barrier(); asm volatile("" ::: "memory");
        const int tid = wid * 64 + lane;
        if (tid < 256) { const f32x4 p = *(const PG8_LAS f32x4*)(Pp + tid * 4); const float tot = (p[0] + p[1]) + (p[2] + p[3]);
            __hip_atomic_store(slots + ((size_t)(u.pm * 4 + u.pn) * 256 + tid), (unsigned long long)__float_as_uint(tot) | (1ull << 32), __ATOMIC_RELAXED, __HIP_MEMORY_SCOPE_AGENT); }
        asm volatile("s_waitcnt vmcnt(0)" ::: "memory"); __builtin_amdgcn_s_barrier(); asm volatile("" ::: "memory");
        if (tid == 0) { __hip_atomic_fetch_add(cnt + 64 * u.pm, 1u, __ATOMIC_RELAXED, __HIP_MEMORY_SCOPE_AGENT);
            unsigned sp = 0; while (__hip_atomic_load(cnt + 64 * u.pm, __ATOMIC_RELAXED, __HIP_MEMORY_SCOPE_AGENT) < 4u) { __builtin_amdgcn_s_sleep(1); if (++sp > (1u << 20)) break; } }
        asm volatile("s_waitcnt vmcnt(0) lgkmcnt(0)" ::: "memory"); __builtin_amdgcn_s_barrier(); asm volatile("" ::: "memory");
        if (tid < 256) { float tot = 0.f;
#pragma unroll
            for (int t = 0; t < 4; ++t) tot += __uint_as_float((unsigned)__hip_atomic_load(slots + ((size_t)(u.pm * 4 + t) * 256 + tid), __ATOMIC_RELAXED, __HIP_MEMORY_SCOPE_AGENT));
            Sr[tid] = 1.0f / sqrtf(tot * (1.0f / 1024.0f) + eps); }
        asm volatile("s_waitcnt vmcnt(0) lgkmcnt(0)" ::: "memory"); __builtin_amdgcn_s_barrier(); asm volatile("" ::: "memory");
        f32x4 wv[2][2];
#pragma unroll
        for (int bj = 0; bj < 2; ++bj)
#pragma unroll
            for (int n = 0; n < 2; ++n) wv[bj][n] = *(const f32x4*)(w + col0 + bj * HALF + n * 16);
#pragma unroll
        for (int ai = 0; ai < 2; ++ai)
#pragma unroll
            for (int m = 0; m < 4; ++m) { const int row = ai * HALF + wr * 64 + m * 16 + fr; const size_t off = (size_t)row * 1024 + col0; const float rstd = Sr[row];
#pragma unroll
                for (int bj = 0; bj < 2; ++bj)
#pragma unroll
                    for (int n = 0; n < 2; ++n) __builtin_nontemporal_store(acc[ai][bj][m][n] * rstd * wv[bj][n], (f32x4*)(o + off + bj * HALF + n * 16)); }
        asm volatile("s_waitcnt lgkmcnt(0)" ::: "memory"); __builtin_amdgcn_s_barrier(); asm volatile("" ::: "memory");
    }
};

struct EpiNorm2 {
    static constexpr bool PERM = false, AFTER_DRAIN = true;
    const float* res; float* out; const float* gate; const float* nw; const float* ms; const float* msh; bf16_t* hb; unsigned long long* slots; unsigned* cnt; float eps; int pm_sub; int mrow_c;
    __device__ __forceinline__ void operator()(const f32x4 (&)[2][2][4][2], const Unit&, int, int, int, int) const {}
    __device__ __forceinline__ void fused(f32x4 (&acc)[2][2][4][2], const Unit& u, int wr, int wc, int fr, int fq, PG8_LAS unsigned char* lds, int wid, int lane) const {
        const int pl = u.pm - pm_sub;
        const float* rs = res + (size_t)pl * BM * 1024; float* o = out + (size_t)pl * BM * 1024; bf16_t* hp = hb + (size_t)u.pm * BM * 1024;
        const size_t mrow = (size_t)(mrow_c >= 0 ? mrow_c : (u.pm >> 3)) * 6144;
        const int col0 = u.pn * BM + wc * 32 + 4 * fq;
        PG8_LAS float* Pp = (PG8_LAS float*)lds;
        PG8_LAS float* Sr = (PG8_LAS float*)(lds + 4096);
        f32x4 gv[2][2];
#pragma unroll
        for (int bj = 0; bj < 2; ++bj)
#pragma unroll
            for (int n = 0; n < 2; ++n) gv[bj][n] = *(const f32x4*)(gate + mrow + col0 + bj * HALF + n * 16);
#pragma unroll
        for (int ai = 0; ai < 2; ++ai)
#pragma unroll
            for (int m = 0; m < 4; ++m) { const int row = ai * HALF + wr * 64 + m * 16 + fr; const size_t off = (size_t)row * 1024 + col0; float s = 0.f;
#pragma unroll
                for (int bj = 0; bj < 2; ++bj)
#pragma unroll
                    for (int n = 0; n < 2; ++n) { const f32x4 r = __builtin_nontemporal_load((const f32x4*)(rs + off + bj * HALF + n * 16)); const f32x4 x = r + gv[bj][n] * acc[ai][bj][m][n]; acc[ai][bj][m][n] = x;
                        __builtin_nontemporal_store(x, (f32x4*)(o + off + bj * HALF + n * 16));
                        s += (x[0] * x[0] + x[1] * x[1]) + (x[2] * x[2] + x[3] * x[3]); }
                { const epi_u32x2 t = __builtin_amdgcn_permlane16_swap(__float_as_uint(s), __float_as_uint(s), false, false); s = __uint_as_float(t.x) + __uint_as_float(t.y); }
                { const epi_u32x2 t = __builtin_amdgcn_permlane32_swap(__float_as_uint(s), __float_as_uint(s), false, false); s = __uint_as_float(t.x) + __uint_as_float(t.y); }
                if (fq == 0) Pp[row * 4 + wc] = s; }
        asm volatile("s_waitcnt lgkmcnt(0)" ::: "memory"); __builtin_amdgcn_s_barrier(); asm volatile("" ::: "memory");
        const int tid = wid * 64 + lane;
        if (tid < 256) { const f32x4 p = *(const PG8_LAS f32x4*)(Pp + tid * 4); const float tot = (p[0] + p[1]) + (p[2] + p[3]);
            __hip_atomic_store(slots + ((size_t)(pl * 4 + u.pn) * 256 + tid), (unsigned long long)__float_as_uint(tot) | (1ull << 32), __ATOMIC_RELAXED, __HIP_MEMORY_SCOPE_AGENT); }
        asm volatile("s_waitcnt vmcnt(0)" ::: "memory"); __builtin_amdgcn_s_barrier(); asm volatile("" ::: "memory");
        if (tid == 0) { __hip_atomic_fetch_add(cnt + 64 * pl, 1u, __ATOMIC_RELAXED, __HIP_MEMORY_SCOPE_AGENT);
            unsigned sp = 0; while (__hip_atomic_load(cnt + 64 * pl, __ATOMIC_RELAXED, __HIP_MEMORY_SCOPE_AGENT) < 4u) { __builtin_amdgcn_s_sleep(1); if (++sp > (1u << 20)) break; } }
        asm volatile("s_waitcnt vmcnt(0) lgkmcnt(0)" ::: "memory"); __builtin_amdgcn_s_barrier(); asm volatile("" ::: "memory");
        if (tid < 256) { float tot = 0.f;
#pragma unroll
            for (int t = 0; t < 4; ++t) tot += __uint_as_float((unsigned)__hip_atomic_load(slots + ((size_t)(pl * 4 + t) * 256 + tid), __ATOMIC_RELAXED, __HIP_MEMORY_SCOPE_AGENT));
            Sr[tid] = 1.0f / sqrtf(tot * (1.0f / 1024.0f) + eps); }
        asm volatile("s_waitcnt vmcnt(0) lgkmcnt(0)" ::: "memory"); __builtin_amdgcn_s_barrier(); asm volatile("" ::: "memory");
        f32x4 cv[2][2], hv[2][2];
#pragma unroll
        for (int bj = 0; bj < 2; ++bj)
#pragma unroll
            for (int n = 0; n < 2; ++n) { const int c = col0 + bj * HALF + n * 16; cv[bj][n] = *(const f32x4*)(nw + c) * (1.0f + *(const f32x4*)(ms + mrow + c)); hv[bj][n] = *(const f32x4*)(msh + mrow + c); }
#pragma unroll
        for (int ai = 0; ai < 2; ++ai)
#pragma unroll
            for (int m = 0; m < 4; ++m) { const int row = ai * HALF + wr * 64 + m * 16 + fr; const size_t off = (size_t)row * 1024 + col0; const float rstd = Sr[row];
#pragma unroll
                for (int bj = 0; bj < 2; ++bj)
#pragma unroll
                    for (int n = 0; n < 2; ++n) { const f32x4 h = acc[ai][bj][m][n] * rstd * cv[bj][n] + hv[bj][n];
                        epi_u32x2 pk; pk.x = cvt_pk_bf16(h[0], h[1]); pk.y = cvt_pk_bf16(h[2], h[3]); *(epi_u32x2*)(hp + off + bj * HALF + n * 16) = pk; } }
        asm volatile("s_waitcnt lgkmcnt(0)" ::: "memory"); __builtin_amdgcn_s_barrier(); asm volatile("" ::: "memory");
    }
};
template <class Epi, class Sched, bool ALIGN_EPI = false, bool SP2 = false>
__device__ __forceinline__ void gemm_phase(PG8_LAS unsigned char* lds, const Gemm g, const Sched& S, const Epi& E) {
    int tid_o = threadIdx.x; asm volatile("" : "+v"(tid_o));
    const int tid = tid_o, wid = __builtin_amdgcn_readfirstlane(tid >> 6), lane = tid & 63, wr = wid >> 2, wc = wid & 3, fr = lane & 15, fq = lane >> 4;
    const int K = g.K, nt = K / BK;
    unsigned voffA[2], voffB[2];
#pragma unroll
    for (int i = 0; i < 2; ++i) { int R, C; stage_rc(tid * 16 + i * 8192, R, C); const int Rb = Epi::PERM ? ((R & ~31) + perm32(R & 31)) : R;
        voffA[i] = (unsigned)(R * g.ld + C) * 2u; voffB[i] = (unsigned)(Rb * g.ld + C) * 2u; }
    const size_t kstep = (size_t)(BK * 2);
    const size_t hstep = (size_t)HALF * g.ld * 2;
    const size_t tstep = 2 * hstep;
    const unsigned ldsw = (unsigned)wid * 1024u;
    const int aoff = lds_byte(wr * 64 + fr, fq * 8), boff = lds_byte(wc * 32 + fr, fq * 8);
#define PG8_SA(b, h) (((b) * 2 + (h)) * HTB)
#define PG8_SB(b, h) ((4 + (b) * 2 + (h)) * HTB)
#define PG8_STAGE(bufoff, gbase, voff) do { _Pragma("unroll") for (int _i = 0; _i < 2; ++_i) \
        __builtin_amdgcn_global_load_lds((const unsigned*)((const char*)(gbase) + (voff)[_i]), (PG8_LAS unsigned*)(lds + (bufoff) + ldsw + _i * 8192), 16, 0, 0); } while (0)
#define PG8_LDA(dst, b, h) do { _Pragma("unroll") for (int m = 0; m < 4; ++m) _Pragma("unroll") for (int k = 0; k < 2; ++k) dst[m][k] = *(const PG8_LAS bf16x8*)(lds + PG8_SA(b, h) + aoff + m * 2048 + k * 1024); } while (0)
#define PG8_LDB(dst, b, h) do { _Pragma("unroll") for (int n = 0; n < 2; ++n) _Pragma("unroll") for (int k = 0; k < 2; ++k) dst[n][k] = *(const PG8_LAS bf16x8*)(lds + PG8_SB(b, h) + boff + n * 2048 + k * 1024); } while (0)
#define PG8_MMA(ai, bj, At, Bt) do { __builtin_amdgcn_s_setprio(1); _Pragma("unroll") for (int m = 0; m < 4; ++m) _Pragma("unroll") for (int n = 0; n < 2; ++n) _Pragma("unroll") for (int k = 0; k < 2; ++k) \
        acc[ai][bj][m][n] = __builtin_amdgcn_mfma_f32_16x16x32_bf16(Bt[n][k], At[m][k], acc[ai][bj][m][n], 0, 0, 0); __builtin_amdgcn_s_setprio(0); } while (0)
#define PG8_WAIT_V(n) asm volatile("s_waitcnt vmcnt(" #n ")" ::: "memory")
#define PG8_WAIT_L(n) asm volatile("s_waitcnt lgkmcnt(" #n ")" ::: "memory")
#define PG8_BAR __builtin_amdgcn_s_barrier()
#define PG8_SCHED __builtin_amdgcn_sched_barrier(0)
    Unit cur, nxt; int ui = 0;
    if (!S.next(0, cur)) return;
    f32x4 acc[2][2][4][2];
#pragma unroll
    for (int a = 0; a < 2; ++a)
#pragma unroll
        for (int b = 0; b < 2; ++b)
#pragma unroll
            for (int m = 0; m < 4; ++m)
#pragma unroll
                for (int n = 0; n < 2; ++n) acc[a][b][m][n] = (f32x4){0.f, 0.f, 0.f, 0.f};
    bf16x8 At[4][2], B0[2][2], B1[2][2];
    const char* cA = (const char*)g.A + (size_t)cur.pm * tstep + (size_t)cur.ks * K * 2; const char* cB = (const char*)g.Bt + (size_t)cur.pn * tstep + (size_t)cur.ks * K * 2;
    S.a_ready(cur);
    if constexpr (SP2) {
        PG8_STAGE(PG8_SB(0, 0), cB, voffB); PG8_STAGE(PG8_SB(0, 1), cB + hstep, voffB); PG8_STAGE(PG8_SA(0, 0), cA, voffA); PG8_STAGE(PG8_SA(0, 1), cA + hstep, voffA);
        if (wr == 1) PG8_BAR;
        PG8_WAIT_V(2); PG8_BAR;
        PG8_STAGE(PG8_SB(1, 0), cB + kstep, voffB); PG8_STAGE(PG8_SA(1, 0), cA + kstep, voffA); PG8_STAGE(PG8_SB(1, 1), cB + hstep + kstep, voffB);
        PG8_WAIT_V(6); PG8_BAR;
    } else {
        PG8_STAGE(PG8_SB(0, 0), cB, voffB); PG8_STAGE(PG8_SA(0, 0), cA, voffA); PG8_STAGE(PG8_SB(0, 1), cB + hstep, voffB); PG8_STAGE(PG8_SA(0, 1), cA + hstep, voffA);
        if (wr == 1) PG8_BAR;
        PG8_WAIT_V(4); PG8_BAR;
        PG8_STAGE(PG8_SB(1, 0), cB + kstep, voffB); PG8_STAGE(PG8_SA(1, 0), cA + kstep, voffA); PG8_STAGE(PG8_SB(1, 1), cB + hstep + kstep, voffB);
        PG8_WAIT_V(6); PG8_BAR;
    }
    for (;;) {
        const bool has_next = S.next(ui + 1, nxt);
        const char* nA = has_next ? (const char*)g.A + (size_t)nxt.pm * tstep + (size_t)nxt.ks * K * 2 : cA; const char* nB = has_next ? (const char*)g.Bt + (size_t)nxt.pn * tstep + (size_t)nxt.ks * K * 2 : cB;
        for (int t = 0; t < nt; t += 2) {
            const bool last = (t == nt - 2);
            const char* a1 = cA + (size_t)(t + 1) * kstep;
            const char* a2 = last ? nA : cA + (size_t)(t + 2) * kstep; const char* b2 = last ? nB : cB + (size_t)(t + 2) * kstep;
            const char* a3 = a2 + kstep; const char* b3 = b2 + kstep;
            if (last && has_next) S.a_ready(nxt);
            if constexpr (SP2) {
            PG8_LDB(B0, 0, 0); PG8_LDB(B1, 0, 1); PG8_SCHED; PG8_LDA(At, 0, 0); PG8_STAGE(PG8_SA(1, 1), a1 + hstep, voffA);
            PG8_WAIT_V(8); PG8_WAIT_L(0); PG8_BAR; PG8_MMA(0, 0, At, B0); PG8_MMA(0, 1, At, B1); PG8_BAR; PG8_SCHED;
            PG8_LDA(At, 0, 1); PG8_STAGE(PG8_SB(0, 0), b2, voffB); PG8_STAGE(PG8_SB(0, 1), b2 + hstep, voffB); PG8_STAGE(PG8_SA(0, 0), a2, voffA);
            PG8_WAIT_V(8); PG8_WAIT_L(0); PG8_BAR; PG8_MMA(1, 0, At, B0); PG8_MMA(1, 1, At, B1); PG8_BAR; PG8_SCHED;
            PG8_LDB(B0, 1, 0); PG8_LDB(B1, 1, 1); PG8_SCHED; PG8_LDA(At, 1, 0); PG8_STAGE(PG8_SA(0, 1), a2 + hstep, voffA);
            PG8_WAIT_V(8); PG8_WAIT_L(0); PG8_BAR; PG8_MMA(0, 0, At, B0); PG8_MMA(0, 1, At, B1); PG8_BAR; PG8_SCHED;
            PG8_LDA(At, 1, 1); PG8_STAGE(PG8_SB(1, 0), b3, voffB); PG8_STAGE(PG8_SB(1, 1), b3 + hstep, voffB); PG8_STAGE(PG8_SA(1, 0), a3, voffA);
            PG8_WAIT_V(8); PG8_WAIT_L(0); PG8_BAR; PG8_MMA(1, 0, At, B0); PG8_MMA(1, 1, At, B1); PG8_BAR; PG8_SCHED;
            } else {
            PG8_LDB(B0, 0, 0); PG8_SCHED; PG8_LDA(At, 0, 0); PG8_STAGE(PG8_SA(1, 1), a1 + hstep, voffA);
            PG8_WAIT_L(8); PG8_BAR; PG8_WAIT_L(0); PG8_MMA(0, 0, At, B0); PG8_BAR; PG8_SCHED;
            PG8_LDB(B1, 0, 1); PG8_STAGE(PG8_SB(0, 0), b2, voffB);
            PG8_BAR; PG8_WAIT_L(0); PG8_MMA(0, 1, At, B1); PG8_BAR;
            PG8_LDA(At, 0, 1); PG8_STAGE(PG8_SA(0, 0), a2, voffA);
            PG8_BAR; PG8_WAIT_L(0); PG8_MMA(1, 0, At, B0); PG8_BAR; PG8_SCHED;
            PG8_STAGE(PG8_SB(0, 1), b2 + hstep, voffB);
            PG8_WAIT_V(6); PG8_BAR; PG8_MMA(1, 1, At, B1); PG8_BAR;
            PG8_LDB(B0, 1, 0); PG8_SCHED; PG8_LDA(At, 1, 0); PG8_STAGE(PG8_SA(0, 1), a2 + hstep, voffA);
            PG8_WAIT_L(8); PG8_BAR; PG8_WAIT_L(0); PG8_MMA(0, 0, At, B0); PG8_BAR; PG8_SCHED;
            PG8_LDB(B1, 1, 1); PG8_STAGE(PG8_SB(1, 0), b3, voffB);
            PG8_BAR; PG8_WAIT_L(0); PG8_MMA(0, 1, At, B1); PG8_BAR;
            PG8_LDA(At, 1, 1); PG8_STAGE(PG8_SA(1, 0), a3, voffA);
            PG8_BAR; PG8_WAIT_L(0); PG8_MMA(1, 0, At, B0); PG8_BAR; PG8_SCHED;
            PG8_STAGE(PG8_SB(1, 1), b3 + hstep, voffB);
            PG8_WAIT_V(6); PG8_BAR; PG8_MMA(1, 1, At, B1); PG8_BAR;
            }
        }
        if constexpr (ALIGN_EPI) { if (wr == 0) PG8_BAR; }
        if constexpr (!Epi::AFTER_DRAIN) { E(acc, cur, wr, wc, fr, fq); S.done(cur); }
        if (!has_next) break;
#pragma unroll
        for (int a = 0; a < 2; ++a)
#pragma unroll
            for (int b = 0; b < 2; ++b)
#pragma unroll
                for (int m = 0; m < 4; ++m)
#pragma unroll
                    for (int n = 0; n < 2; ++n) acc[a][b][m][n] = (f32x4){0.f, 0.f, 0.f, 0.f};
        cur = nxt; cA = nA; cB = nB; ++ui;
        if constexpr (ALIGN_EPI) { if (wr == 1) PG8_BAR; }
    }
    PG8_WAIT_V(0);
    if constexpr (!ALIGN_EPI) { if (wr == 0) PG8_BAR; }
    PG8_BAR;
    if constexpr (Epi::AFTER_DRAIN) { E.fused(acc, cur, wr, wc, fr, fq, lds, wid, lane); S.done(cur); }
#undef PG8_SA
#undef PG8_SB
#undef PG8_STAGE
#undef PG8_LDA
#undef PG8_LDB
#undef PG8_MMA
#undef PG8_WAIT_V
#undef PG8_WAIT_L
#undef PG8_BAR
#undef PG8_SCHED
}
}

#define LAS __attribute__((address_space(3)))
typedef unsigned short bf16;
typedef float f32x4 __attribute__((ext_vector_type(4)));
typedef short bf16x8 __attribute__((ext_vector_type(8)));
typedef unsigned u32x4 __attribute__((ext_vector_type(4)));
typedef unsigned u32x2 __attribute__((ext_vector_type(2)));
typedef float f32x2 __attribute__((ext_vector_type(2)));

constexpr int DM = 1024, NB = 8, SEQ = 2048, CTXL = 256;
constexpr int ML = NB * SEQ, MC = NB * CTXL, MT = ML + MC;
constexpr int INW = 2304, DFF = 4096;
constexpr int ZP = 0, ZQ = 256, ZK = 768, ZV = 896, ZHQ = 1024, ZFF = 1280, ZFB = 1536, ZHI = 1792, ZHG = 2048;
constexpr int NTHREADS = 512;
constexpr int LDS_BYTES = 147456;
constexpr float EPSN = 1e-6f;

constexpr size_t MiB = 1u << 20;
constexpr size_t WS_WT = 0;
constexpr size_t WT_LAYER = 22 * MiB + MiB / 2, WT_IN = 0, WT_OUT = 4 * MiB + MiB / 2, WT_W1 = 6 * MiB + MiB / 2, WT_W2 = 14 * MiB + MiB / 2;
constexpr size_t WS_XC = 45 * MiB;
constexpr size_t WS_ACT = 53 * MiB;
constexpr size_t WS_Z = 89 * MiB;
constexpr size_t WS_S = 170 * MiB;
constexpr size_t WS_HH = 89 * MiB;
constexpr size_t WS_MOD = 233 * MiB;
constexpr size_t WS_ROPE = WS_MOD + 512 * 1024;
constexpr size_t WS_LB = WS_ROPE + 16 * 1024;
constexpr size_t WS_DEC = WS_LB + 16 * 1024;
constexpr size_t WS_CTL = 234 * MiB + 512 * 1024;
constexpr size_t CTL_BYTES = 90112;
constexpr size_t WS_PWT = 234 * MiB + 768 * 1024;
constexpr size_t WS_P1 = 0, WS_P2 = 235 * MiB, WS_P3 = 243 * MiB;
constexpr size_t WS_FSLOT = 251 * MiB;
constexpr size_t WS_END = 254 * MiB;
static_assert(WS_DEC + 2304 * 64 * 4 <= WS_CTL && WS_CTL + CTL_BYTES <= WS_PWT && WS_PWT + 65536 <= WS_P2, "ws map");

struct Params {
    const float *x, *c, *ctx, *c_ctx, *w_ada, *b_ada, *norm1_w, *w_in, *pool_w, *pool_scale, *attn_sink, *hg_lower, *hg_norm_w, *w_out, *norm2_w, *w_mlp1, *w_mlp2, *final_norm_w;
    float* out; unsigned char* ws; int ph_lo, ph_hi;
};

__device__ __forceinline__ int otid() { int t = threadIdx.x; asm volatile("" : "+v"(t)); return t; }
__device__ __forceinline__ float bf2f(unsigned u) { return __uint_as_float(u << 16); }
__device__ __forceinline__ unsigned f2bf(float f) { unsigned u = __float_as_uint(f); return (u + 0x7fffu + ((u >> 16) & 1u)) >> 16; }
__device__ __forceinline__ unsigned pk2(float lo, float hi) { return pg8::cvt_pk_bf16(lo, hi); }
__device__ __forceinline__ float xmax16(float v) { const u32x2 r = __builtin_amdgcn_permlane16_swap(__float_as_uint(v), __float_as_uint(v), false, false); return fmaxf(__uint_as_float(r.x), __uint_as_float(r.y)); }
__device__ __forceinline__ float xmax32(float v) { const u32x2 r = __builtin_amdgcn_permlane32_swap(__float_as_uint(v), __float_as_uint(v), false, false); return fmaxf(__uint_as_float(r.x), __uint_as_float(r.y)); }
__device__ __forceinline__ float xsum16(float v) { const u32x2 r = __builtin_amdgcn_permlane16_swap(__float_as_uint(v), __float_as_uint(v), false, false); return __uint_as_float(r.x) + __uint_as_float(r.y); }
__device__ __forceinline__ float xsum32(float v) { const u32x2 r = __builtin_amdgcn_permlane32_swap(__float_as_uint(v), __float_as_uint(v), false, false); return __uint_as_float(r.x) + __uint_as_float(r.y); }
#define DPP_F(v, ctrl) __uint_as_float((unsigned)__builtin_amdgcn_update_dpp(0, (int)__float_as_uint(v), (ctrl), 0xF, 0xF, false))
__device__ __forceinline__ float wave_sum(float v) {
    v += DPP_F(v, 0xB1);
    v += DPP_F(v, 0x4E);
    v += DPP_F(v, 0x141);
    v += DPP_F(v, 0x140);
    return xsum32(xsum16(v));
}
__device__ __forceinline__ float rcpf_(float x) { return __builtin_amdgcn_rcpf(x); }
__device__ __forceinline__ float siluf(float x) { return x * rcpf_(1.f + __expf(-x)); }
__device__ __forceinline__ float bfe(const u32x4& v, int j) { const unsigned w = v[j >> 1]; return (j & 1) ? __uint_as_float(w & 0xffff0000u) : __uint_as_float(w << 16); }

__device__ __forceinline__ f32x4 mma16(const LAS bf16* A, int lda, const LAS bf16* Bt, int ldb, int K, f32x4 acc, int lane) {
    const int r = lane & 15, q = lane >> 4;
    for (int k0 = 0; k0 < K; k0 += 32) {
        const bf16x8 a = *(const LAS bf16x8*)(A + r * lda + k0 + q * 8);
        const bf16x8 b = *(const LAS bf16x8*)(Bt + r * ldb + k0 + q * 8);
        acc = __builtin_amdgcn_mfma_f32_16x16x32_bf16(a, b, acc, 0, 0, 0);
    }
    return acc;
}

__device__ __forceinline__ void transpose_item(const float* W, int K, int N, bf16* WT, LAS float* scr, int item, int lane) {
    const int nblk = N / 32, kb = item / nblk, nb = item % nblk, k0 = 64 * kb, n0 = 32 * nb;
    float tv[32];
#pragma unroll
    for (int i = 0; i < 32; ++i) tv[i] = __builtin_nontemporal_load(W + (size_t)(k0 + 2 * i + (lane >> 5)) * N + n0 + (lane & 31));
#pragma unroll
    for (int i = 0; i < 32; ++i) scr[(2 * i + (lane >> 5)) * 33 + (lane & 31)] = tv[i];
    asm volatile("s_waitcnt lgkmcnt(0)" ::: "memory");
    const int c = lane & 7;
#pragma unroll
    for (int j = 0; j < 4; ++j) { const int n = (lane >> 3) + 8 * j; const LAS float* s = scr + (8 * c) * 33 + n;
        u32x4 o; o.x = pk2(s[0 * 33], s[1 * 33]); o.y = pk2(s[2 * 33], s[3 * 33]); o.z = pk2(s[4 * 33], s[5 * 33]); o.w = pk2(s[6 * 33], s[7 * 33]);
        *(u32x4*)(WT + (size_t)(n0 + n) * K + k0 + 8 * c) = o; }
    asm volatile("s_waitcnt lgkmcnt(0)" ::: "memory");
}

__device__ __forceinline__ void convert_weights(const Params& P, LAS unsigned char* lds, int l, int gw, int NGW, int wave, int lane, int item_lo, int item_hi) {
    LAS float* scr = (LAS float*)(lds + wave * 8448);
    constexpr int I_IN = 16 * 72, I_OUT = 16 * 32, I_1 = 16 * 128, I_2 = 64 * 32, I_L = I_IN + I_OUT + I_1 + I_2;
    unsigned char* wt = P.ws + WS_WT + (size_t)l * WT_LAYER;
    for (int it = item_lo + gw; it < item_hi; it += NGW) {
        int r = it;
        if (r < I_IN) { transpose_item(P.w_in + (size_t)l * DM * INW, DM, INW, (bf16*)(wt + WT_IN), scr, r, lane); continue; } r -= I_IN;
        if (r < I_OUT) { transpose_item(P.w_out + (size_t)l * DM * DM, DM, DM, (bf16*)(wt + WT_OUT), scr, r, lane); continue; } r -= I_OUT;
        if (r < I_1) { transpose_item(P.w_mlp1 + (size_t)l * DM * DFF, DM, DFF, (bf16*)(wt + WT_W1), scr, r, lane); continue; } r -= I_1;
        transpose_item(P.w_mlp2 + (size_t)l * DFF * DM, DFF, DM, (bf16*)(wt + WT_W2), scr, r, lane);
    }
}

__device__ __forceinline__ void ph_prologue(const Params& P, LAS unsigned char* lds) {
    const int tid = otid(), lane = tid & 63, wave = __builtin_amdgcn_readfirstlane(tid >> 6);
    unsigned char* ws = P.ws;
    {
        const int gt = blockIdx.x * NTHREADS + tid, nt = gridDim.x * NTHREADS;
        float2* rope = (float2*)(ws + WS_ROPE);
        for (int i = gt; i < 64 * 16; i += nt) { const int p = i >> 4, f = i & 15;
            const float inv = exp2f(-(float)f * (13.287712379549449f / 16.0f));
            const float a = (float)p * inv; rope[i] = make_float2(__cosf(a), __sinf(a)); }
        bf16* PWT = (bf16*)(ws + WS_PWT);
        for (int i = gt; i < 2 * 4 * 64 * 64; i += nt) { const int lg = i >> 12, d = (i >> 6) & 63, c = i & 63; PWT[i] = (bf16)f2bf(P.pool_w[(size_t)(lg * 64 + c) * 64 + d]); }
        float* LB = (float*)(ws + WS_LB);
        for (int i = gt; i < 512; i += nt) { const float h0 = P.hg_lower[i], h1 = P.hg_lower[512 + i];
            LB[i] = 0.f; LB[512 + i] = 1.f / (1.f + __expf(h0 - h1)); }
    }
    if (blockIdx.x < 192) {
        LAS float* sc = (LAS float*)lds;
        LAS float* red = (LAS float*)(lds + 36864);
        for (int i = tid; i < 9 * 1024; i += NTHREADS) { const int r = i >> 10, k = i & 1023; const float v = r < 8 ? P.c[r * 1024 + k] : P.c_ctx[k]; sc[i] = siluf(v); }
        __syncthreads();
        float* MOD = (float*)(ws + WS_MOD);
        for (int u = blockIdx.x; u < 192; u += gridDim.x) {
            const int l = u / 96, n0 = (u % 96) * 64;
            const float* W = P.w_ada + (size_t)l * 1024 * 6144 + n0 + lane;
            float acc[9];
#pragma unroll
            for (int r = 0; r < 9; ++r) acc[r] = 0.f;
#pragma unroll 1
            for (int kb = 128 * wave; kb < 128 * wave + 128; kb += 32) { float wv[32];
#pragma unroll
                for (int i = 0; i < 32; ++i) wv[i] = __builtin_nontemporal_load(W + (size_t)(kb + i) * 6144);
#pragma unroll
                for (int i = 0; i < 32; ++i) {
#pragma unroll
                    for (int r = 0; r < 9; ++r) acc[r] += sc[r * 1024 + kb + i] * wv[i]; } }
#pragma unroll
            for (int r = 0; r < 9; ++r) red[(wave * 9 + r) * 64 + lane] = acc[r];
            __syncthreads();
            for (int i = tid; i < 576; i += NTHREADS) { const int r = i >> 6, cc = i & 63; float s = P.b_ada[l * 6144 + n0 + cc];
#pragma unroll
                for (int w = 0; w < 8; ++w) s += red[(w * 9 + r) * 64 + cc];
                MOD[(size_t)(l * 9 + r) * 6144 + n0 + cc] = s; }
            __syncthreads();
        }
    }
    __syncthreads();
    convert_weights(P, lds, 0, blockIdx.x * 8 + wave, gridDim.x * 8, wave, lane, 0, 1152);
}

__device__ __forceinline__ void ph_norm_mod(const float* xlat, const float* xctx, int nrows, const float* w, const float* modl, int sh_off, int s_off, bf16* out, const float* p1 = nullptr, const float* p2 = nullptr, const float* p3 = nullptr, int row0 = 0) {
    const int tid = otid(), lane = tid & 63, gw = blockIdx.x * 8 + (tid >> 6), NGW = gridDim.x * 8;
    const int per = (nrows - row0 + NGW - 1) / NGW, start = row0 + gw * per, end = min(start + per, nrows);
    int cur = -1; f32x4 cv[4], hv[4];
#pragma unroll
    for (int j = 0; j < 4; ++j) { cv[j] = (f32x4){0.f, 0.f, 0.f, 0.f}; hv[j] = cv[j]; }
    for (int r0 = start; r0 < end; r0 += 3) {
        f32x4 v[3][4];
#pragma unroll
        for (int u = 0; u < 3; ++u) { const int row = r0 + u;
            if (row < end) { const float* xr = row < ML ? xlat + (size_t)row * DM : xctx + (size_t)(row - ML) * DM;
#pragma unroll
                for (int j = 0; j < 4; ++j) { v[u][j] = __builtin_nontemporal_load((const f32x4*)(xr + 4 * lane + 256 * j));
                    if (p1 && row >= ML) { const size_t po = (size_t)(row - ML) * DM + 4 * lane + 256 * j; v[u][j] = v[u][j] + (*(const f32x4*)(p1 + po) + *(const f32x4*)(p2 + po) + *(const f32x4*)(p3 + po)); } } }
            else {
#pragma unroll
                for (int j = 0; j < 4; ++j) v[u][j] = (f32x4){0.f, 0.f, 0.f, 0.f}; } }
#pragma unroll
        for (int u = 0; u < 3; ++u) { const int row = r0 + u;
            if (row < end) {
                float ss = 0.f;
#pragma unroll
                for (int j = 0; j < 4; ++j) ss += (v[u][j].x * v[u][j].x + v[u][j].y * v[u][j].y) + (v[u][j].z * v[u][j].z + v[u][j].w * v[u][j].w);
                const float rstd = rsqrtf(wave_sum(ss) * (1.f / DM) + EPSN);
                const int mr = row < ML ? (row >> 11) : 8;
                if (mr != cur) { cur = mr; const float* md = modl + (size_t)mr * 6144;
#pragma unroll
                    for (int j = 0; j < 4; ++j) { const int col = 4 * lane + 256 * j; cv[j] = *(const f32x4*)(w + col) * (1.f + *(const f32x4*)(md + s_off + col)); hv[j] = *(const f32x4*)(md + sh_off + col); } }
#pragma unroll
                for (int j = 0; j < 4; ++j) { const int col = 4 * lane + 256 * j; const f32x4 o = v[u][j] * rstd * cv[j] + hv[j];
                    u32x2 pk; pk.x = pk2(o.x, o.y); pk.y = pk2(o.z, o.w); *(u32x2*)(out + (size_t)row * DM + col) = pk; } } }
    }
}
__device__ __forceinline__ void ph_final_norm(const float* x, const float* w, float* out) {
    const int tid = otid(), lane = tid & 63, gw = blockIdx.x * 8 + (tid >> 6), NGW = gridDim.x * 8;
    const int per = (ML + NGW - 1) / NGW, start = gw * per, end = min(start + per, ML);
    f32x4 wv[4];
#pragma unroll
    for (int j = 0; j < 4; ++j) wv[j] = *(const f32x4*)(w + 4 * lane + 256 * j);
    for (int r0 = start; r0 < end; r0 += 4) {
        f32x4 v[4][4];
#pragma unroll
        for (int u = 0; u < 4; ++u) { const int row = min(r0 + u, end - 1);
#pragma unroll
            for (int j = 0; j < 4; ++j) v[u][j] = *(const f32x4*)(x + (size_t)row * DM + 4 * lane + 256 * j); }
#pragma unroll
        for (int u = 0; u < 4; ++u) { const int row = r0 + u;
            if (row < end) { float ss = 0.f;
#pragma unroll
                for (int j = 0; j < 4; ++j) ss += (v[u][j].x * v[u][j].x + v[u][j].y * v[u][j].y) + (v[u][j].z * v[u][j].z + v[u][j].w * v[u][j].w);
                const float rstd = rsqrtf(wave_sum(ss) * (1.f / DM) + EPSN);
#pragma unroll
                for (int j = 0; j < 4; ++j) *(f32x4*)(out + (size_t)row * DM + 4 * lane + 256 * j) = v[u][j] * rstd * wv[j]; } }
    }
}

__device__ __forceinline__ void pool_unit(LAS unsigned char* lds, const bf16* Z, bf16* Y, const bf16* PWT_l, const float* pool_scale_l, int T) {
    const int tid = otid(), lane = tid & 63, wave = __builtin_amdgcn_readfirstlane(tid >> 6), r = lane & 15, quad = lane >> 4;
    LAS float* Pf = (LAS float*)lds;
    LAS bf16* Dt = (LAS bf16*)lds;
    LAS bf16* Wt = (LAS bf16*)(lds + 81920);
    int t0, n, rowbase;
    if (T < 256) { rowbase = (T >> 5) * SEQ; t0 = (T & 31) * 64; n = SEQ; } else { const int Tc = T - 256; rowbase = ML + (Tc >> 2) * CTXL; t0 = (Tc & 3) * 64; n = CTXL; }
#pragma unroll
    for (int i = 0; i < 5; ++i) { const int idx = tid + NTHREADS * i, rr = idx >> 5, c8 = idx & 31, t = t0 - 8 + rr;
        u32x4 v = {0u, 0u, 0u, 0u};
        if (t >= 0 && t < n) v = *(const u32x4*)(Z + (size_t)(rowbase + t) * INW + ZP + c8 * 8);
        f32x4 lo4 = {bfe(v, 0), bfe(v, 1), bfe(v, 2), bfe(v, 3)}, hi4 = {bfe(v, 4), bfe(v, 5), bfe(v, 6), bfe(v, 7)};
        *(LAS f32x4*)(Pf + rr * 256 + c8 * 8) = lo4; *(LAS f32x4*)(Pf + rr * 256 + c8 * 8 + 4) = hi4; }
#pragma unroll
    for (int i = 0; i < 4; ++i) { const int idx = tid + NTHREADS * i, row = idx >> 3, ch8 = idx & 7;
        *(LAS u32x4*)(Wt + row * 72 + ch8 * 8) = *(const u32x4*)(PWT_l + row * 64 + ch8 * 8); }
    __syncthreads();
    const int c = tid & 255, hf = tid >> 8, half = 1 << (c >> 6);
    float dv[32];
    {
        const int rb = 32 * hf + 8;
        float sacc = 0.f;
        for (int j = -half; j < half; ++j) sacc += Pf[(rb + j) * 256 + c];
#pragma unroll
        for (int i = 0; i < 32; ++i) { const int t = t0 + 32 * hf + i; const int lo = max(t - half, 0), hi = min(t + half, n);
            dv[i] = sacc * rcpf_((float)(hi - lo)) - Pf[(rb + i) * 256 + c];
            if (i < 31) sacc += Pf[(rb + i + half) * 256 + c] - Pf[(rb + i - half) * 256 + c]; }
    }
    __syncthreads();
#pragma unroll
    for (int i = 0; i < 32; ++i) Dt[(32 * hf + i) * 264 + c] = (bf16)f2bf(dv[i]);
    __syncthreads();
#pragma unroll
    for (int e = 0; e < 8; ++e) { const int tt = wave * 8 + e, g = tt >> 4, d0 = ((tt >> 2) & 3) * 16, tau0 = (tt & 3) * 16;
        f32x4 acc = {0.f, 0.f, 0.f, 0.f};
        acc = mma16(Wt + (g * 64 + d0) * 72, 72, Dt + tau0 * 264 + g * 64, 264, 64, acc, lane);
        const f32x4 sc = *(const f32x4*)(pool_scale_l + 64 * g + d0 + quad * 4);
        u32x2 pk; pk.x = pk2(acc[0] * sc[0], acc[1] * sc[1]); pk.y = pk2(acc[2] * sc[2], acc[3] * sc[3]);
        *(u32x2*)(Y + (size_t)(rowbase + t0 + tau0 + r) * DM + 64 * g + d0 + quad * 4) = pk; }
    __syncthreads();
}

__device__ __forceinline__ bf16x8 rope8(const u32x4& own, const u32x4& par, const LAS f32x2* cs, bool first, float scale) {
    bf16x8 o;
    float t[8];
#pragma unroll
    for (int j = 0; j < 8; ++j) { const float a = bfe(own, j), b = bfe(par, j); const f32x2 c = cs[j];
        t[j] = (first ? a * c.x - b * c.y : a * c.x + b * c.y) * scale; }
    u32x4 w; w.x = pk2(t[0], t[1]); w.y = pk2(t[2], t[3]); w.z = pk2(t[4], t[5]); w.w = pk2(t[6], t[7]);
    return __builtin_bit_cast(bf16x8, w);
}
__device__ __forceinline__ bf16x8 scale8(const u32x4& own, float scale) {
    float t[8];
#pragma unroll
    for (int j = 0; j < 8; ++j) t[j] = bfe(own, j) * scale;
    u32x4 w; w.x = pk2(t[0], t[1]); w.y = pk2(t[2], t[3]); w.z = pk2(t[4], t[5]); w.w = pk2(t[6], t[7]);
    return __builtin_bit_cast(bf16x8, w);
}

__device__ __forceinline__ void attn_unit(LAS unsigned char* lds, const bf16* Z, bf16* Y, const float* sink_l, const float2* rope, int unit) {
    const int tid = otid(), lane = tid & 63, wave = __builtin_amdgcn_readfirstlane(tid >> 6), r = lane & 15, quad = lane >> 4;
    LAS bf16* Ks = (LAS bf16*)lds;
    LAS bf16* Vt = (LAS bf16*)(lds + 36864);
    const bool lat = unit < 512;
    int b, kh, qrow0, qpos0, ntiles, tlo;
    if (lat) { b = unit >> 6; const int n = (unit & 63) >> 1; kh = unit & 1; qpos0 = 64 * n; qrow0 = b * SEQ + qpos0; tlo = n == 0 ? 2 : (n == 1 ? 1 : 0); const int thi = n == 31 ? 3 : (n == 30 ? 4 : 5); ntiles = 4 + thi - tlo; }
    else { const int cu = unit - 512; b = cu >> 3; const int qb4 = (cu & 7) >> 1; kh = cu & 1; qpos0 = 0; qrow0 = ML + b * CTXL + 64 * qb4; tlo = 0; ntiles = 4; }
    const int hh = wave >> 1, qhead = kh * 4 + hh, qw0 = (wave & 1) * 32;
    LAS f32x2* ropeL = (LAS f32x2*)(lds + 73728);
    ropeL[tid] = ((const f32x2*)rope)[tid]; ropeL[tid + NTHREADS] = ((const f32x2*)rope)[tid + NTHREADS];
    __syncthreads();
    const float QSC = 0.125f * 1.4426950408889634f;
    bf16x8 qf[2][2];
#pragma unroll
    for (int qb = 0; qb < 2; ++qb)
#pragma unroll
        for (int ks = 0; ks < 2; ++ks) {
            const int qi = qw0 + qb * 16 + r;
            const bf16* ptr = Z + (size_t)(qrow0 + qi) * INW + ZQ + qhead * 64 + ks * 32;
            const u32x4 own = *(const u32x4*)(ptr + quad * 8);
            if (lat) { const u32x4 par = *(const u32x4*)(ptr + (quad ^ 2) * 8); const int pos = qpos0 + qi; const int p = ks == 0 ? (pos >> 6) : (pos & 63);
                qf[qb][ks] = rope8(own, par, ropeL + p * 16 + (quad & 1) * 8, quad < 2, QSC); }
            else qf[qb][ks] = scale8(own, QSC);
        }
    const float sk = sink_l[qhead] * 1.4426950408889634f;
    float mrun[2], lrun[2]; f32x4 o[2][4];
#pragma unroll
    for (int qb = 0; qb < 2; ++qb) { mrun[qb] = sk; lrun[qb] = quad == 0 ? 1.f : 0.f;
#pragma unroll
        for (int db = 0; db < 4; ++db) o[qb][db] = (f32x4){0.f, 0.f, 0.f, 0.f}; }
    const int skey = tid >> 3, c8 = tid & 7;
    u32x4 kown, kpar, vv;
    auto tile_rows = [&](int idx, int& rowbase, int& kpos0) { if (idx < 4) { rowbase = ML + b * CTXL + 64 * idx; kpos0 = -100000; } else { kpos0 = qpos0 - 128 + 64 * (tlo + idx - 4); rowbase = b * SEQ + kpos0; } };
    auto prefetch = [&](int idx) { int rowbase, kpos0; tile_rows(idx, rowbase, kpos0);
        const bf16* zr = Z + (size_t)(rowbase + skey) * INW;
        kown = *(const u32x4*)(zr + ZK + kh * 64 + c8 * 8); kpar = *(const u32x4*)(zr + ZK + kh * 64 + (c8 ^ 2) * 8); vv = *(const u32x4*)(zr + ZV + kh * 64 + c8 * 8); };
    auto stage_store = [&](int idx, int buf) {
        int rowbase, kpos0; tile_rows(idx, rowbase, kpos0);
        LAS bf16* Kb = Ks + buf * 9216; LAS bf16* Vb = Vt + buf * 9216;
        bf16x8 kk;
        if (kpos0 >= 0) { const int pos = kpos0 + skey; const int p = (c8 < 4) ? (pos >> 6) : (pos & 63);
            kk = rope8(kown, kpar, ropeL + p * 16 + (c8 & 1) * 8, (c8 & 3) < 2, 1.0f); }
        else kk = __builtin_bit_cast(bf16x8, kown);
        *(LAS bf16x8*)(Kb + skey * 72 + c8 * 8) = kk;
#pragma unroll
        for (int j = 0; j < 8; ++j) Vb[(c8 * 8 + j) * 72 + skey] = (bf16)((vv[j >> 1] >> ((j & 1) * 16)) & 0xffffu);
    };
    prefetch(0);
    __syncthreads();
    stage_store(0, 0);
    if (ntiles > 1) prefetch(1);
    __syncthreads();
    for (int it = 0; it < ntiles; ++it) {
        int rowbase, kpos0; tile_rows(it, rowbase, kpos0);
        const LAS bf16* Kc = Ks + (it & 1) * 9216; const LAS bf16* Vc = Vt + (it & 1) * 9216;
        bf16x8 kf[4][2], vf[4][2];
#pragma unroll
        for (int kb = 0; kb < 4; ++kb)
#pragma unroll
            for (int ks = 0; ks < 2; ++ks) kf[kb][ks] = *(const LAS bf16x8*)(Kc + (kb * 16 + r) * 72 + ks * 32 + quad * 8);
#pragma unroll
        for (int db = 0; db < 4; ++db)
#pragma unroll
            for (int k2 = 0; k2 < 2; ++k2) { const u32x2 a = *(const LAS u32x2*)(Vc + (db * 16 + r) * 72 + 32 * k2 + 4 * quad), c = *(const LAS u32x2*)(Vc + (db * 16 + r) * 72 + 32 * k2 + 16 + 4 * quad);
                u32x4 w; w.x = a.x; w.y = a.y; w.z = c.x; w.w = c.y; vf[db][k2] = __builtin_bit_cast(bf16x8, w); }
#pragma unroll
        for (int qb = 0; qb < 2; ++qb) {
            f32x4 st[4];
#pragma unroll
            for (int kb = 0; kb < 4; ++kb) { st[kb] = (f32x4){0.f, 0.f, 0.f, 0.f};
#pragma unroll
                for (int ks = 0; ks < 2; ++ks) st[kb] = __builtin_amdgcn_mfma_f32_16x16x32_bf16(kf[kb][ks], qf[qb][ks], st[kb], 0, 0, 0); }
            if (kpos0 >= 0) { const int qpos = qpos0 + qw0 + qb * 16 + r;
#pragma unroll
                for (int kb = 0; kb < 4; ++kb)
#pragma unroll
                    for (int j = 0; j < 4; ++j) { const int dd = qpos - (kpos0 + kb * 16 + quad * 4 + j); if (dd > 128 || dd < -128) st[kb][j] = -1e30f; } }
            float mx = -3e38f;
#pragma unroll
            for (int kb = 0; kb < 4; ++kb)
#pragma unroll
                for (int j = 0; j < 4; ++j) mx = fmaxf(mx, st[kb][j]);
            mx = xmax32(xmax16(mx));
            const float mnew = fmaxf(mrun[qb], mx), alpha = __builtin_amdgcn_exp2f(mrun[qb] - mnew); mrun[qb] = mnew;
            float ps = 0.f;
#pragma unroll
            for (int kb = 0; kb < 4; ++kb)
#pragma unroll
                for (int j = 0; j < 4; ++j) { const float pv = __builtin_amdgcn_exp2f(st[kb][j] - mnew); ps += pv; st[kb][j] = pv; }
            lrun[qb] = lrun[qb] * alpha + ps;
#pragma unroll
            for (int db = 0; db < 4; ++db) o[qb][db] = o[qb][db] * alpha;
#pragma unroll
            for (int k2 = 0; k2 < 2; ++k2) { u32x4 w; w.x = pk2(st[2 * k2][0], st[2 * k2][1]); w.y = pk2(st[2 * k2][2], st[2 * k2][3]); w.z = pk2(st[2 * k2 + 1][0], st[2 * k2 + 1][1]); w.w = pk2(st[2 * k2 + 1][2], st[2 * k2 + 1][3]);
                const bf16x8 pb = __builtin_bit_cast(bf16x8, w);
#pragma unroll
                for (int db = 0; db < 4; ++db) o[qb][db] = __builtin_amdgcn_mfma_f32_16x16x32_bf16(vf[db][k2], pb, o[qb][db], 0, 0, 0); }
        }
        if (it + 1 < ntiles) { stage_store(it + 1, (it + 1) & 1); if (it + 2 < ntiles) prefetch(it + 2); }
        __syncthreads();
    }
#pragma unroll
    for (int qb = 0; qb < 2; ++qb) { float lt = xsum32(xsum16(lrun[qb])); const float inv = rcpf_(lt);
        bf16* yr = Y + (size_t)(qrow0 + qw0 + qb * 16 + r) * DM + 256 + qhead * 64 + quad * 4;
#pragma unroll
        for (int db = 0; db < 4; ++db) { u32x2 pk; pk.x = pk2(o[qb][db][0] * inv, o[qb][db][1] * inv); pk.y = pk2(o[qb][db][2] * inv, o[qb][db][3] * inv); *(u32x2*)(yr + db * 16) = pk; } }
    __syncthreads();
}

__device__ __forceinline__ int hg_row(int b, int step, int dir, int tau) {
    if (dir == 0) return step < 4 ? ML + b * CTXL + 64 * step + tau : b * SEQ + 64 * (step - 4) + tau;
    return step < 4 ? ML + b * CTXL + 64 * (3 - step) + 63 - tau : b * SEQ + 64 * (35 - step) + 63 - tau;
}
__device__ __forceinline__ void hg_stage(LAS bf16* dst, const bf16* Z, int b, int step, int dir, int col0, int tid) {
    const int tau = tid >> 3, c8 = tid & 7;
    *(LAS u32x4*)(dst + tau * 72 + c8 * 8) = *(const u32x4*)(Z + (size_t)hg_row(b, step, dir, tau) * INW + col0 + c8 * 8);
}
__device__ __forceinline__ float hg_gates(const LAS bf16* RAWF, LAS float* TOT, float lb, float (&kk)[8], float (&bb)[8], int lane, int wave, float (&cend)[3], int rs = 72) {
    float run = 0.f;
#pragma unroll
    for (int i = 0; i < 8; ++i) { const float fp = bf2f(RAWF[(8 * wave + i) * rs + lane]);
        const float e = __expf(fp);
        const float om = (1.f - lb) * rcpf_(1.f + e);
        kk[i] = om; run += __logf(1.f - om); bb[i] = run; }
    TOT[wave * 64 + lane] = run;
    __syncthreads();
    float pre = 0.f, tot = 0.f;
#pragma unroll
    for (int s = 0; s < 8; ++s) { const float t = TOT[s * 64 + lane]; tot += t; if (s < wave) pre += t; if (s == 1) cend[0] = tot; if (s == 3) cend[1] = tot; if (s == 5) cend[2] = tot; }
#pragma unroll
    for (int i = 0; i < 8; ++i) bb[i] += pre;
    return tot;
}

struct HuPre { u32x4 f, v; bool valid; };
__device__ __forceinline__ HuPre hu_load(const bf16* Z, int u, int tid) {
    const int chain = u / 36, step = u % 36, b = chain >> 3, h = (chain >> 1) & 3, dir = chain & 1;
    const int tau = tid >> 3, c8 = tid & 7;
    const bf16* zr = Z + (size_t)hg_row(b, step, dir, tau) * INW + h * 64 + c8 * 8;
    HuPre p; p.f = *(const u32x4*)(zr + (dir ? ZFB : ZFF)); p.v = *(const u32x4*)(zr + ZHI); p.valid = true; return p;
}
__device__ __forceinline__ void hgU_unit(LAS unsigned char* lds, const bf16* Z, const float* LBl, float* Sbuf, float* DEC, int u, HuPre& pre, int u_next) {
    const int tid = otid(), lane = tid & 63, wave = __builtin_amdgcn_readfirstlane(tid >> 6), r = lane & 15, quad = lane >> 4;
    LAS bf16* KH = (LAS bf16*)lds;
    LAS bf16* VT = (LAS bf16*)(lds + 9216);
    LAS float* TOT = (LAS float*)(lds + 18432);
    LAS bf16* RAWF = (LAS bf16*)(lds + 20480);
    LAS bf16* RAWV = (LAS bf16*)(lds + 29696);
    const int chain = u / 36, step = u % 36, b = chain >> 3, h = (chain >> 1) & 3, dir = chain & 1;
    const float lb = LBl[dir * 256 + h * 64 + lane];
    if (!pre.valid) pre = hu_load(Z, u, tid);
    { const int tau = tid >> 3, c8 = tid & 7; *(LAS u32x4*)(RAWF + tau * 72 + c8 * 8) = pre.f; *(LAS u32x4*)(RAWV + tau * 72 + c8 * 8) = pre.v; }
    __syncthreads();
    if (u_next >= 0) pre = hu_load(Z, u_next, tid); else pre.valid = false;
    float kk[8], bb[8];
    float cend_[3];
    const float bend = hg_gates(RAWF, TOT, lb, kk, bb, lane, wave, cend_);
    float kh[8];
    u32x4 x;
#pragma unroll
    for (int i = 0; i < 8; ++i) kh[i] = kk[i] * __expf(bend - bb[i]);
#pragma unroll
    for (int i = 0; i < 4; ++i) x[i] = (unsigned)RAWV[(8 * wave + 2 * i) * 72 + lane] | ((unsigned)RAWV[(8 * wave + 2 * i + 1) * 72 + lane] << 16);
    { u32x4 w; w.x = pk2(kh[0], kh[1]); w.y = pk2(kh[2], kh[3]); w.z = pk2(kh[4], kh[5]); w.w = pk2(kh[6], kh[7]); *(LAS u32x4*)(KH + lane * 72 + 8 * wave) = w;
      *(LAS u32x4*)(VT + lane * 72 + 8 * wave) = x; }
    if (wave == 0) DEC[(size_t)u * 64 + lane] = __expf(bend);
    __syncthreads();
#pragma unroll
    for (int e = 0; e < 2; ++e) { const int tt = 2 * wave + e, v0 = (tt >> 2) * 16, k0 = (tt & 3) * 16;
        f32x4 acc = {0.f, 0.f, 0.f, 0.f};
        acc = mma16(VT + v0 * 72, 72, KH + k0 * 72, 72, 64, acc, lane);
#pragma unroll
        for (int j = 0; j < 4; ++j) Sbuf[(size_t)u * 4096 + (v0 + quad * 4 + j) * 64 + k0 + r] = acc[j]; }
    __syncthreads();
}

__device__ __forceinline__ void hg_chain(LAS unsigned char* lds, const bf16* Z, const float* LBl, float* Sbuf, int chain) {
    const int tid = otid(), lane = tid & 63, wave = __builtin_amdgcn_readfirstlane(tid >> 6), r = lane & 15, quad = lane >> 4;
    LAS bf16* KH = (LAS bf16*)lds;
    LAS bf16* VT = (LAS bf16*)(lds + 9216);
    LAS float* TOT = (LAS float*)(lds + 18432);
    LAS bf16* RAWF = (LAS bf16*)(lds + 20480);
    LAS bf16* RAWV = (LAS bf16*)(lds + 29696);
    LAS float* DECL = (LAS float*)(lds + 57344);
    const int h = (chain >> 1) & 3, dir = chain & 1;
    const float lb = LBl[dir * 256 + h * 64 + lane];
    f32x4 st[2];
    st[0] = (f32x4){0.f, 0.f, 0.f, 0.f}; st[1] = st[0];
    HuPre pre = hu_load(Z, chain * 36, tid);
    __syncthreads();
    { const int tau = tid >> 3, c8 = tid & 7; *(LAS u32x4*)(RAWF + tau * 72 + c8 * 8) = pre.f; *(LAS u32x4*)(RAWV + tau * 72 + c8 * 8) = pre.v; }
    pre = hu_load(Z, chain * 36 + 1, tid);
    __syncthreads();
#pragma unroll 1
    for (int step = 0; step < 36; ++step) {
        const int u = chain * 36 + step;
        LAS bf16* RF = RAWF + (step & 1) * 9216;
        LAS bf16* RV = RAWV + (step & 1) * 9216;
        float kk[8], bb[8], cend_[3];
        const float bend = hg_gates(RF, TOT, lb, kk, bb, lane, wave, cend_);
        float kh[8]; u32x4 x;
#pragma unroll
        for (int i = 0; i < 8; ++i) kh[i] = kk[i] * __expf(bend - bb[i]);
#pragma unroll
        for (int i = 0; i < 4; ++i) x[i] = (unsigned)RV[(8 * wave + 2 * i) * 72 + lane] | ((unsigned)RV[(8 * wave + 2 * i + 1) * 72 + lane] << 16);
        { u32x4 w; w.x = pk2(kh[0], kh[1]); w.y = pk2(kh[2], kh[3]); w.z = pk2(kh[4], kh[5]); w.w = pk2(kh[6], kh[7]); *(LAS u32x4*)(KH + lane * 72 + 8 * wave) = w;
          *(LAS u32x4*)(VT + lane * 72 + 8 * wave) = x; }
        if (wave == 0) DECL[lane] = __expf(bend);
        if (step + 1 < 36) { const int tau = tid >> 3, c8 = tid & 7; LAS bf16* NF = RAWF + ((step + 1) & 1) * 9216; LAS bf16* NV = RAWV + ((step + 1) & 1) * 9216;
            *(LAS u32x4*)(NF + tau * 72 + c8 * 8) = pre.f; *(LAS u32x4*)(NV + tau * 72 + c8 * 8) = pre.v;
            if (step + 2 < 36) pre = hu_load(Z, u + 2, tid); }
        __syncthreads();
#pragma unroll
        for (int e = 0; e < 2; ++e) { const int tt = 2 * wave + e, v0 = (tt >> 2) * 16, k0 = (tt & 3) * 16;
            f32x4 acc = {0.f, 0.f, 0.f, 0.f};
            acc = mma16(VT + v0 * 72, 72, KH + k0 * 72, 72, 64, acc, lane);
            const float dk = DECL[k0 + r];
#pragma unroll
            for (int j = 0; j < 4; ++j) { Sbuf[(size_t)u * 4096 + (v0 + quad * 4 + j) * 64 + k0 + r] = st[e][j]; st[e][j] = dk * st[e][j] + acc[j]; } }
    }
    __syncthreads();
}

__device__ __forceinline__ void ph_hg_scan(float* __restrict__ Sbuf, const float* __restrict__ DEC) {
    const int gt = blockIdx.x * NTHREADS + otid(), nt = gridDim.x * NTHREADS;
    for (int i = gt; i < 64 * 4096; i += nt) { const int chain = i >> 12, e = i & 4095, k = e & 63;
        float* __restrict__ sp = Sbuf + (size_t)chain * 36 * 4096 + e; const float* __restrict__ dp = DEC + (size_t)chain * 36 * 64 + k;
        float s = 0.f;
#pragma unroll 1
        for (int s0 = 0; s0 < 36; s0 += 12) {
            float uu[12], dd[12];
#pragma unroll
            for (int j = 0; j < 12; ++j) { uu[j] = sp[(size_t)(s0 + j) * 4096]; dd[j] = dp[(s0 + j) * 64]; }
#pragma unroll
            for (int j = 0; j < 12; ++j) { sp[(size_t)(s0 + j) * 4096] = s; s = dd[j] * s + uu[j]; }
        } }
}

constexpr int HO_RAWQ = 0, HO_RAWF = 9216, HO_RAWV = 18432, HO_QE = 27648, HO_KT = 36864, HO_KD = 46080, HO_VT = 55296, HO_ST = 64512, HO_AM = 73728, HO_QOFF = 82944, HO_OB = 96768, HO_TOT = 114176, HO_BEND = 116224, HO_ST1 = 117248;
struct HoPre { u32x4 q, f, v; f32x4 s0, s1; };
__device__ __forceinline__ void ho_decode(int it, int l, int& b, int& cstep, int& h) {
    if (l == 0) { b = it / 144; cstep = (it % 144) >> 2; h = it & 3; } else { b = it >> 7; cstep = 4 + ((it & 127) >> 2); h = it & 3; }
}
__device__ __forceinline__ HoPre ho_load(const bf16* Z, const float* Sbuf, int b, int cstep, int h, int dir, int tid) {
    const int step = dir == 0 ? cstep : (cstep < 4 ? 3 - cstep : 39 - cstep);
    const int uidx = ((b * 4 + h) * 2 + dir) * 36 + step;
    const int tau = tid >> 3, c8 = tid & 7;
    const bf16* zr = Z + (size_t)hg_row(b, step, dir, tau) * INW + h * 64 + c8 * 8;
    HoPre p; p.q = *(const u32x4*)(zr + ZHQ); p.f = *(const u32x4*)(zr + (dir ? ZFB : ZFF)); p.v = *(const u32x4*)(zr + ZHI);
    const float* sp = Sbuf + (size_t)uidx * 4096 + tau * 64 + c8 * 8; p.s0 = *(const f32x4*)sp; p.s1 = *(const f32x4*)(sp + 4);
    return p;
}
constexpr int H2_RAW = 0  , H2_QE = 49152, H2_KT = 58368, H2_KD = 67584, H2_VT = 76800, H2_ST = 86016  ,
              H2_AM = 104448, H2_QOFF = 113664, H2_OB = 127488, H2_TOT = 144896;
static_assert(H2_TOT + 2048 <= LDS_BYTES - 256, "hgO LDS map");
__device__ __forceinline__ HoPre ho_load_k(const bf16* Z, const float* Sbuf, int l, int it0, int G, int k, int tid) {
    int b, cstep, h; ho_decode(it0 + (k >> 1) * G, l, b, cstep, h);
    return ho_load(Z, Sbuf, b, cstep, h, k & 1, tid);
}
__device__ __forceinline__ void ho_stage(LAS unsigned char* lds, const HoPre& pre, int set, int dirbuf, int tid) {
    const int tau = tid >> 3, c8 = tid & 7;
    LAS bf16* R = (LAS bf16*)(lds + H2_RAW + set * 24576);
    *(LAS u32x4*)(R + tau * 64 + c8 * 8) = pre.q; *(LAS u32x4*)(R + 4096 + tau * 64 + c8 * 8) = pre.f; *(LAS u32x4*)(R + 8192 + tau * 64 + c8 * 8) = pre.v;
    u32x4 w; w.x = pk2(pre.s0.x, pre.s0.y); w.y = pk2(pre.s0.z, pre.s0.w); w.z = pk2(pre.s1.x, pre.s1.y); w.w = pk2(pre.s1.z, pre.s1.w);
    *(LAS u32x4*)((LAS bf16*)(lds + H2_ST + dirbuf * 9216) + tau * 72 + c8 * 8) = w;
}
__device__ __forceinline__ void ph_hgO(LAS unsigned char* lds, const bf16* Z, bf16* Y, const float* LBl, const float* Sbuf, const float* hg_norm_w_l, int l, int n_u) {
    const int it0 = blockIdx.x, G = (int)gridDim.x; if (it0 >= n_u) return;
    const int nk = 2 * ((n_u - it0 + G - 1) / G);
    const int tid = otid(), lane = tid & 63, wave = __builtin_amdgcn_readfirstlane(tid >> 6), r = lane & 15, quad = lane >> 4;
    LAS bf16* QE = (LAS bf16*)(lds + H2_QE); LAS bf16* KT = (LAS bf16*)(lds + H2_KT); LAS bf16* KD = (LAS bf16*)(lds + H2_KD); LAS bf16* VT = (LAS bf16*)(lds + H2_VT);
    LAS bf16* AM = (LAS bf16*)(lds + H2_AM); LAS bf16* QOFF = (LAS bf16*)(lds + H2_QOFF);
    LAS float* OB = (LAS float*)(lds + H2_OB);
    LAS float* TOT = (LAS float*)(lds + H2_TOT);
    HoPre pre = ho_load_k(Z, Sbuf, l, it0, G, 0, tid);
    ho_stage(lds, pre, 0, 0, tid);
    if (nk > 1) pre = ho_load_k(Z, Sbuf, l, it0, G, 1, tid);
    __syncthreads();
#pragma unroll 1
    for (int k = 0; k < nk; ++k) {
        const int dir = k & 1;
        int b, cstep, h; ho_decode(it0 + (k >> 1) * G, l, b, cstep, h);
        const float lb = LBl[dir * 256 + h * 64 + lane];
        const LAS bf16* RAWQ = (const LAS bf16*)(lds + H2_RAW + dir * 24576); const LAS bf16* RAWF = RAWQ + 4096; const LAS bf16* RAWV = RAWQ + 8192;
        const LAS bf16* ST = (const LAS bf16*)(lds + H2_ST + dir * 9216);
        float kk[8], bb[8], cend[3];
        const float btot = hg_gates(RAWF, TOT, lb, kk, bb, lane, wave, cend, 64);
        { u32x4 x;
#pragma unroll
          for (int i = 0; i < 4; ++i) x[i] = (unsigned)RAWV[(8 * wave + 2 * i) * 64 + lane] | ((unsigned)RAWV[(8 * wave + 2 * i + 1) * 64 + lane] << 16);
          *(LAS u32x4*)(VT + lane * 72 + 8 * wave) = x; }
        { const int jj = wave >> 1;
          const float b0 = cend[0], b1 = cend[1], b2 = cend[2];
          const float be = jj == 0 ? b0 : (jj == 1 ? b1 : (jj == 2 ? b2 : btot));
          const float bs = jj == 0 ? 0.f : (jj == 1 ? b0 : (jj == 2 ? b1 : b2));
          const float Es = __expf(bs);
          const float H0 = jj >= 2 ? __expf(bs - b0) : 1.f, H1 = jj >= 3 ? __expf(bs - b1) : 1.f;
#pragma unroll
          for (int i2 = 0; i2 < 4; ++i2) { const int tau = 8 * wave + 2 * i2;
              const float ba = bb[2 * i2], bb_ = bb[2 * i2 + 1], ka = kk[2 * i2], kb_ = kk[2 * i2 + 1];
              const float qa = siluf(bf2f(RAWQ[tau * 64 + lane])) * __expf(ba - bs), qb_ = siluf(bf2f(RAWQ[(tau + 1) * 64 + lane])) * __expf(bb_ - bs);
              unsigned w;
              w = pk2(qa * Es, qb_ * Es); QE[tau * 72 + lane] = (bf16)(w & 0xffffu); QE[(tau + 1) * 72 + lane] = (bf16)(w >> 16);
              w = pk2(ka * __expf(be - ba), kb_ * __expf(be - bb_)); KT[tau * 72 + lane] = (bf16)(w & 0xffffu); KT[(tau + 1) * 72 + lane] = (bf16)(w >> 16);
              w = pk2(ka * __expf(fminf(bs - ba, 80.f)), kb_ * __expf(fminf(bs - bb_, 80.f))); KD[tau * 72 + lane] = (bf16)(w & 0xffffu); KD[(tau + 1) * 72 + lane] = (bf16)(w >> 16);
              if (jj >= 1) { w = pk2(qa * H0, qb_ * H0); QOFF[(tau - 16) * 72 + lane] = (bf16)(w & 0xffffu); QOFF[(tau - 15) * 72 + lane] = (bf16)(w >> 16); }
              if (jj >= 2) { w = pk2(qa * H1, qb_ * H1); QOFF[(48 + tau - 32) * 72 + lane] = (bf16)(w & 0xffffu); QOFF[(48 + tau - 31) * 72 + lane] = (bf16)(w >> 16); }
              if (jj >= 3) { w = pk2(qa, qb_); QOFF[(80 + tau - 48) * 72 + lane] = (bf16)(w & 0xffffu); QOFF[(80 + tau - 47) * 72 + lane] = (bf16)(w >> 16); } } }
        if (k + 1 < nk) { ho_stage(lds, pre, 1 - dir, 1 - dir, tid); if (k + 2 < nk) pre = ho_load_k(Z, Sbuf, l, it0, G, k + 2, tid); }
        __syncthreads();
#pragma unroll
        for (int ee = 0; ee < 2; ++ee) { const int bi = 2 * wave + ee, i = bi >> 2, j = bi & 3;
            if (j <= i) {
                const LAS bf16* qa = (j < i) ? QOFF + ((j == 0 ? 0 : (j == 1 ? 48 : 80)) + 16 * (i - j - 1)) * 72
                                             : (i == 0 ? QE : QOFF + (i == 1 ? 0 : (i == 2 ? 48 : 80)) * 72);
                const LAS bf16* ka = (j < i) ? KT + 16 * j * 72 : KD + 16 * i * 72;
                f32x4 acc = {0.f, 0.f, 0.f, 0.f};
                acc = mma16(qa, 72, ka, 72, 64, acc, lane);
#pragma unroll
                for (int jj = 0; jj < 4; ++jj) { const float v = (j < i || r <= quad * 4 + jj) ? acc[jj] : 0.f; AM[(16 * i + quad * 4 + jj) * 72 + 16 * j + r] = (bf16)f2bf(v); } }
            else {
#pragma unroll
                for (int jj = 0; jj < 4; ++jj) AM[(16 * i + quad * 4 + jj) * 72 + 16 * j + r] = (bf16)0; } }
        __syncthreads();
#pragma unroll
        for (int e = 0; e < 2; ++e) { const int tt = 2 * wave + e, tau0 = (tt >> 2) * 16, v0 = (tt & 3) * 16;
            f32x4 acc = {0.f, 0.f, 0.f, 0.f};
            acc = mma16(AM + tau0 * 72, 72, VT + v0 * 72, 72, tau0 < 32 ? 32 : 64, acc, lane);
            acc = mma16(QE + tau0 * 72, 72, ST + v0 * 72, 72, 64, acc, lane);
#pragma unroll
            for (int j = 0; j < 4; ++j) { const int tau = tau0 + quad * 4 + j; const int t = dir == 0 ? tau : 63 - tau;
                if (dir == 0) OB[t * 68 + v0 + r] = acc[j]; else OB[t * 68 + v0 + r] += acc[j]; } }
        if (dir == 1) {
            __syncthreads();
            const float nw = hg_norm_w_l[lane];
            const int rowbase = cstep < 4 ? ML + b * CTXL + 64 * cstep : b * SEQ + 64 * (cstep - 4);
#pragma unroll
            for (int i = 0; i < 8; ++i) { const int t = 8 * wave + i; const float v = OB[t * 68 + lane];
                const float rstd = rsqrtf(wave_sum(v * v) * (1.f / 64.f) + EPSN);
                const float gt = bf2f(Z[(size_t)(rowbase + t) * INW + ZHG + h * 64 + lane]);
                Y[(size_t)(rowbase + t) * DM + 768 + h * 64 + lane] = (bf16)f2bf(v * rstd * nw * siluf(gt)); }
        }
    }
    __syncthreads();
}

__device__ __forceinline__ void flat_barrier(unsigned* ctr, unsigned target) {
    __builtin_amdgcn_fence(__ATOMIC_RELEASE, "agent");
    asm volatile("s_waitcnt vmcnt(0)" ::: "memory");
    __syncthreads();
    if (threadIdx.x == 0) {
        __hip_atomic_fetch_add(ctr, 1u, __ATOMIC_RELEASE, __HIP_MEMORY_SCOPE_AGENT);
        while (__hip_atomic_load(ctr, __ATOMIC_ACQUIRE, __HIP_MEMORY_SCOPE_AGENT) < target) __builtin_amdgcn_s_sleep(2);
    }
    __syncthreads();
    __builtin_amdgcn_fence(__ATOMIC_ACQUIRE, "agent");
    asm volatile("s_waitcnt vmcnt(0)" ::: "memory");
}
#define XB_TMO      128
#define XB_XCNT(j)  (256  + 64 * (j))
#define XB_XSUB(j)  (1280 + 64 * (j))
#define XB_XGEN(j)  (2304 + 64 * (j))
#define XB_TOP      3328
#define XB_TOPGEN   3392
#define XCD_BAR_WORDS 3456
#define XB_SPIN_CAP (1u << 18)

__device__ __forceinline__ unsigned xb_ld(unsigned* p)              { return __hip_atomic_load(p, __ATOMIC_RELAXED, __HIP_MEMORY_SCOPE_AGENT); }
__device__ __forceinline__ unsigned xb_add(unsigned* p, unsigned v) { return __hip_atomic_fetch_add(p, v, __ATOMIC_RELAXED, __HIP_MEMORY_SCOPE_AGENT); }
__device__ __forceinline__ unsigned xb_xcc_id() { return (unsigned)__builtin_amdgcn_s_getreg((3 << 11) | 20) & 0xFu; }
#define XB_SPIN(cond, bar) do { unsigned _sp = 0; while (cond) { __builtin_amdgcn_s_sleep(1); \
    if ((++_sp & 255u) == 0u) { if (xb_ld(&(bar)[XB_TMO])) break; if (_sp > XB_SPIN_CAP) { atomicAdd(&(bar)[XB_TMO], 1u); break; } } } } while (0)

struct XcdBarrier {
    unsigned* bar; unsigned x;
    volatile LAS unsigned* st;
};

__device__ __forceinline__ XcdBarrier xcd_barrier_post(unsigned* bar, volatile LAS unsigned* st) {
    XcdBarrier b; b.bar = bar; b.x = xb_xcc_id(); b.st = st;
    if (threadIdx.x == 0) (void)xb_add(&bar[XB_XCNT(b.x)], 1u);
    return b;
}
__device__ __forceinline__ void xcd_barrier_complete(unsigned* bar, unsigned x, unsigned& nloc, unsigned& nx) {
    const unsigned G = gridDim.x * gridDim.y * gridDim.z;
    unsigned sum, cnt, mine, sp = 0u;
    for (;;) {
        sum = 0u; cnt = 0u; mine = 0u;
#pragma unroll
        for (unsigned j = 0; j < 16; ++j) { const unsigned c = xb_ld(&bar[XB_XCNT(j)]); sum += c; cnt += (c > 0u) ? 1u : 0u; mine = (j == x) ? c : mine; }
        if (sum == G) break;
        __builtin_amdgcn_s_sleep(1);
        if ((++sp & 255u) == 0u) { if (xb_ld(&bar[XB_TMO])) break; if (sp > XB_SPIN_CAP) { atomicAdd(&bar[XB_TMO], 1u); break; } }
    }
    nloc = mine > 0u ? mine : 1u; nx = cnt > 0u ? cnt : 1u;
}

__device__ __forceinline__ void xcd_barrier(const XcdBarrier& b) {
    asm volatile("s_waitcnt vmcnt(0)" ::: "memory");
    __syncthreads();
    if (threadIdx.x == 0) {
        unsigned* bar = b.bar;
        __builtin_amdgcn_s_waitcnt(0);
        unsigned nloc = b.st[0], nx = b.st[1];
        if (nloc == 0u) { xcd_barrier_complete(bar, b.x, nloc, nx); b.st[0] = nloc; b.st[1] = nx; }
        const unsigned old = xb_add(&bar[XB_XSUB(b.x)], 1u);
        const unsigned gen = old / nloc;
        if (old + 1u == (gen + 1u) * nloc) {
            __builtin_amdgcn_fence(__ATOMIC_RELEASE, "agent");
            asm volatile("s_waitcnt vmcnt(0)" ::: "memory");
            const unsigned og = xb_add(&bar[XB_TOP], 1u);
            const unsigned tg = og / nx;
            if (og + 1u == (tg + 1u) * nx) xb_add(&bar[XB_TOPGEN], 1u);
            else XB_SPIN(xb_ld(&bar[XB_TOPGEN]) == tg, bar);
            __builtin_amdgcn_fence(__ATOMIC_ACQUIRE, "agent");
            xb_add(&bar[XB_XGEN(b.x)], 1u);
            asm volatile("s_waitcnt vmcnt(0)" ::: "memory");
        } else {
            XB_SPIN(xb_ld(&bar[XB_XGEN(b.x)]) == gen, bar);
            __builtin_amdgcn_fence(__ATOMIC_ACQUIRE, "agent");
            asm volatile("s_waitcnt vmcnt(0)" ::: "memory");
        }
    }
    __syncthreads();
}

constexpr int NPHASE = 20;
#ifndef EN_MASK
#define EN_MASK 0x3ff
#endif
#define EN(k) (((EN_MASK) >> (k)) & 1)
#ifndef REP_OP0
#define REP_OP0 1
#endif
#ifndef REP_SYNC
#define REP_SYNC 0
#endif
#ifndef REP_PRO
#define REP_PRO 1
#endif
#ifndef REP_NORM
#define REP_NORM 1
#endif
#ifndef REP_MIX1
#define REP_MIX1 1
#endif
#ifndef REP_HGO
#define REP_HGO 1
#endif
#ifndef REP_GZ
#define REP_GZ 1
#endif
#ifndef REP_ATT
#define REP_ATT 1
#endif
#ifndef REP_HU
#define REP_HU 1
#endif
#ifndef REP_POOL
#define REP_POOL 1
#endif
typedef __attribute__((address_space(4))) const Params CParams;
__device__ __forceinline__ CParams* kparams() { CParams* p = (CParams*)__builtin_amdgcn_kernarg_segment_ptr(); asm volatile("" : "+s"(p)); return p; }
__device__ __forceinline__ Params ldparams(CParams* k) { Params P;
    P.x = k->x; P.c = k->c; P.ctx = k->ctx; P.c_ctx = k->c_ctx; P.w_ada = k->w_ada; P.b_ada = k->b_ada; P.norm1_w = k->norm1_w; P.w_in = k->w_in; P.pool_w = k->pool_w; P.pool_scale = k->pool_scale;
    P.attn_sink = k->attn_sink; P.hg_lower = k->hg_lower; P.hg_norm_w = k->hg_norm_w; P.w_out = k->w_out; P.norm2_w = k->norm2_w; P.w_mlp1 = k->w_mlp1; P.w_mlp2 = k->w_mlp2; P.final_norm_w = k->final_norm_w;
    P.out = k->out; P.ws = k->ws; P.ph_lo = k->ph_lo; P.ph_hi = k->ph_hi; return P; }
#define WSP(T, off) ((T*)(P.ws + (off)))
__global__ void __launch_bounds__(NTHREADS, 2) fwd_kernel(Params Parg) {
    extern __shared__ __attribute__((aligned(16))) unsigned char lds_raw[];
    LAS unsigned char* lds = (LAS unsigned char*)lds_raw;
    cg::grid_group grid = cg::this_grid();
    const int lo = Parg.ph_lo, hi = Parg.ph_hi;
    volatile LAS unsigned* bst = (volatile LAS unsigned*)(lds + LDS_BYTES - 256);
    if (threadIdx.x == 0) { bst[0] = 0u; bst[1] = 0u; }
    __syncthreads();
    const XcdBarrier xbar = xcd_barrier_post((unsigned*)(Parg.ws + WS_CTL), bst);
#define IN(k) (lo <= (k) && (k) < hi)
#define SEAM(k) do { if (IN(k) && IN((k) + 1)) { if (lo < 0) grid.sync(); else xcd_barrier(xbar); } } while (0)
    if (EN(0) && IN(0)) for (int rep = 0; rep < REP_PRO; ++rep) { const Params P = ldparams(kparams()); ph_prologue(P, lds); }
    SEAM(0);
#pragma unroll 1
    for (int l = 0; l < 2; ++l) {
        const int pb = 1 + 9 * l;
        const int mrows = l == 0 ? MT : ML;
        if (EN(1) && IN(pb + 0)) for (int rep = 0; rep < REP_NORM; ++rep) { const Params P = ldparams(kparams());
            ph_norm_mod(l == 0 ? P.x : P.out, l == 0 ? P.ctx : WSP(const float, WS_XC), MT, P.norm1_w + l * DM, WSP(const float, WS_MOD) + (size_t)l * 9 * 6144, 0, 1024, WSP(bf16, WS_ACT),
                        l == 0 ? (const float*)nullptr : WSP(const float, WS_P1), WSP(const float, WS_P2), WSP(const float, WS_P3), (l == 1 && gridDim.x == 256) ? ML : 0); }
        SEAM(pb + 0);
        if (EN(2) && IN(pb + 1)) for (int rep = 0; rep < REP_GZ; ++rep) { const Params P = ldparams(kparams());
            pg8::Gemm g{WSP(const bf16, WS_ACT), WSP(const bf16, WS_WT + (size_t)l * WT_LAYER + WT_IN), MT, INW, DM, DM}; pg8::StaticOrder S; S.init(MT, INW, gridDim.x, blockIdx.x);
            pg8::EpiBf E{WSP(bf16, WS_Z), INW, 0}; pg8::gemm_phase<pg8::EpiBf, pg8::StaticOrder, true, true>(lds, g, S, E);
            if (l == 0) {
                const int G = (int)gridDim.x, nun = (MT / 256) * (INW / 256), rem = nun % G, first = rem == 0 ? 0 : rem, nb = G - first;
                if ((int)blockIdx.x >= first) { const int t_ = otid(); const int w_ = __builtin_amdgcn_readfirstlane(t_ >> 6);
                    convert_weights(P, lds, 0, ((int)blockIdx.x - first) * 8 + w_, nb * 8, w_, t_ & 63, 1152, 5760); } } }
        SEAM(pb + 1);
        if (IN(pb + 2)) for (int rep = 0; rep < REP_MIX1; ++rep) { const Params P = ldparams(kparams());
            const bf16* Z = WSP(const bf16, WS_Z); bf16* ACT = WSP(bf16, WS_ACT);
            const int n_attn = l == 0 ? 576 : 512, n_pool = l == 0 ? 288 : 256, G = (int)gridDim.x, bx = (int)blockIdx.x;
            const int NCH = 64;
            if (G >= 2 * NCH) {
                if (bx < NCH) { if (EN(4)) hg_chain(lds, Z, WSP(const float, WS_LB) + l * 512, WSP(float, WS_S), bx); }
                else for (int it = bx - NCH; it < n_attn; it += G - NCH) { if (EN(3)) attn_unit(lds, Z, ACT, P.attn_sink + l * 8, WSP(const float2, WS_ROPE), it); }
            } else {
                for (int c = bx; c < NCH; c += G) hg_chain(lds, Z, WSP(const float, WS_LB) + l * 512, WSP(float, WS_S), c);
                for (int it = bx; it < n_attn; it += G) attn_unit(lds, Z, ACT, P.attn_sink + l * 8, WSP(const float2, WS_ROPE), it);
            }
            __syncthreads();
            {
                int j0 = bx, jstep = G;
                if (G == 256) {
                    if (l == 1) { j0 = bx >= 192 ? bx - 192 : n_pool; jstep = 64; }
                    else { if (bx >= 192) { j0 = bx - 192; jstep = 64; if (0) {} }
                           else if (bx < 160) { j0 = 128 + bx; jstep = 1024; }
                           else { j0 = n_pool; } }
                }
                const int jlim = (G == 256 && l == 0 && bx >= 192) ? 128 : n_pool;
                if (EN(5)) for (int j = j0; j < jlim; j += jstep) pool_unit(lds, Z, ACT, WSP(const bf16, WS_PWT) + (size_t)l * 4 * 64 * 64, P.pool_scale + l * 256, j);
            }
        }
        SEAM(pb + 2);
        if (EN(7) && IN(pb + 4)) for (int rep = 0; rep < REP_HGO; ++rep) { const Params P = ldparams(kparams());
            const int n_u = l == 0 ? 8 * 36 * 4 : 8 * 32 * 4;
            ph_hgO(lds, WSP(const bf16, WS_Z), WSP(bf16, WS_ACT), WSP(const float, WS_LB) + l * 512, WSP(const float, WS_S), P.hg_norm_w + l * 64, l, n_u);
        }
        SEAM(pb + 4);
        const bool fuse_n2 = (gridDim.x == 256);
        if (EN(8) && IN(pb + 5) && fuse_n2) { const Params P = ldparams(kparams());
            { pg8::Gemm g{WSP(const bf16, WS_ACT), WSP(const bf16, WS_WT + (size_t)l * WT_LAYER + WT_OUT), ML, DM, DM, DM}; pg8::StaticOrder S; S.init(ML, DM, gridDim.x, blockIdx.x);
              const float* modl = WSP(const float, WS_MOD) + (size_t)l * 9 * 6144;
              pg8::EpiNorm2 E{l == 0 ? P.x : P.out, P.out, modl + 2048, P.norm2_w + l * DM, modl + 4096, modl + 3072, WSP(bf16, WS_ACT), WSP(unsigned long long, WS_FSLOT + (l == 0 ? 1536 : 512) * 1024), WSP(unsigned, WS_CTL) + (l == 0 ? 16384 : 8192), EPSN, 0, -1};
              pg8::gemm_phase<pg8::EpiNorm2, pg8::StaticOrder, false, true>(lds, g, S, E); }
            if (l == 0) {
                pg8::Gemm g{WSP(const bf16, WS_ACT), WSP(const bf16, WS_WT + WT_OUT), MT, DM, DM, DM}; pg8::SplitOrder S{64, 8, 4, 1, (int)gridDim.x, (int)blockIdx.x};
                const float* mod0 = WSP(const float, WS_MOD);
                pg8::EpiNorm2 E{P.ctx, WSP(float, WS_XC), mod0 + 2048, P.norm2_w, mod0 + 4096, mod0 + 3072, WSP(bf16, WS_ACT), WSP(unsigned long long, WS_FSLOT + 2048 * 1024), WSP(unsigned, WS_CTL) + 20480, EPSN, 64, 8};
                pg8::gemm_phase<pg8::EpiNorm2, pg8::SplitOrder, false, true>(lds, g, S, E);
                if ((int)blockIdx.x >= 32) { const int t_ = otid(); const int w_ = __builtin_amdgcn_readfirstlane(t_ >> 6);
                    convert_weights(P, lds, 1, ((int)blockIdx.x - 32) * 8 + w_, ((int)gridDim.x - 32) * 8, w_, t_ & 63, 0, 5760); } } }
        if (EN(8) && IN(pb + 5) && !fuse_n2) for (int rep = 0; rep < (l == 0 ? REP_OP0 : 1); ++rep) { const Params P = ldparams(kparams());
            pg8::Gemm g{WSP(const bf16, WS_ACT), WSP(const bf16, WS_WT + (size_t)l * WT_LAYER + WT_OUT), mrows, DM, DM, DM}; pg8::StaticOrder S; S.init(mrows, DM, gridDim.x, blockIdx.x);
            pg8::EpiRes E{l == 0 ? P.x : P.out, l == 0 ? P.ctx : WSP(const float, WS_XC), P.out, WSP(float, WS_XC), WSP(const float, WS_MOD) + (size_t)l * 9 * 6144 + 2048};
            pg8::gemm_phase<pg8::EpiRes, pg8::StaticOrder, true, true>(lds, g, S, E);
            if (l == 0) {
                const int G = (int)gridDim.x, nun = (MT / 256) * (DM / 256), rem = nun % G, first = rem == 0 ? 0 : rem, nb = G - first;
                if ((int)blockIdx.x >= first) { const int t_ = otid(); const int w_ = __builtin_amdgcn_readfirstlane(t_ >> 6);
                    convert_weights(P, lds, 1, ((int)blockIdx.x - first) * 8 + w_, nb * 8, w_, t_ & 63, 0, 5760); } } }
        if (!fuse_n2) SEAM(pb + 5);
        if (EN(1) && IN(pb + 6) && !fuse_n2) for (int rep = 0; rep < REP_NORM; ++rep) { const Params P = ldparams(kparams());
            ph_norm_mod(P.out, WSP(const float, WS_XC), mrows, P.norm2_w + l * DM, WSP(const float, WS_MOD) + (size_t)l * 9 * 6144, 3072, 4096, WSP(bf16, WS_ACT), nullptr, nullptr, nullptr, fuse_n2 ? ML : 0); }
        SEAM(pb + 6);
        if (EN(2) && IN(pb + 7)) for (int rep = 0; rep < REP_GZ; ++rep) { const Params P = ldparams(kparams());
            pg8::Gemm g{WSP(const bf16, WS_ACT), WSP(const bf16, WS_WT + (size_t)l * WT_LAYER + WT_W1), mrows, DFF, DM, DM}; pg8::StaticOrder S; S.init(mrows, DFF, gridDim.x, blockIdx.x);
            pg8::EpiBf E{WSP(bf16, WS_HH), DFF, 1}; pg8::gemm_phase<pg8::EpiBf, pg8::StaticOrder, true, true>(lds, g, S, E); }
        SEAM(pb + 7);
        if (EN(8) && IN(pb + 8)) { const Params P = ldparams(kparams());
            if (l == 1 && gridDim.x == 256) {
              pg8::Gemm g{WSP(const bf16, WS_HH), WSP(const bf16, WS_WT + (size_t)l * WT_LAYER + WT_W2), ML, DM, DFF, DFF}; pg8::StaticOrder S; S.init(ML, DM, gridDim.x, blockIdx.x);
              pg8::EpiFinal E{P.out, P.out, WSP(const float, WS_MOD) + (size_t)l * 9 * 6144 + 5120, P.final_norm_w, WSP(unsigned long long, WS_FSLOT), WSP(unsigned, WS_CTL) + 4096, EPSN};
              pg8::gemm_phase<pg8::EpiFinal, pg8::StaticOrder, false, true>(lds, g, S, E); }
            else
            if (l == 0 && gridDim.x == 256) {
              pg8::Gemm g{WSP(const bf16, WS_HH), WSP(const bf16, WS_WT + WT_W2), ML, DM, DFF, DFF}; pg8::StaticOrder S; S.init(ML, DM, gridDim.x, blockIdx.x);
              const float* mod0 = WSP(const float, WS_MOD); const float* mod1 = mod0 + 9 * 6144;
              pg8::EpiNorm2 E{P.out, P.out, mod0 + 5120, P.norm1_w + DM, mod1 + 1024, mod1 + 0, WSP(bf16, WS_ACT), WSP(unsigned long long, WS_FSLOT + 1024 * 1024), WSP(unsigned, WS_CTL) + 12288, EPSN, 0, -1};
              pg8::gemm_phase<pg8::EpiNorm2, pg8::StaticOrder, false, true>(lds, g, S, E); }
            else
            { pg8::Gemm g{WSP(const bf16, WS_HH), WSP(const bf16, WS_WT + (size_t)l * WT_LAYER + WT_W2), ML, DM, DFF, DFF}; pg8::StaticOrder S; S.init(ML, DM, gridDim.x, blockIdx.x);
              pg8::EpiRes E{P.out, WSP(const float, WS_XC), P.out, WSP(float, WS_XC), WSP(const float, WS_MOD) + (size_t)l * 9 * 6144 + 5120};
              pg8::gemm_phase<pg8::EpiRes, pg8::StaticOrder, true, true>(lds, g, S, E); }
            if (l == 0) {
              pg8::Gemm g{WSP(const bf16, WS_HH), WSP(const bf16, WS_WT + WT_W2), MT, DM, 1024, DFF}; pg8::SplitOrder S{64, 8, 4, 4, (int)gridDim.x, (int)blockIdx.x};
              pg8::EpiPart E{WSP(float, WS_XC), WSP(float, WS_P1), WSP(float, WS_P2), WSP(float, WS_P3), WSP(const float, WS_MOD) + 8 * 6144 + 5120};
              pg8::gemm_phase<pg8::EpiPart, pg8::SplitOrder, true, true>(lds, g, S, E); } }
        if (!(l == 1 && gridDim.x == 256)) SEAM(pb + 8);
    }
    for (int rep = 0; rep < REP_SYNC; ++rep) xcd_barrier(xbar);
    if (EN(9) && IN(19) && gridDim.x != 256) { const Params P = ldparams(kparams()); ph_final_norm(P.out, P.final_norm_w, P.out); }
#undef IN
#undef SEAM
}

#ifndef N_LAUNCH_MODE
#define N_LAUNCH_MODE 1
#endif
extern "C" void kernel_launch(void* const* d_in, const int* in_sizes, int n_in, void* d_out, int out_size, void* d_ws, size_t ws_size, hipStream_t stream) {
    static int grid = 0;
    if (grid == 0) {
        if (n_in != 18 || out_size != ML * DM || ws_size < WS_END) { fprintf(stderr, "kernel_launch: unexpected shapes (n_in %d out %d ws %zu)\n", n_in, out_size, ws_size); grid = -1; return; }
        int dev = 0, cus = 0, per_cu = 0;
        hipGetDevice(&dev); hipDeviceGetAttribute(&cus, hipDeviceAttributeMultiprocessorCount, dev);
        hipFuncSetAttribute((const void*)fwd_kernel, hipFuncAttributeMaxDynamicSharedMemorySize, LDS_BYTES);
        hipOccupancyMaxActiveBlocksPerMultiprocessor(&per_cu, (const void*)fwd_kernel, NTHREADS, LDS_BYTES);
        if (per_cu < 1) { fprintf(stderr, "kernel_launch: occupancy query returned %d\n", per_cu); per_cu = 1; }
        grid = cus * per_cu;
        fprintf(stderr, "kernel_launch: cus %d per_cu %d grid %d\n", cus, per_cu, grid);
    }
    if (grid < 0) return;
    hipMemsetAsync((unsigned char*)d_ws + WS_CTL, 0, CTL_BYTES, stream);
    Params p{};
    const float** pp = (const float**)&p;
    for (int i = 0; i < 18; ++i) pp[i] = (const float*)d_in[i];
    p.out = (float*)d_out; p.ws = (unsigned char*)d_ws;
#if N_LAUNCH_MODE == 1
    p.ph_lo = 0; p.ph_hi = NPHASE;
    void* args[] = {&p};
    hipError_t e = hipLaunchCooperativeKernel((const void*)fwd_kernel, dim3(grid), dim3(NTHREADS), args, LDS_BYTES, stream);
    if (e != hipSuccess) fprintf(stderr, "cooperative launch failed: %s (grid %d)\n", hipGetErrorString(e), grid);
#else
    for (int k = 0; k < NPHASE; ++k) { p.ph_lo = k; p.ph_hi = k + 1;
        hipLaunchKernelGGL(fwd_kernel, dim3(grid), dim3(NTHREADS), LDS_BYTES, stream, p); }
#endif
}
```
